# Optimizing an MI355X kernel written in HIP

```python
import jax, jax.numpy as jnp
from jax import lax
import numpy as np

D_MODEL = 2048
BATCH = 2
SEQ = 4096
DEPTH = 1
DEC_BATCH = 8
DEC_SEQ = 4
PAST_LEN = 16384
PAGE_SIZE = 128

HEAD_DIM = 128
GDN_HEADS = D_MODEL // HEAD_DIM
GDN_WIDTH = GDN_HEADS * HEAD_DIM
CONV_WIDTH = 4
GDN_CHUNK = 64
NSA_HEADS = D_MODEL // HEAD_DIM
NSA_KV_HEADS = NSA_HEADS // 4
NSA_GROUP = NSA_HEADS // NSA_KV_HEADS
NSA_WIDTH = NSA_HEADS * HEAD_DIM
NSA_KV_WIDTH = NSA_KV_HEADS * HEAD_DIM
CMP_BLOCK = 32
SEL_BLOCK = 64
SEL_TOPK = 16
WINDOW = 512
Q_BLOCK = 64
PLE_DIM = 256
FFN_HIDDEN = -(-8 * D_MODEL // (3 * 256)) * 256
PROJ_WIDTH = 4 * GDN_WIDTH + 2 * GDN_HEADS + NSA_WIDTH + 6 * NSA_KV_WIDTH + 3 * NSA_HEADS + 2 * D_MODEL
RMS_EPS = 1e-6
NEG_INF = -1e30
FORCE_BONUS = float(NSA_GROUP + 1)

kernel_name = "hybrid_gdn_nsa_decode_step"


def rmsnorm(x, g):
    xf = x.astype(jnp.float32)
    r = lax.rsqrt(jnp.mean(xf * xf, axis=-1, keepdims=True) + RMS_EPS)
    return (xf * r).astype(x.dtype) * g


def l2norm(x):
    return x * lax.rsqrt(jnp.sum(x * x, axis=-1, keepdims=True) + RMS_EPS)


def masked_softmax(s, valid):
    p = jax.nn.softmax(jnp.where(valid, s, NEG_INF), axis=-1)
    return jnp.where(valid, p, 0.0)


def alibi_slopes():
    h = jnp.arange(1, NSA_HEADS + 1, dtype=jnp.float32)
    return jnp.exp2(-8.0 * h / NSA_HEADS).reshape(NSA_KV_HEADS, NSA_GROUP)


def split_projection(z):
    sizes = (3 * GDN_WIDTH, GDN_WIDTH, GDN_HEADS, GDN_HEADS, NSA_WIDTH,
             2 * NSA_KV_WIDTH, 2 * NSA_KV_WIDTH, 2 * NSA_KV_WIDTH, 3 * NSA_HEADS, 2 * D_MODEL)
    offsets, acc = [], 0
    for s in sizes[:-1]:
        acc += s
        offsets.append(acc)
    return jnp.split(z, offsets, axis=-1)


def causal_conv_silu(u, buf, w):
    T = u.shape[1]
    full = jnp.concatenate([buf.astype(u.dtype), u], axis=1)
    out = full[:, 0:T] * w[0]
    for j in range(1, CONV_WIDTH):
        out = out + full[:, j:j + T] * w[j]
    return jax.nn.silu(out), full[:, T:]


def gdn_chunked(q, k, v, g, beta, S0):
    B, T, H, dk = q.shape
    dv = v.shape[-1]
    C = min(GDN_CHUNK, T)
    N = T // C

    def chunks(a):
        a = a.reshape((B, N, C, H) + a.shape[3:])
        return jnp.moveaxis(jnp.moveaxis(a, 1, 0), 3, 2)

    qc, kc, vc, gc, bc = chunks(q), chunks(k), chunks(v), chunks(g), chunks(beta)
    gc = jnp.cumsum(gc, axis=-1)
    incl = jnp.tril(jnp.ones((C, C), dtype=bool))
    strict = jnp.tril(jnp.ones((C, C), dtype=bool), -1)
    eye = jnp.eye(C, dtype=jnp.float32)

    def step(S, inp):
        qi, ki, vi, gi, bi = inp
        decay = jnp.exp(jnp.where(incl, gi[..., :, None] - gi[..., None, :], NEG_INF))
        kk = jnp.einsum('bhid,bhjd->bhij', ki, ki)
        L = jnp.where(strict, kk * decay, 0.0) * bi[..., :, None]
        rhs = jnp.concatenate([vi * bi[..., None], ki * (bi * jnp.exp(gi))[..., None]], axis=-1)
        sol = lax.linalg.triangular_solve(eye + L, rhs, left_side=True, lower=True, unit_diagonal=True)
        u, w = sol[..., :dv], sol[..., dv:]
        v_new = u - jnp.einsum('bhck,bhkv->bhcv', w, S)
        qk = jnp.einsum('bhid,bhjd->bhij', qi, ki) * decay
        o = (jnp.einsum('bhck,bhkv->bhcv', qi * jnp.exp(gi)[..., None], S)
             + jnp.einsum('bhij,bhjv->bhiv', qk, v_new))
        g_last = gi[..., -1:]
        S = (S * jnp.exp(g_last)[..., None]
             + jnp.einsum('bhck,bhcv->bhkv', ki * jnp.exp(g_last - gi)[..., None], v_new))
        return S, o

    S, o = lax.scan(step, S0, (qc, kc, vc, gc, bc))
    o = jnp.moveaxis(jnp.moveaxis(o, 3, 2), 0, 1).reshape(B, T, H, dv)
    return o, S


def nsa_block(q, gates, t_pos, kvc, c_end, sel, kw, w_pos, slopes):
    B, Tq, G, R, d = q.shape
    f32 = jnp.float32
    sl = slopes[None, None, :, :, None]
    kc, vc = kvc[:, :, 0], kvc[:, :, 1]
    dist_c = t_pos[:, None] - c_end[None, :]
    s = jnp.einsum('btgrd,bngd->btgrn', q, kc).astype(f32) - sl * dist_c.astype(f32)[None, :, None, None, :]
    p_c = masked_softmax(s, (dist_c >= 0)[None, :, None, None, :])
    o_c = jnp.einsum('btgrn,bngd->btgrd', p_c.astype(vc.dtype), vc)
    NS = sel.shape[2]
    ratio = SEL_BLOCK // CMP_BLOCK
    NC = p_c.shape[-1]
    imp = jnp.pad(p_c.sum(axis=3), ((0, 0), (0, 0), (0, 0), (0, NS * ratio - NC)))
    imp = imp.reshape(B, Tq, G, NS, ratio).sum(-1)
    blk = jnp.arange(NS)
    cur = t_pos // SEL_BLOCK
    forced = (blk[None, :] == 0) | (blk[None, :] == cur[:, None]) | (blk[None, :] == cur[:, None] - 1)
    avail = blk[None, :] * SEL_BLOCK <= t_pos[:, None]
    score = jnp.where(forced[None, :, None, :], imp + FORCE_BONUS,
                      jnp.where(avail[None, :, None, :], imp, -1.0))
    k_sel = min(SEL_TOPK, NS)
    _, idx = lax.top_k(score, k_sel)
    idx_t = idx.transpose(0, 2, 1, 3).reshape(B, G, Tq * k_sel)
    kv = sel[jnp.arange(B)[:, None, None], jnp.arange(G)[None, :, None], idx_t]
    kv = kv.reshape(B, G, Tq, k_sel * SEL_BLOCK, 2, d)
    kpos = (idx[..., None] * SEL_BLOCK + jnp.arange(SEL_BLOCK)).reshape(B, Tq, G, k_sel * SEL_BLOCK)
    dist_s = t_pos[None, :, None, None] - kpos
    s = jnp.einsum('btgrd,bgtkd->btgrk', q, kv[..., 0, :]).astype(f32) - sl * dist_s.astype(f32)[:, :, :, None, :]
    p_s = masked_softmax(s, (dist_s >= 0)[:, :, :, None, :])
    o_s = jnp.einsum('btgrk,bgtkd->btgrd', p_s.astype(kv.dtype), kv[..., 1, :])
    dist_w = t_pos[:, None] - w_pos[None, :]
    valid_w = (dist_w >= 0) & (dist_w < WINDOW) & (w_pos[None, :] >= 0)
    s = jnp.einsum('btgrd,bsgd->btgrs', q, kw[:, :, 0]).astype(f32) - sl * dist_w.astype(f32)[None, :, None, None, :]
    p_w = masked_softmax(s, valid_w[None, :, None, None, :])
    o_w = jnp.einsum('btgrs,bsgd->btgrd', p_w.astype(kw.dtype), kw[:, :, 1])
    return gates[..., 0:1] * o_c + gates[..., 1:2] * o_s + gates[..., 2:3] * o_w


def nsa_attention(q_n, gate_n, cmp_all, sel_all, kw_pad, past_len, w_cmp):
    B, T, _ = q_n.shape
    Tk = cmp_all.shape[1]
    G, R, d = NSA_KV_HEADS, NSA_GROUP, HEAD_DIM
    q = q_n.reshape(B, T, G, R, d) * (HEAD_DIM ** -0.5)
    gates = jax.nn.sigmoid(gate_n.reshape(B, T, G, R, 3))
    NC = Tk // CMP_BLOCK
    blocks = cmp_all[:, :NC * CMP_BLOCK].reshape(B, NC, CMP_BLOCK, 2, G, d)
    kvc = jnp.einsum('bncxgd,cxgd->bnxgd', blocks, w_cmp)
    c_end = jnp.arange(NC) * CMP_BLOCK + (CMP_BLOCK - 1)
    NS = -(-Tk // SEL_BLOCK)
    sel = jnp.pad(sel_all, ((0, 0), (0, NS * SEL_BLOCK - Tk), (0, 0), (0, 0), (0, 0)))
    sel = sel.reshape(B, NS, SEL_BLOCK, 2, G, d).transpose(0, 4, 1, 2, 3, 5)
    slopes = alibi_slopes()
    qb = min(Q_BLOCK, T)
    nb = T // qb

    def one_block(i):
        s0 = i * qb
        qi = lax.dynamic_slice_in_dim(q, s0, qb, axis=1)
        gi = lax.dynamic_slice_in_dim(gates, s0, qb, axis=1)
        kwi = lax.dynamic_slice_in_dim(kw_pad, s0, WINDOW + qb, axis=1)
        t_pos = past_len + s0 + jnp.arange(qb)
        w_pos = past_len - WINDOW + s0 + jnp.arange(WINDOW + qb)
        return nsa_block(qi, gi, t_pos, kvc, c_end, sel, kwi, w_pos, slopes)

    o = lax.map(one_block, jnp.arange(nb))
    return o.transpose(1, 0, 2, 3, 4, 5).reshape(B, T, NSA_WIDTH)


def trunk_layer(x, ple, past_len, win_buf, conv_buf, S0, cmp_past, sel_past, win_past,
                g_pre1, w_in, conv_w, A_log, dt_bias, gdn_norm_w, w_cmp, w_o, g_post1,
                g_pre2, w_ffn_in, w_ffn_out, g_post2, w_ple, w_ple_gate):
    B, T, _ = x.shape
    f32 = jnp.float32
    h = rmsnorm(x, g_pre1)
    (qkv_a, z_a, a_a, b_a, q_n, cmp_new, sel_new, win_new, gate_n, gate_m) = split_projection(h @ w_in)
    qkv_c, conv_new = causal_conv_silu(qkv_a, conv_buf, conv_w)
    qa, ka, va = [a.reshape(B, T, GDN_HEADS, HEAD_DIM) for a in jnp.split(qkv_c.astype(f32), 3, axis=-1)]
    qa = l2norm(qa) * (HEAD_DIM ** -0.5)
    ka = l2norm(ka)
    beta = jax.nn.sigmoid(b_a.astype(f32))
    g = -jnp.exp(A_log.astype(f32)) * jax.nn.softplus(a_a.astype(f32) + dt_bias.astype(f32))
    o_a, S_new = gdn_chunked(qa, ka, va, g, beta, S0.astype(f32))
    o_a = rmsnorm(o_a, gdn_norm_w.astype(f32)) * jax.nn.silu(z_a.astype(f32).reshape(B, T, GDN_HEADS, HEAD_DIM))
    o_a = o_a.reshape(B, T, GDN_WIDTH).astype(x.dtype)
    kv_shape = (B, T, 2, NSA_KV_HEADS, HEAD_DIM)
    cmp_new = cmp_new.reshape(kv_shape)
    sel_new = sel_new.reshape(kv_shape)
    win_new = win_new.reshape(kv_shape)
    cmp_all = jnp.concatenate([cmp_past.astype(x.dtype), cmp_new], axis=1)
    sel_all = jnp.concatenate([sel_past.astype(x.dtype), sel_new], axis=1)
    win_all = jnp.concatenate([win_past.astype(x.dtype), win_new], axis=1)
    kw_pad = jnp.pad(win_all, ((0, 0), (WINDOW - win_past.shape[1], 0), (0, 0), (0, 0), (0, 0)))
    o_n = nsa_attention(q_n, gate_n, cmp_all, sel_all, kw_pad, past_len, w_cmp)
    win_state = kw_pad[:, kw_pad.shape[1] - win_buf:]
    gm_a, gm_n = jnp.split(jax.nn.sigmoid(gate_m), 2, axis=-1)
    x = x + rmsnorm((gm_a * o_a + gm_n * o_n) @ w_o, g_post1)
    gt, up = jnp.split(rmsnorm(x, g_pre2) @ w_ffn_in, 2, axis=-1)
    x = x + rmsnorm((jax.nn.silu(gt) * up) @ w_ffn_out, g_post2)
    x = x + jax.nn.sigmoid(x @ w_ple_gate) * (ple @ w_ple)
    return x, cmp_new, sel_new, win_state, S_new, conv_new


def setup_inputs(seed: int = 0) -> dict:
    key = jax.random.key(seed)
    ks = jax.random.split(key, 26)
    f32 = jnp.float32
    n_pages = PAST_LEN // PAGE_SIZE
    used = DEC_BATCH * n_pages
    n_pool = used + max(1, used // 4)
    win_buf = min(WINDOW, PAST_LEN)
    kvh = (2, NSA_KV_HEADS, HEAD_DIM)
    nrm = lambda k, shape, s=1.0: jax.random.normal(k, shape, f32) * s
    gain = lambda k, shape: 1.0 + 0.05 * jax.random.normal(k, shape, f32)
    page_table = jax.random.permutation(ks[3], n_pool)[:used].reshape(DEC_BATCH, n_pages).astype(jnp.int32)
    dt = jnp.exp(jax.random.uniform(ks[14], (DEPTH, GDN_HEADS), f32, np.log(0.001), np.log(0.1)))
    return {
        "x_prompt": nrm(ks[0], (BATCH, SEQ, D_MODEL)),
        "x_sample": nrm(ks[1], (DEC_BATCH, DEC_SEQ, D_MODEL)),
        "cache_cmp_kv": nrm(ks[2], (DEPTH, n_pool, PAGE_SIZE) + kvh),
        "cache_sel_kv": nrm(ks[4], (DEPTH, n_pool, PAGE_SIZE) + kvh),
        "page_table": page_table,
        "state_win_kv": nrm(ks[5], (DEPTH, DEC_BATCH, win_buf) + kvh),
        "state_gdn": nrm(ks[6], (DEPTH, DEC_BATCH, GDN_HEADS, HEAD_DIM, HEAD_DIM), 0.1),
        "state_conv": nrm(ks[7], (DEPTH, DEC_BATCH, CONV_WIDTH - 1, 3 * GDN_WIDTH)),
        "p_prompt": nrm(ks[8], (DEPTH, BATCH, SEQ, PLE_DIM)),
        "p_sample": nrm(ks[9], (DEPTH, DEC_BATCH, DEC_SEQ, PLE_DIM)),
        "g_pre1": gain(ks[10], (DEPTH, D_MODEL)),
        "w_in": nrm(ks[11], (DEPTH, D_MODEL, PROJ_WIDTH), D_MODEL ** -0.5),
        "conv_w": nrm(ks[12], (DEPTH, CONV_WIDTH, 3 * GDN_WIDTH), CONV_WIDTH ** -0.5),
        "A_log": jnp.log(jax.random.uniform(ks[13], (DEPTH, GDN_HEADS), f32, 1.0, 16.0)),
        "dt_bias": dt + jnp.log(-jnp.expm1(-dt)),
        "gdn_norm_w": gain(ks[15], (DEPTH, HEAD_DIM)),
        "w_cmp": (1.0 + 0.5 * jax.random.normal(ks[16], (DEPTH, CMP_BLOCK) + kvh, f32)) / CMP_BLOCK,
        "w_o": nrm(ks[17], (DEPTH, D_MODEL, D_MODEL), D_MODEL ** -0.5),
        "g_post1": gain(ks[18], (DEPTH, D_MODEL)),
        "g_pre2": gain(ks[19], (DEPTH, D_MODEL)),
        "w_ffn_in": nrm(ks[20], (DEPTH, D_MODEL, 2 * FFN_HIDDEN), D_MODEL ** -0.5),
        "w_ffn_out": nrm(ks[21], (DEPTH, FFN_HIDDEN, D_MODEL), FFN_HIDDEN ** -0.5),
        "g_post2": gain(ks[22], (DEPTH, D_MODEL)),
        "w_ple": nrm(ks[23], (DEPTH, PLE_DIM, D_MODEL), PLE_DIM ** -0.5),
        "w_ple_gate": nrm(ks[24], (DEPTH, D_MODEL, D_MODEL), D_MODEL ** -0.5),
    }


def reference(x_prompt, x_sample, cache_cmp_kv, cache_sel_kv, page_table, state_win_kv, state_gdn,
              state_conv, p_prompt, p_sample, g_pre1, w_in, conv_w, A_log, dt_bias, gdn_norm_w, w_cmp,
              w_o, g_post1, g_pre2, w_ffn_in, w_ffn_out, g_post2, w_ple, w_ple_gate):
    B = x_prompt.shape[0]
    Bs = x_sample.shape[0]
    n_pages = page_table.shape[1]
    past_len = n_pages * PAGE_SIZE
    win_buf = state_win_kv.shape[2]
    kvh = (2, NSA_KV_HEADS, HEAD_DIM)
    xp, xs = x_prompt, x_sample
    outs_p, outs_s = [], []
    for i in range(DEPTH):
        w = (g_pre1[i], w_in[i], conv_w[i], A_log[i], dt_bias[i], gdn_norm_w[i], w_cmp[i], w_o[i],
             g_post1[i], g_pre2[i], w_ffn_in[i], w_ffn_out[i], g_post2[i], w_ple[i], w_ple_gate[i])
        empty = jnp.zeros((B, 0) + kvh, xp.dtype)
        conv0 = jnp.zeros((B, CONV_WIDTH - 1, 3 * GDN_WIDTH), xp.dtype)
        S0 = jnp.zeros((B, GDN_HEADS, HEAD_DIM, HEAD_DIM), jnp.float32)
        xp, *sp = trunk_layer(xp, p_prompt[i], 0, win_buf, conv0, S0, empty, empty, empty, *w)
        cmp_past = cache_cmp_kv[i][page_table].reshape((Bs, past_len) + kvh)
        sel_past = cache_sel_kv[i][page_table].reshape((Bs, past_len) + kvh)
        xs, *ss = trunk_layer(xs, p_sample[i], past_len, win_buf, state_conv[i], state_gdn[i],
                              cmp_past, sel_past, state_win_kv[i], *w)
        outs_p.append(sp)
        outs_s.append(ss)
    new_cmp_p = jnp.stack([o[0] for o in outs_p])
    new_sel_p = jnp.stack([o[1] for o in outs_p])
    new_win_p = jnp.stack([o[2] for o in outs_p])
    new_gdn_p = jnp.stack([o[3] for o in outs_p])
    new_conv_p = jnp.stack([o[4] for o in outs_p])
    new_cmp_s = jnp.stack([o[0] for o in outs_s])
    new_sel_s = jnp.stack([o[1] for o in outs_s])
    new_win_s = jnp.stack([o[2] for o in outs_s])
    new_gdn_s = jnp.stack([o[3] for o in outs_s])
    new_conv_s = jnp.stack([o[4] for o in outs_s])
    return (xp, xs, new_cmp_p, new_sel_p, new_win_p, new_gdn_p, new_conv_p,
            new_cmp_s, new_sel_s, new_win_s, new_gdn_s, new_conv_s)
```

```cpp
#ifndef CPU_SHIM
#include <hip/hip_runtime.h>
#endif
#include <cstdio>
#include <cstdint>
#include <cstring>
#include <cmath>

#ifndef CFG_D_MODEL
#define CFG_D_MODEL 2048
#define CFG_BATCH 2
#define CFG_SEQ 4096
#define CFG_DEC_BATCH 8
#define CFG_PAST_LEN 16384
#endif
namespace cfg {
constexpr int D = CFG_D_MODEL, BATCH = CFG_BATCH, SEQ = CFG_SEQ, DEC_BATCH = CFG_DEC_BATCH, DEC_SEQ = 4, PAST = CFG_PAST_LEN, PAGE = 128;
constexpr int HD = 128, GH = D / HD, GW = GH * HD, NH = D / HD, NKV = NH / 4, NSAW = NH * HD, KVW = NKV * HD, KV2 = 2 * KVW;
constexpr int FFN = ((8 * D + 3 * 256 - 1) / (3 * 256)) * 256, PLE = 256, WINDOW = 512, WINBUF = (WINDOW < PAST ? WINDOW : PAST);
constexpr int C_QKV = 0, C_Z = 3 * GW, C_A = 4 * GW, C_B = C_A + GH, C_QN = C_B + GH, C_CMP = C_QN + NSAW, C_SEL = C_CMP + KV2, C_WIN = C_SEL + KV2,
              C_GN = C_WIN + KV2, C_GM = C_GN + 3 * NH, PROJ = C_GM + 2 * D;
constexpr int NPROJ = ((PROJ + 255) / 256) * 256;
constexpr int N_PAGES = PAST / PAGE, USED = DEC_BATCH * N_PAGES, N_POOL = USED + (USED / 4 > 1 ? USED / 4 : 1);
constexpr int MPR = BATCH * SEQ, MSA = DEC_BATCH * DEC_SEQ, M = MPR + MSA, MPAD = ((M + 255) / 256) * 256;
constexpr int NCP = SEQ / 32, NSP = (SEQ + 63) / 64;
constexpr int TKS = PAST + DEC_SEQ, NCS = TKS / 32, NSS = (TKS + 63) / 64;
constexpr int KSEL_P = NSP < 16 ? NSP : 16, KSEL_S = NSS < 16 ? NSS : 16;
static_assert(SEQ % 64 == 0 && SEQ >= WINDOW && PAST % 128 == 0 && PAST >= WINDOW && D % 256 == 0, "shape assumptions");
constexpr long O_YP = 0, O_YS = O_YP + (long)MPR * D, O_CMPP = O_YS + (long)MSA * D, O_SELP = O_CMPP + (long)MPR * KV2, O_WINP = O_SELP + (long)MPR * KV2,
               O_GDNP = O_WINP + (long)BATCH * WINBUF * KV2, O_CONVP = O_GDNP + (long)BATCH * GH * HD * HD, O_CMPS = O_CONVP + (long)BATCH * 3 * 3 * GW,
               O_SELS = O_CMPS + (long)MSA * KV2, O_WINS = O_SELS + (long)MSA * KV2, O_GDNS = O_WINS + (long)DEC_BATCH * WINBUF * KV2,
               O_CONVS = O_GDNS + (long)DEC_BATCH * GH * HD * HD, O_END = O_CONVS + (long)DEC_BATCH * 3 * 3 * GW;
constexpr float RMS_EPS = 1e-6f, NEG_INF = -1e30f, FORCE_BONUS = 5.0f, QSCALE = 0.08838834764831845f;
}
using namespace cfg;

typedef unsigned short bf16_t;
#ifdef CPU_SHIM
typedef float act_t;
#else
typedef bf16_t act_t;
#endif

#ifdef CPU_SHIM
static thread_local int g_bid = 0, g_nblk = 1;
#define BID g_bid
#define NBLK g_nblk
#define TID 0
#define NTHR 1
#define SYNC() do {} while (0)
#define CFENCE() do {} while (0)
#define UNIFORM(x) (x)
#define DEVFN static inline
#define LDSP
static inline float rsqrt_f(float x) { return 1.0f / sqrtf(x); }
static inline float exp2_f(float x) { return exp2f(x); }
#else
#define BID ((int)blockIdx.x)
#define NBLK ((int)gridDim.x)
#define TID ((int)threadIdx.x)
#define NTHR ((int)blockDim.x)
#define SYNC() __syncthreads()
#define CFENCE() asm volatile("" ::: "memory")
#define UNIFORM(x) __builtin_amdgcn_readfirstlane(x)
#define DEVFN __device__ __forceinline__
#define LDSP
__device__ __forceinline__ float rsqrt_f(float x) { return 1.0f / sqrtf(x); }
__device__ __forceinline__ float exp2_f(float x) { return exp2f(x); }
#endif
#define GSL(i, n) for (long i = (long)BID * NTHR + TID; i < (long)(n); i += (long)NBLK * NTHR)
#define BSL(i, n) for (int i = TID; i < (int)(n); i += NTHR)
#define USL(u, n) for (int u = BID; u < (int)(n); u += NBLK)

DEVFN float sigmoid_f(float x) { return 1.0f / (1.0f + expf(-x)); }
DEVFN float silu_f(float x) { return x / (1.0f + expf(-x)); }
DEVFN float softplus_f(float x) { return fmaxf(x, 0.0f) + log1pf(expf(-fabsf(x))); }
DEVFN bf16_t f2bf(float f) { unsigned u; memcpy(&u, &f, 4); u += 0x7FFFu + ((u >> 16) & 1u); return (bf16_t)(u >> 16); }
DEVFN float bf2f(bf16_t b) { unsigned u = ((unsigned)b) << 16; float f; memcpy(&f, &u, 4); return f; }
#ifdef CPU_SHIM
DEVFN act_t to_act(float f) { return f; }
DEVFN float from_act(act_t a) { return a; }
#else
DEVFN act_t to_act(float f) { return f2bf(f); }
DEVFN float from_act(act_t a) { return bf2f(a); }
#endif

struct Params {
    const float *x_prompt, *x_sample, *cache_cmp, *cache_sel; const int* page_table;
    const float *state_win, *state_gdn, *state_conv, *p_prompt, *p_sample, *g_pre1, *w_in, *conv_w, *A_log, *dt_bias, *gdn_norm_w, *w_cmp,
                *w_o, *g_post1, *g_pre2, *w_ffn_in, *w_ffn_out, *g_post2, *w_ple, *w_ple_gate;
    float* out;
    unsigned* ctl;
    act_t *Wt_in, *Wt_o, *Wt_ffi, *Wt_ffo, *Wt_pg, *Wt_ple;
    act_t *H1, *Pbf, *MIX, *H2, *ACT, *X2b;
    float *Z, *QKVc, *GB, *OA, *KVCp, *KVCs, *On, *T1, *X1, *FF, *T2, *X2, *G, *PL;
    int ph_lo, ph_hi;
};

DEVFN const float* x_row(const Params& p, int m) { return m < MPR ? p.x_prompt + (size_t)m * D : p.x_sample + (size_t)(m - MPR) * D; }
#ifndef CPU_SHIM
namespace pg8 {
#define PG8_LAS __attribute__((address_space(3)))
typedef unsigned short bf16_t;
typedef short bf16x8 __attribute__((ext_vector_type(8)));
typedef float f32x4 __attribute__((ext_vector_type(4)));
typedef unsigned u32x4 __attribute__((ext_vector_type(4)));
constexpr int BM = 256, BK = 64, HALF = 128, HTB = HALF * BK * 2  , STAGE_BYTES = 8 * HTB, NXCD = 8, WGM = 8;

__host__ __device__ __forceinline__ int lds_byte(int r, int c) { const int st = (r >> 4) * 2 + (c >> 5), rr = r & 15, cc = c & 31, ob = rr * 64 + cc * 2; return st * 1024 + (ob ^ (((ob >> 9) & 1) << 5)); }
__host__ __device__ __forceinline__ void stage_rc(int b, int& R, int& C) { const int st = b / 1024, sb = b % 1024, swz = sb ^ (((sb >> 9) & 1) << 5); R = (st >> 1) * 16 + swz / 64; C = (st & 1) * 32 + (swz % 64) / 2; }
__host__ __device__ __forceinline__ int perm32(int rho) { const int n = rho >> 4, i = rho & 15; return 8 * (i >> 2) + 4 * n + (i & 3); }

struct Unit { int pm, pn; };
struct Gemm { const bf16_t* A; const bf16_t* Bt; int M, N, K; };

struct StaticOrder {
    int nM, nN, nwg, G, c;
    __host__ __device__ void init(int M, int N, int G_, int c_) { nM = M / BM; nN = N / BM; nwg = nM * nN; G = G_; c = c_; }
    __host__ __device__ bool next(int i, Unit& u) const {
        const long L = (long)i * G + c; if (L >= nwg) return false;
        int wgid = (int)L; { const int q = nwg / NXCD, r = nwg % NXCD, xcd = wgid % NXCD, off = wgid / NXCD; wgid = (xcd < r ? xcd * (q + 1) : r * (q + 1) + (xcd - r) * q) + off; }
        const int nig = WGM * nN, gid = wgid / nig, fm = gid * WGM, gsz = (nM - fm) < WGM ? (nM - fm) : WGM;
        u.pm = fm + ((wgid % nig) % gsz); u.pn = (wgid % nig) / gsz; return true;
    }
    __device__ __forceinline__ void a_ready(const Unit&) const {}
    __device__ __forceinline__ void done(const Unit&) const {}
};
struct CountedOrder : StaticOrder {
    const unsigned* ready; unsigned need; unsigned* tmo;
    __device__ __forceinline__ void a_ready(const Unit& u) const {
        if (threadIdx.x < 64) {
            const unsigned long long t0 = __builtin_amdgcn_s_memrealtime(); unsigned polls = 0;
            while ((unsigned)__builtin_amdgcn_readfirstlane(__hip_atomic_load(ready + 64 * u.pm, __ATOMIC_RELAXED, __HIP_MEMORY_SCOPE_AGENT)) < need) {
                if ((++polls & 255u) == 0u && __builtin_amdgcn_readfirstlane(__hip_atomic_load(tmo, __ATOMIC_RELAXED, __HIP_MEMORY_SCOPE_AGENT)) != 0u) break;
                if (__builtin_amdgcn_s_memrealtime() - t0 > 2000000ull) {
                    if (threadIdx.x == 0) { unsigned expect = 0u; __hip_atomic_compare_exchange_strong(tmo + 1, &expect, 0x600u | (unsigned)(u.pm & 0xff), __ATOMIC_RELAXED, __ATOMIC_RELAXED, __HIP_MEMORY_SCOPE_AGENT); __hip_atomic_store(tmo, 1u, __ATOMIC_RELAXED, __HIP_MEMORY_SCOPE_AGENT); }
                    break; }
                __builtin_amdgcn_s_sleep(2); }
            __builtin_amdgcn_fence(__ATOMIC_ACQUIRE, "agent");
            asm volatile("s_waitcnt vmcnt(0)" ::: "memory");
        }
#if !defined(BROKEN_HOOK_NO_BARRIER)
        asm volatile("" ::: "memory"); __builtin_amdgcn_s_barrier(); asm volatile("" ::: "memory");
#endif
    }
};

__device__ __forceinline__ unsigned cvt_pk_bf16(float lo, float hi) { unsigned r; asm volatile("v_cvt_pk_bf16_f32 %0, %1, %2" : "=v"(r) : "v"(lo), "v"(hi)); return r; }
typedef float f32x2 __attribute__((ext_vector_type(2)));
__device__ __forceinline__ f32x2 gelu_pk(f32x2 v) {
    const f32x2 av = __builtin_elementwise_abs(v), d = av * 0.2316418882f + 1.0f;
    f32x2 t; t.x = __builtin_amdgcn_rcpf(d.x); t.y = __builtin_amdgcn_rcpf(d.y);
    f32x2 q = t * 0.5307027145f + (-0.7265760135f); q = q * t + 0.7107068705f; q = q * t + (-0.142248368f); q = q * t + 0.127414796f; q = q * t;
    const f32x2 s = (v * v) * (-0.72134752044f);
    f32x2 e; e.x = __builtin_amdgcn_exp2f(s.x); e.y = __builtin_amdgcn_exp2f(s.y);
    const f32x2 m = v * (q * e), r = v - m;
    f32x2 o; o.x = v.x < 0.f ? m.x : r.x; o.y = v.y < 0.f ? m.y : r.y; return o;
}

struct EpiF32 {
    static constexpr bool PERM = false, AFTER_DRAIN = false;
    float* C; int ldc; const float* bias;
    __device__ __forceinline__ void operator()(const f32x4 (&acc)[2][2][4][2], const Unit& u, int wr, int wc, int fr, int fq) const {
        const int row0 = u.pm * BM + wr * 64 + fr, col0 = u.pn * BM + wc * 32 + 4 * fq;
        f32x4 bv[2][2];
#pragma unroll
        for (int bj = 0; bj < 2; ++bj)
#pragma unroll
            for (int n = 0; n < 2; ++n) bv[bj][n] = bias ? *(const f32x4*)(bias + col0 + bj * HALF + n * 16) : (f32x4){0.f, 0.f, 0.f, 0.f};
#pragma unroll
        for (int ai = 0; ai < 2; ++ai)
#pragma unroll
            for (int m = 0; m < 4; ++m) { float* rowp = C + (size_t)(row0 + ai * HALF + m * 16) * ldc + col0;
#pragma unroll
                for (int bj = 0; bj < 2; ++bj)
#pragma unroll
                    for (int n = 0; n < 2; ++n) *(f32x4*)(rowp + bj * HALF + n * 16) = acc[ai][bj][m][n] + bv[bj][n]; }
    }
};
template <int ACT  > struct EpiBf16 {
    static constexpr bool PERM = true, AFTER_DRAIN = false;
    bf16_t* O; int ldc; const float* bias; int split_cols; size_t split_stride;
    __device__ __forceinline__ void operator()(const f32x4 (&acc)[2][2][4][2], const Unit& u, int wr, int wc, int fr, int fq) const {
        const int row0 = u.pm * BM + wr * 64 + fr; int colt = u.pn * BM; bf16_t* base = O;
        if (split_cols) { const int t = colt / split_cols; base += (size_t)t * split_stride; colt -= t * split_cols; }
        const int col0 = colt + wc * 32 + 8 * fq, bcol0 = u.pn * BM + wc * 32 + 8 * fq;
        f32x4 bv[2][2];
#pragma unroll
        for (int bj = 0; bj < 2; ++bj)
#pragma unroll
            for (int n = 0; n < 2; ++n) bv[bj][n] = bias ? *(const f32x4*)(bias + bcol0 + bj * HALF + 4 * n) : (f32x4){0.f, 0.f, 0.f, 0.f};
#pragma unroll
        for (int ai = 0; ai < 2; ++ai)
#pragma unroll
            for (int m = 0; m < 4; ++m) { bf16_t* rowp = base + (size_t)(row0 + ai * HALF + m * 16) * ldc + col0;
#pragma unroll
                for (int bj = 0; bj < 2; ++bj) { f32x4 v0 = acc[ai][bj][m][0] + bv[bj][0], v1 = acc[ai][bj][m][1] + bv[bj][1];
                    if (ACT == 1) { f32x2 a = gelu_pk((f32x2){v0[0], v0[1]}), b = gelu_pk((f32x2){v0[2], v0[3]}), c = gelu_pk((f32x2){v1[0], v1[1]}), d = gelu_pk((f32x2){v1[2], v1[3]});
                        v0 = (f32x4){a.x, a.y, b.x, b.y}; v1 = (f32x4){c.x, c.y, d.x, d.y}; }
                    if (ACT == 2) {
#pragma unroll
                        for (int j = 0; j < 4; ++j) { v0[j] = 0.5f * v0[j] * (1.0f + erff(v0[j] * 0.70710678f)); v1[j] = 0.5f * v1[j] * (1.0f + erff(v1[j] * 0.70710678f)); } }
                    u32x4 w; w.x = cvt_pk_bf16(v0[0], v0[1]); w.y = cvt_pk_bf16(v0[2], v0[3]); w.z = cvt_pk_bf16(v1[0], v1[1]); w.w = cvt_pk_bf16(v1[2], v1[3]);
                    *(u32x4*)(rowp + bj * HALF) = w; } }
    }
};
template <class Epi, class Sched, bool STAMP = false>
__device__ __forceinline__ void gemm_phase(PG8_LAS unsigned char* lds, const Gemm g, const Sched& S, const Epi& E, unsigned long long* stamps) {
    const int tid = threadIdx.x, wid = __builtin_amdgcn_readfirstlane(tid >> 6), lane = tid & 63, wr = wid >> 2, wc = wid & 3, fr = lane & 15, fq = lane >> 4;
    const int K = g.K, nt = K / BK;
    int ts_lo = 0, ts_hi = 0, nts = 0; const unsigned long long rt_entry = STAMP ? (unsigned long long)wall_clock64() : 0ull;
#define PG8_STAMP() do { if (STAMP && wid == 0 && nts < 64) { const unsigned long long _c = (unsigned long long)clock64(); \
        ts_lo = (lane == nts) ? (int)(unsigned)_c : ts_lo; ts_hi = (lane == nts) ? (int)(unsigned)(_c >> 32) : ts_hi; ++nts; } } while (0)
    PG8_STAMP();
    unsigned voffA[2], voffB[2];
#pragma unroll
    for (int i = 0; i < 2; ++i) { int R, C; stage_rc(tid * 16 + i * 8192, R, C); const int Rb = Epi::PERM ? ((R & ~31) + perm32(R & 31)) : R;
        voffA[i] = (unsigned)(R * K + C) * 2u; voffB[i] = (unsigned)(Rb * K + C) * 2u; }
    const size_t kstep = (size_t)(BK * 2);
    const size_t hstep = (size_t)HALF * K * 2;
    const size_t tstep = 2 * hstep;
    const unsigned ldsw = (unsigned)wid * 1024u;
    const int aoff = lds_byte(wr * 64 + fr, fq * 8), boff = lds_byte(wc * 32 + fr, fq * 8);
#define PG8_SA(b, h) (((b) * 2 + (h)) * HTB)
#define PG8_SB(b, h) ((4 + (b) * 2 + (h)) * HTB)
#define PG8_STAGE(bufoff, gbase, voff) do { _Pragma("unroll") for (int _i = 0; _i < 2; ++_i) \
        __builtin_amdgcn_global_load_lds((const unsigned*)((const char*)(gbase) + (voff)[_i]), (PG8_LAS unsigned*)(lds + (bufoff) + ldsw + _i * 8192), 16, 0, 0); } while (0)
#define PG8_LDA(dst, b, h) do { _Pragma("unroll") for (int m = 0; m < 4; ++m) _Pragma("unroll") for (int k = 0; k < 2; ++k) dst[m][k] = *(const PG8_LAS bf16x8*)(lds + PG8_SA(b, h) + aoff + m * 2048 + k * 1024); } while (0)
#define PG8_LDB(dst, b, h) do { _Pragma("unroll") for (int n = 0; n < 2; ++n) _Pragma("unroll") for (int k = 0; k < 2; ++k) dst[n][k] = *(const PG8_LAS bf16x8*)(lds + PG8_SB(b, h) + boff + n * 2048 + k * 1024); } while (0)
#define PG8_MMA(ai, bj, At, Bt) do { __builtin_amdgcn_s_setprio(1); _Pragma("unroll") for (int m = 0; m < 4; ++m) _Pragma("unroll") for (int n = 0; n < 2; ++n) _Pragma("unroll") for (int k = 0; k < 2; ++k) \
        acc[ai][bj][m][n] = __builtin_amdgcn_mfma_f32_16x16x32_bf16(Bt[n][k], At[m][k], acc[ai][bj][m][n], 0, 0, 0); __builtin_amdgcn_s_setprio(0); } while (0)
#define PG8_WAIT_V(n) asm volatile("s_waitcnt vmcnt(" #n ")" ::: "memory")
#define PG8_WAIT_L(n) asm volatile("s_waitcnt lgkmcnt(" #n ")" ::: "memory")
#define PG8_BAR __builtin_amdgcn_s_barrier()
#define PG8_SCHED __builtin_amdgcn_sched_barrier(0)
    Unit cur, nxt; int ui = 0;
    if (!S.next(0, cur)) return;
    f32x4 acc[2][2][4][2];
#pragma unroll
    for (int a = 0; a < 2; ++a)
#pragma unroll
        for (int b = 0; b < 2; ++b)
#pragma unroll
            for (int m = 0; m < 4; ++m)
#pragma unroll
                for (int n = 0; n < 2; ++n) acc[a][b][m][n] = (f32x4){0.f, 0.f, 0.f, 0.f};
    bf16x8 At[4][2], B0[2][2], B1[2][2];
    const char* cA = (const char*)g.A + (size_t)cur.pm * tstep; const char* cB = (const char*)g.Bt + (size_t)cur.pn * tstep;
    S.a_ready(cur);
    PG8_STAGE(PG8_SB(0, 0), cB, voffB); PG8_STAGE(PG8_SA(0, 0), cA, voffA); PG8_STAGE(PG8_SB(0, 1), cB + hstep, voffB); PG8_STAGE(PG8_SA(0, 1), cA + hstep, voffA);
    if (wr == 1) PG8_BAR;
    PG8_WAIT_V(4); PG8_BAR;
    PG8_STAGE(PG8_SB(1, 0), cB + kstep, voffB); PG8_STAGE(PG8_SA(1, 0), cA + kstep, voffA); PG8_STAGE(PG8_SB(1, 1), cB + hstep + kstep, voffB);
    PG8_WAIT_V(6); PG8_BAR;
    PG8_STAMP();
    for (;;) {
        const bool has_next = S.next(ui + 1, nxt);
        const char* nA = has_next ? (const char*)g.A + (size_t)nxt.pm * tstep : cA; const char* nB = has_next ? (const char*)g.Bt + (size_t)nxt.pn * tstep : cB;
        for (int t = 0; t < nt; t += 2) {
            const bool last = (t == nt - 2);
            const char* a1 = cA + (size_t)(t + 1) * kstep;
            const char* a2 = last ? nA : cA + (size_t)(t + 2) * kstep; const char* b2 = last ? nB : cB + (size_t)(t + 2) * kstep;
            const char* a3 = a2 + kstep; const char* b3 = b2 + kstep;
            if (last && has_next) S.a_ready(nxt);
            PG8_LDB(B0, 0, 0); PG8_SCHED; PG8_LDA(At, 0, 0); PG8_STAGE(PG8_SA(1, 1), a1 + hstep, voffA);
            PG8_WAIT_L(8); PG8_BAR; PG8_WAIT_L(0); PG8_MMA(0, 0, At, B0); PG8_BAR; PG8_SCHED;
            PG8_LDB(B1, 0, 1); PG8_STAGE(PG8_SB(0, 0), b2, voffB);
            PG8_BAR; PG8_WAIT_L(0); PG8_MMA(0, 1, At, B1); PG8_BAR;
            PG8_LDA(At, 0, 1); PG8_STAGE(PG8_SA(0, 0), a2, voffA);
            PG8_BAR; PG8_WAIT_L(0); PG8_MMA(1, 0, At, B0); PG8_BAR; PG8_SCHED;
            PG8_STAGE(PG8_SB(0, 1), b2 + hstep, voffB);
            PG8_WAIT_V(6); PG8_BAR; PG8_MMA(1, 1, At, B1); PG8_BAR;
            PG8_LDB(B0, 1, 0); PG8_SCHED; PG8_LDA(At, 1, 0); PG8_STAGE(PG8_SA(0, 1), a2 + hstep, voffA);
            PG8_WAIT_L(8); PG8_BAR; PG8_WAIT_L(0); PG8_MMA(0, 0, At, B0); PG8_BAR; PG8_SCHED;
            PG8_LDB(B1, 1, 1); PG8_STAGE(PG8_SB(1, 0), b3, voffB);
            PG8_BAR; PG8_WAIT_L(0); PG8_MMA(0, 1, At, B1); PG8_BAR;
            PG8_LDA(At, 1, 1); PG8_STAGE(PG8_SA(1, 0), a3, voffA);
            PG8_BAR; PG8_WAIT_L(0); PG8_MMA(1, 0, At, B0); PG8_BAR; PG8_SCHED;
            PG8_STAGE(PG8_SB(1, 1), b3 + hstep, voffB);
            PG8_WAIT_V(6); PG8_BAR; PG8_MMA(1, 1, At, B1); PG8_BAR;
        }
        PG8_STAMP();
        if constexpr (!Epi::AFTER_DRAIN) { E(acc, cur, wr, wc, fr, fq); S.done(cur); }
        PG8_STAMP();
        if (!has_next) break;
#pragma unroll
        for (int a = 0; a < 2; ++a)
#pragma unroll
            for (int b = 0; b < 2; ++b)
#pragma unroll
                for (int m = 0; m < 4; ++m)
#pragma unroll
                    for (int n = 0; n < 2; ++n) acc[a][b][m][n] = (f32x4){0.f, 0.f, 0.f, 0.f};
        cur = nxt; cA = nA; cB = nB; ++ui;
    }
    PG8_WAIT_V(0);
    if (wr == 0) PG8_BAR;
    PG8_BAR;
    if constexpr (Epi::AFTER_DRAIN) { E.fused(acc, cur, wr, wc, fr, fq, lds, wid, lane); S.done(cur); }
    PG8_STAMP();
    if (STAMP && wid == 0) { stamps[lane] = lane < nts ? (((unsigned long long)(unsigned)ts_hi << 32) | (unsigned)ts_lo) : 0ull;
        if (lane == 62) stamps[62] = rt_entry; if (lane == 63) stamps[63] = (unsigned long long)wall_clock64(); }
#undef PG8_STAMP
#undef PG8_SA
#undef PG8_SB
#undef PG8_STAGE
#undef PG8_LDA
#undef PG8_LDB
#undef PG8_MMA
#undef PG8_WAIT_V
#undef PG8_WAIT_L
#undef PG8_BAR
#undef PG8_SCHED
}
}
#define XB_TMO      128
#define XB_XCNT(j)  (256  + 64 * (j))
#define XB_XSUB(j)  (1280 + 64 * (j))
#define XB_XGEN(j)  (2304 + 64 * (j))
#define XB_TOP      3328
#define XB_TOPGEN   3392
#define XCD_BAR_WORDS 3456
#define XB_SPIN_CAP (1u << 23)
#define LAS __attribute__((address_space(3)))

__device__ __forceinline__ unsigned xb_ld(unsigned* p)              { return __hip_atomic_load(p, __ATOMIC_RELAXED, __HIP_MEMORY_SCOPE_AGENT); }
__device__ __forceinline__ unsigned xb_add(unsigned* p, unsigned v) { return __hip_atomic_fetch_add(p, v, __ATOMIC_RELAXED, __HIP_MEMORY_SCOPE_AGENT); }
__device__ __forceinline__ unsigned xb_xcc_id() { return (unsigned)__builtin_amdgcn_s_getreg((3 << 11) | 20) & 0xFu; }
#define XB_SPIN(cond, bar) do { unsigned _sp = 0; while (cond) { __builtin_amdgcn_s_sleep(1); \
    if ((++_sp & 255u) == 0u) { if (xb_ld(&(bar)[XB_TMO])) break; if (_sp > XB_SPIN_CAP) { atomicAdd(&(bar)[XB_TMO], 1u); break; } } } } while (0)

struct XcdBarrier {
    unsigned* bar; unsigned x;
    volatile LAS unsigned* st;
};

__device__ __forceinline__ XcdBarrier xcd_barrier_post(unsigned* bar, volatile LAS unsigned* st) {
    XcdBarrier b; b.bar = bar; b.x = xb_xcc_id(); b.st = st;
    if (threadIdx.x == 0) (void)xb_add(&bar[XB_XCNT(b.x)], 1u);
    return b;
}
__device__ __forceinline__ void xcd_barrier_complete(unsigned* bar, unsigned x, unsigned& nloc, unsigned& nx) {
    const unsigned G = gridDim.x * gridDim.y * gridDim.z;
    unsigned sum, cnt, mine, sp = 0u;
    for (;;) {
        sum = 0u; cnt = 0u; mine = 0u;
#pragma unroll
        for (unsigned j = 0; j < 16; ++j) { const unsigned c = xb_ld(&bar[XB_XCNT(j)]); sum += c; cnt += (c > 0u) ? 1u : 0u; mine = (j == x) ? c : mine; }
        if (sum == G) break;
        __builtin_amdgcn_s_sleep(1);
        if ((++sp & 255u) == 0u) { if (xb_ld(&bar[XB_TMO])) break; if (sp > XB_SPIN_CAP) { atomicAdd(&bar[XB_TMO], 1u); break; } }
    }
    nloc = mine > 0u ? mine : 1u; nx = cnt > 0u ? cnt : 1u;
}

__device__ __forceinline__ void xcd_barrier(const XcdBarrier& b) {
    asm volatile("s_waitcnt vmcnt(0)" ::: "memory");
    __syncthreads();
    if (threadIdx.x == 0) {
        unsigned* bar = b.bar;
        __builtin_amdgcn_s_waitcnt(0);
        unsigned nloc = b.st[0], nx = b.st[1];
        if (nloc == 0u) { xcd_barrier_complete(bar, b.x, nloc, nx); b.st[0] = nloc; b.st[1] = nx; }
        const unsigned old = xb_add(&bar[XB_XSUB(b.x)], 1u);
        const unsigned gen = old / nloc;
        if (old + 1u == (gen + 1u) * nloc) {
            __builtin_amdgcn_fence(__ATOMIC_RELEASE, "agent");
            asm volatile("s_waitcnt vmcnt(0)" ::: "memory");
            const unsigned og = xb_add(&bar[XB_TOP], 1u);
            const unsigned tg = og / nx;
            if (og + 1u == (tg + 1u) * nx) xb_add(&bar[XB_TOPGEN], 1u);
            else XB_SPIN(xb_ld(&bar[XB_TOPGEN]) == tg, bar);
            __builtin_amdgcn_fence(__ATOMIC_ACQUIRE, "agent");
            xb_add(&bar[XB_XGEN(b.x)], 1u);
            asm volatile("s_waitcnt vmcnt(0)" ::: "memory");
        } else {
            XB_SPIN(xb_ld(&bar[XB_XGEN(b.x)]) == gen, bar);
            __builtin_amdgcn_fence(__ATOMIC_ACQUIRE, "agent");
            asm volatile("s_waitcnt vmcnt(0)" ::: "memory");
        }
    }
    __syncthreads();
}
#endif
DEVFN float block_sum(float v, float* red) {
    red[TID] = v; SYNC();
    for (int s = NTHR >> 1; s > 0; s >>= 1) { if (TID < s) red[TID] += red[TID + s]; SYNC(); }
    const float r = red[0]; SYNC(); return r;
}

DEVFN void tr_weight(const float* W, int K, int N, int NP, act_t* Wt) {
    GSL(i, (long)NP * K) { const int n = (int)(i / K), k = (int)(i % K); Wt[i] = n < N ? to_act(W[(size_t)k * N + n]) : to_act(0.f); }
}
DEVFN void st_prep(const Params& p, float* sm) {
#ifndef CPU_SHIM
    tr_weight(p.w_in, D, PROJ, NPROJ, p.Wt_in); tr_weight(p.w_o, D, D, D, p.Wt_o); tr_weight(p.w_ffn_in, D, 2 * FFN, 2 * FFN, p.Wt_ffi);
    tr_weight(p.w_ffn_out, FFN, D, D, p.Wt_ffo); tr_weight(p.w_ple_gate, D, D, D, p.Wt_pg); tr_weight(p.w_ple, PLE, D, D, p.Wt_ple);
#endif
    USL(m, MPAD) {
        act_t* h = p.H1 + (size_t)m * D; act_t* pb = p.Pbf + (size_t)m * PLE;
        if (m >= M) { BSL(k, D) h[k] = to_act(0.f); BSL(k, PLE) pb[k] = to_act(0.f); continue; }
        const float* x = x_row(p, m);
        float part = 0.f; BSL(k, D) part += x[k] * x[k];
        const float r = rsqrt_f(block_sum(part, sm) / (float)D + RMS_EPS);
        BSL(k, D) h[k] = to_act(x[k] * r * p.g_pre1[k]);
        const float* pl = m < MPR ? p.p_prompt + (size_t)m * PLE : p.p_sample + (size_t)(m - MPR) * PLE;
        BSL(k, PLE) pb[k] = to_act(pl[k]);
    }
    GSL(i, (long)DEC_BATCH * NCS * KV2) {
        const int c = (int)(i % KV2), n = (int)((i / KV2) % NCS), bs = (int)(i / ((long)KV2 * NCS));
        float acc = 0.f;
        for (int cc = 0; cc < 32; ++cc) { const int pos = 32 * n + cc;
            acc += p.cache_cmp[((size_t)p.page_table[bs * N_PAGES + pos / PAGE] * PAGE + pos % PAGE) * KV2 + c] * p.w_cmp[cc * KV2 + c]; }
        p.KVCs[i] = acc;
    }
}

DEVFN float conv_tap(const Params& p, int m, int j, int c) {
    if (m < MPR) { const int b = m / SEQ, tt = m % SEQ + j - 3; return tt >= 0 ? p.Z[(size_t)(b * SEQ + tt) * NPROJ + C_QKV + c] : 0.f; }
    const int bs = (m - MPR) / DEC_SEQ, tt = (m - MPR) % DEC_SEQ + j - 3;
    return tt >= 0 ? p.Z[(size_t)(MPR + bs * DEC_SEQ + tt) * NPROJ + C_QKV + c] : p.state_conv[(size_t)(bs * 3 + tt + 3) * (3 * GW) + c];
}
DEVFN void st_post_inproj(const Params& p) {
    GSL(i, (long)M * KV2) { const int c = (int)(i % KV2), m = (int)(i / KV2);
        const float vc = p.Z[(size_t)m * NPROJ + C_CMP + c], vs = p.Z[(size_t)m * NPROJ + C_SEL + c];
        if (m < MPR) { p.out[O_CMPP + i] = vc; p.out[O_SELP + i] = vs; } else { const long o = i - (long)MPR * KV2; p.out[O_CMPS + o] = vc; p.out[O_SELS + o] = vs; } }
    GSL(i, (long)BATCH * WINBUF * KV2) { const int c = (int)(i % KV2), j = (int)((i / KV2) % WINBUF), b = (int)(i / ((long)KV2 * WINBUF));
        p.out[O_WINP + i] = p.Z[(size_t)(b * SEQ + SEQ - WINBUF + j) * NPROJ + C_WIN + c]; }
    GSL(i, (long)DEC_BATCH * WINBUF * KV2) { const int c = (int)(i % KV2), j = (int)((i / KV2) % WINBUF), bs = (int)(i / ((long)KV2 * WINBUF));
        const int jj = j + DEC_SEQ;
        p.out[O_WINS + i] = jj < WINBUF ? p.state_win[((size_t)bs * WINBUF + jj) * KV2 + c] : p.Z[(size_t)(MPR + bs * DEC_SEQ + jj - WINBUF) * NPROJ + C_WIN + c]; }
    GSL(i, (long)BATCH * 3 * 3 * GW) { const int c = (int)(i % (3 * GW)), j = (int)((i / (3 * GW)) % 3), b = (int)(i / (9L * GW));
        p.out[O_CONVP + i] = p.Z[(size_t)(b * SEQ + SEQ - 3 + j) * NPROJ + C_QKV + c]; }
    GSL(i, (long)DEC_BATCH * 3 * 3 * GW) { const int c = (int)(i % (3 * GW)), j = (int)((i / (3 * GW)) % 3), bs = (int)(i / (9L * GW));
        p.out[O_CONVS + i] = p.Z[(size_t)(MPR + bs * DEC_SEQ + DEC_SEQ - 3 + j) * NPROJ + C_QKV + c]; }
    GSL(i, (long)M * 3 * GH) { const int h = (int)(i % GH), part = (int)((i / GH) % 3), m = (int)(i / (3 * GH));
        float* dst = p.QKVc + (size_t)m * 3 * GW + part * GW + h * HD; float ss = 0.f;
        for (int d = 0; d < HD; ++d) { const int c = part * GW + h * HD + d; float a = 0.f;
            for (int j = 0; j < 4; ++j) a += conv_tap(p, m, j, c) * p.conv_w[(size_t)j * 3 * GW + c];
            const float v = silu_f(a); dst[d] = v; ss += v * v; }
        if (part < 2) { const float r = rsqrt_f(ss + RMS_EPS) * (part == 0 ? QSCALE : 1.0f); for (int d = 0; d < HD; ++d) dst[d] *= r; } }
    GSL(i, (long)M * GH) { const int h = (int)(i % GH), m = (int)(i / GH);
        p.GB[(size_t)m * 2 * GH + h] = -expf(p.A_log[h]) * softplus_f(p.Z[(size_t)m * NPROJ + C_A + h] + p.dt_bias[h]);
        p.GB[(size_t)m * 2 * GH + GH + h] = sigmoid_f(p.Z[(size_t)m * NPROJ + C_B + h]); }
    GSL(i, (long)BATCH * NCP * KV2) { const int c = (int)(i % KV2), n = (int)((i / KV2) % NCP), b = (int)(i / ((long)KV2 * NCP)); float acc = 0.f;
        for (int cc = 0; cc < 32; ++cc) acc += p.Z[(size_t)(b * SEQ + 32 * n + cc) * NPROJ + C_CMP + c] * p.w_cmp[cc * KV2 + c];
        p.KVCp[i] = acc; }
}

DEVFN void st_gdn_naive(const Params& p) {
    GSL(item, (long)(BATCH + DEC_BATCH) * GH * HD) {
        const int v = (int)(item % HD), h = (int)((item / HD) % GH), s = (int)(item / (HD * GH));
        float S[HD]; int m0, T; float* sout;
        if (s < BATCH) { m0 = s * SEQ; T = SEQ; sout = p.out + O_GDNP + ((size_t)(s * GH + h) * HD) * HD + v;
#pragma unroll
            for (int k = 0; k < HD; ++k) S[k] = 0.f; }
        else { const int bs = s - BATCH; m0 = MPR + bs * DEC_SEQ; T = DEC_SEQ; sout = p.out + O_GDNS + ((size_t)(bs * GH + h) * HD) * HD + v;
#pragma unroll
            for (int k = 0; k < HD; ++k) S[k] = p.state_gdn[((size_t)(bs * GH + h) * HD + k) * HD + v]; }
        for (int t = 0; t < T; ++t) { const int m = UNIFORM(m0 + t); const int hu = UNIFORM(h);
            const float* q = p.QKVc + (size_t)m * 3 * GW + hu * HD; const float* kk = q + GW; const float vv = q[2 * GW + v];
            const float eg = expf(p.GB[(size_t)m * 2 * GH + hu]), beta = p.GB[(size_t)m * 2 * GH + GH + hu];
            float dot = 0.f;
#pragma unroll
            for (int c = 0; c < HD / 16; ++c) {
#pragma unroll
                for (int k = 0; k < 16; ++k) dot += S[c * 16 + k] * kk[c * 16 + k];
                CFENCE(); }
            const float vn = beta * (vv - eg * dot); float o = 0.f;
#pragma unroll
            for (int c = 0; c < HD / 16; ++c) {
#pragma unroll
                for (int k = 0; k < 16; ++k) { S[c * 16 + k] = eg * S[c * 16 + k] + kk[c * 16 + k] * vn; o += S[c * 16 + k] * q[c * 16 + k]; }
                CFENCE(); }
            p.OA[(size_t)m * GW + h * HD + v] = o; }
#pragma unroll
        for (int k = 0; k < HD; ++k) sout[(size_t)k * HD] = S[k];
    }
}

constexpr int SCW = 1024;
static_assert(NCP <= SCW && NCS <= SCW && WINDOW <= SCW, "score buffer");
constexpr int NSMAX = NSP > NSS ? NSP : NSS;
DEVFN const float* sel_row(const Params& p, bool smp, int b, int kpos, int x, int g) {
    if (!smp) return p.Z + (size_t)(b * SEQ + kpos) * NPROJ + C_SEL + x * KVW + g * HD;
    if (kpos < PAST) return p.cache_sel + ((size_t)p.page_table[b * N_PAGES + kpos / PAGE] * PAGE + kpos % PAGE) * KV2 + x * KVW + g * HD;
    return p.Z + (size_t)(MPR + b * DEC_SEQ + kpos - PAST) * NPROJ + C_SEL + x * KVW + g * HD;
}
DEVFN const float* win_row(const Params& p, bool smp, int b, int wpos, int x, int g) {
    if (!smp) return p.Z + (size_t)(b * SEQ + wpos) * NPROJ + C_WIN + x * KVW + g * HD;
    if (wpos < PAST) return p.state_win + ((size_t)b * WINBUF + (wpos - (PAST - WINBUF))) * KV2 + x * KVW + g * HD;
    return p.Z + (size_t)(MPR + b * DEC_SEQ + wpos - PAST) * NPROJ + C_WIN + x * KVW + g * HD;
}
DEVFN void nsa_softmax(float* ssc, float* sstat, int n) {
    BSL(r, 4) { float mx = -3.0e38f; for (int i = 0; i < n; ++i) mx = fmaxf(mx, ssc[r * SCW + i]);
        if (mx < -1e29f) { sstat[r] = 0.f; sstat[4 + r] = 0.f; }
        else { float sum = 0.f; for (int i = 0; i < n; ++i) { const float s = ssc[r * SCW + i]; if (s > -1e29f) sum += expf(s - mx); } sstat[r] = mx; sstat[4 + r] = 1.0f / sum; } }
    SYNC();
    BSL(i, 4 * n) { const int r = i / n, ii = i % n; const float s = ssc[r * SCW + ii]; ssc[r * SCW + ii] = s > -1e29f ? expf(s - sstat[r]) * sstat[4 + r] : 0.f; }
    SYNC();
}
DEVFN void st_nsa_naive(const Params& p, float* sm) {
    float* sq = sm; float* sgate = sq + 4 * HD; float* so = sgate + 16; float* sstat = so + 4 * HD; float* sscore = sstat + 16; int* sidx = (int*)(sscore + ((NSMAX + 15) / 16) * 16);
    float* ssc = (float*)(sidx + 16);
    USL(u, M * NKV) {
        const int m = u / NKV, g = u % NKV; const bool smp = m >= MPR;
        const int b = smp ? (m - MPR) / DEC_SEQ : m / SEQ, tpos = smp ? PAST + (m - MPR) % DEC_SEQ : m % SEQ;
        const int NC = smp ? NCS : NCP, NS = smp ? NSS : NSP, ksel = smp ? KSEL_S : KSEL_P;
        const float* kvc = smp ? p.KVCs + (size_t)b * NCS * KV2 : p.KVCp + (size_t)b * NCP * KV2;
        BSL(i, 4 * HD) sq[i] = p.Z[(size_t)m * NPROJ + C_QN + g * 4 * HD + i] * QSCALE;
        BSL(i, 12) sgate[i] = sigmoid_f(p.Z[(size_t)m * NPROJ + C_GN + g * 12 + i]);
        SYNC();
        BSL(i, 4 * NC) { const int r = i / NC, n = i % NC, cend = 32 * n + 31; float s = NEG_INF;
            if (tpos >= cend) { const float* kr = kvc + (size_t)n * KV2 + g * HD; float a = 0.f; for (int d = 0; d < HD; ++d) a += sq[r * HD + d] * kr[d];
                s = a - exp2_f(-8.0f * (float)(g * 4 + r + 1) / (float)NH) * (float)(tpos - cend); }
            ssc[r * SCW + n] = s; }
        SYNC();
        nsa_softmax(ssc, sstat, NC);
        BSL(i, 4 * HD) { const int r = i / HD, d = i % HD; float a = 0.f;
            for (int n = 0; n < NC; ++n) { const float pr = ssc[r * SCW + n]; if (pr != 0.f) a += pr * kvc[(size_t)n * KV2 + KVW + g * HD + d]; }
            so[i] = sgate[r * 3 + 0] * a; }
        BSL(j, NS) { float imp = 0.f;
            for (int r = 0; r < 4; ++r) { if (2 * j < NC) imp += ssc[r * SCW + 2 * j]; if (2 * j + 1 < NC) imp += ssc[r * SCW + 2 * j + 1]; }
            const int cur = tpos / 64; const bool forced = (j == 0) || (j == cur) || (j == cur - 1), avail = j * 64 <= tpos;
            sscore[j] = forced ? imp + FORCE_BONUS : (avail ? imp : -1.0f); }
        SYNC();
        if (TID == 0) for (int kk = 0; kk < ksel; ++kk) { int best = 0; float bv = -3.0e38f;
            for (int j = 0; j < NS; ++j) if (sscore[j] > bv) { bv = sscore[j]; best = j; }
            sidx[kk] = best; sscore[best] = -3.0e38f; }
        SYNC();
        BSL(i, 4 * ksel * 64) { const int r = i / (ksel * 64), kk = i % (ksel * 64), kpos = sidx[kk / 64] * 64 + kk % 64; float s = NEG_INF;
            if (kpos <= tpos) { const float* kr = sel_row(p, smp, b, kpos, 0, g); float a = 0.f; for (int d = 0; d < HD; ++d) a += sq[r * HD + d] * kr[d];
                s = a - exp2_f(-8.0f * (float)(g * 4 + r + 1) / (float)NH) * (float)(tpos - kpos); }
            ssc[r * SCW + kk] = s; }
        SYNC();
        nsa_softmax(ssc, sstat, ksel * 64);
        BSL(i, 4 * HD) { const int r = i / HD, d = i % HD; float a = 0.f;
            for (int kk = 0; kk < ksel * 64; ++kk) { const float pr = ssc[r * SCW + kk]; if (pr != 0.f) a += pr * sel_row(p, smp, b, sidx[kk / 64] * 64 + kk % 64, 1, g)[d]; }
            so[i] += sgate[r * 3 + 1] * a; }
        SYNC();
        const int wmin = smp ? PAST - WINBUF : 0;
        BSL(i, 4 * WINDOW) { const int r = i / WINDOW, kk = i % WINDOW, wpos = tpos - (WINDOW - 1) + kk; float s = NEG_INF;
            if (wpos >= wmin) { const float* kr = win_row(p, smp, b, wpos, 0, g); float a = 0.f; for (int d = 0; d < HD; ++d) a += sq[r * HD + d] * kr[d];
                s = a - exp2_f(-8.0f * (float)(g * 4 + r + 1) / (float)NH) * (float)(tpos - wpos); }
            ssc[r * SCW + kk] = s; }
        SYNC();
        nsa_softmax(ssc, sstat, WINDOW);
        BSL(i, 4 * HD) { const int r = i / HD, d = i % HD; float a = 0.f;
            for (int kk = 0; kk < WINDOW; ++kk) { const float pr = ssc[r * SCW + kk]; if (pr != 0.f) a += pr * win_row(p, smp, b, tpos - (WINDOW - 1) + kk, 1, g)[d]; }
            p.On[(size_t)m * NSAW + g * 4 * HD + i] = so[i] + sgate[r * 3 + 2] * a; }
        SYNC();
    }
}

DEVFN void st_merge(const Params& p) {
    GSL(i, (long)MPAD * GH) { const int h = (int)(i % GH), m = (int)(i / GH); act_t* dst = p.MIX + (size_t)m * D + h * HD;
        if (m >= M) { for (int d = 0; d < HD; ++d) dst[d] = to_act(0.f); continue; }
        const float* o = p.OA + (size_t)m * GW + h * HD; float ss = 0.f;
        for (int d = 0; d < HD; ++d) ss += o[d] * o[d];
        const float r = rsqrt_f(ss / (float)HD + RMS_EPS); const float* z = p.Z + (size_t)m * NPROJ;
        for (int d = 0; d < HD; ++d) { const int c = h * HD + d;
            const float oa = o[d] * r * p.gdn_norm_w[d] * silu_f(z[C_Z + c]);
            dst[d] = to_act(sigmoid_f(z[C_GM + c]) * oa + sigmoid_f(z[C_GM + D + c]) * p.On[(size_t)m * NSAW + c]); } }
}
DEVFN void st_norm1(const Params& p, float* sm) {
    USL(m, MPAD) { act_t* h2 = p.H2 + (size_t)m * D;
        if (m >= M) { BSL(k, D) h2[k] = to_act(0.f); continue; }
        const float* t1 = p.T1 + (size_t)m * D; const float* x = x_row(p, m); float* x1 = p.X1 + (size_t)m * D;
        float part = 0.f; BSL(k, D) part += t1[k] * t1[k];
        const float r1 = rsqrt_f(block_sum(part, sm) / (float)D + RMS_EPS);
        part = 0.f; BSL(k, D) { const float v = x[k] + t1[k] * r1 * p.g_post1[k]; x1[k] = v; part += v * v; }
        const float r2 = rsqrt_f(block_sum(part, sm) / (float)D + RMS_EPS);
        BSL(k, D) h2[k] = to_act(x1[k] * r2 * p.g_pre2[k]); }
}
DEVFN void st_act(const Params& p) {
    GSL(i, (long)MPAD * FFN) { const int j = (int)(i % FFN), m = (int)(i / FFN);
        p.ACT[i] = m < M ? to_act(silu_f(p.FF[(size_t)m * 2 * FFN + j]) * p.FF[(size_t)m * 2 * FFN + FFN + j]) : to_act(0.f); }
}
DEVFN void st_norm2(const Params& p, float* sm) {
    USL(m, MPAD) { act_t* xb = p.X2b + (size_t)m * D;
        if (m >= M) { BSL(k, D) xb[k] = to_act(0.f); continue; }
        const float* t2 = p.T2 + (size_t)m * D; const float* x1 = p.X1 + (size_t)m * D; float* x2 = p.X2 + (size_t)m * D;
        float part = 0.f; BSL(k, D) part += t2[k] * t2[k];
        const float r = rsqrt_f(block_sum(part, sm) / (float)D + RMS_EPS);
        BSL(k, D) { const float v = x1[k] + t2[k] * r * p.g_post2[k]; x2[k] = v; xb[k] = to_act(v); } }
}
DEVFN void st_final(const Params& p) {
    GSL(i, (long)M * D) { const int m = (int)(i / D);
        const float y = p.X2[i] + sigmoid_f(p.G[i]) * p.PL[i];
        if (m < MPR) p.out[O_YP + i] = y; else p.out[O_YS + (i - (long)MPR * D)] = y; }
}
constexpr int N_PHASES = 13;
#ifndef MK_N_LAUNCHES
#define MK_N_LAUNCHES 1
#endif
struct WsMap { size_t off; template <class T> T* take(unsigned char* base, size_t n) { T* r = (T*)(base + off); off += ((n * sizeof(T) + 255) / 256) * 256; return r; } };
constexpr size_t CTL_BYTES = 65536;
static size_t carve(Params& p, unsigned char* ws) {
    WsMap w{0};
    p.ctl = w.take<unsigned>(ws, CTL_BYTES / 4);
    p.Wt_in = w.take<act_t>(ws, (size_t)NPROJ * D); p.Wt_o = w.take<act_t>(ws, (size_t)D * D); p.Wt_ffi = w.take<act_t>(ws, (size_t)2 * FFN * D);
    p.Wt_ffo = w.take<act_t>(ws, (size_t)D * FFN); p.Wt_pg = w.take<act_t>(ws, (size_t)D * D); p.Wt_ple = w.take<act_t>(ws, (size_t)D * PLE);
    p.H1 = w.take<act_t>(ws, (size_t)MPAD * D); p.Pbf = w.take<act_t>(ws, (size_t)MPAD * PLE); p.MIX = w.take<act_t>(ws, (size_t)MPAD * D);
    p.H2 = w.take<act_t>(ws, (size_t)MPAD * D); p.ACT = w.take<act_t>(ws, (size_t)MPAD * FFN); p.X2b = w.take<act_t>(ws, (size_t)MPAD * D);
    p.Z = w.take<float>(ws, (size_t)MPAD * NPROJ); p.QKVc = w.take<float>(ws, (size_t)M * 3 * GW); p.GB = w.take<float>(ws, (size_t)M * 2 * GH);
    p.OA = w.take<float>(ws, (size_t)M * GW); p.KVCp = w.take<float>(ws, (size_t)BATCH * NCP * KV2); p.KVCs = w.take<float>(ws, (size_t)DEC_BATCH * NCS * KV2);
    p.On = w.take<float>(ws, (size_t)M * NSAW); p.T1 = w.take<float>(ws, (size_t)MPAD * D); p.X1 = w.take<float>(ws, (size_t)M * D);
    p.FF = w.take<float>(ws, (size_t)MPAD * 2 * FFN); p.T2 = w.take<float>(ws, (size_t)MPAD * D); p.X2 = w.take<float>(ws, (size_t)M * D);
    p.G = w.take<float>(ws, (size_t)MPAD * D); p.PL = w.take<float>(ws, (size_t)MPAD * D);
    return w.off;
}
static void fill_inputs(Params& p, void* const* d_in, void* d_out) {
    p.x_prompt = (const float*)d_in[0]; p.x_sample = (const float*)d_in[1]; p.cache_cmp = (const float*)d_in[2]; p.cache_sel = (const float*)d_in[3];
    p.page_table = (const int*)d_in[4]; p.state_win = (const float*)d_in[5]; p.state_gdn = (const float*)d_in[6]; p.state_conv = (const float*)d_in[7];
    p.p_prompt = (const float*)d_in[8]; p.p_sample = (const float*)d_in[9]; p.g_pre1 = (const float*)d_in[10]; p.w_in = (const float*)d_in[11];
    p.conv_w = (const float*)d_in[12]; p.A_log = (const float*)d_in[13]; p.dt_bias = (const float*)d_in[14]; p.gdn_norm_w = (const float*)d_in[15];
    p.w_cmp = (const float*)d_in[16]; p.w_o = (const float*)d_in[17]; p.g_post1 = (const float*)d_in[18]; p.g_pre2 = (const float*)d_in[19];
    p.w_ffn_in = (const float*)d_in[20]; p.w_ffn_out = (const float*)d_in[21]; p.g_post2 = (const float*)d_in[22]; p.w_ple = (const float*)d_in[23];
    p.w_ple_gate = (const float*)d_in[24]; p.out = (float*)d_out;
}

#ifndef CPU_SHIM
constexpr int LDS_BYTES = pg8::STAGE_BYTES + 16384;
constexpr int MISC_OFF = pg8::STAGE_BYTES;
template <class Epi> __device__ __forceinline__ void run_gemm(PG8_LAS unsigned char* lds, const bf16_t* A, const bf16_t* Bt, int Mr, int N, int K, const Epi& E) {
    pg8::Gemm g{A, Bt, Mr, N, K}; pg8::StaticOrder S; S.init(Mr, N, (int)gridDim.x, (int)blockIdx.x);
    pg8::gemm_phase<Epi, pg8::StaticOrder, false>(lds, g, S, E, nullptr);
}
__global__ void __launch_bounds__(512, 2) fwd(Params p) {
    extern __shared__ __attribute__((aligned(16))) unsigned char lds_raw[];
    PG8_LAS unsigned char* lds = (PG8_LAS unsigned char*)lds_raw;
    float* sm = (float*)lds_raw;
    volatile LAS unsigned* misc = (volatile LAS unsigned*)(lds + MISC_OFF);
    if (threadIdx.x < 4) misc[threadIdx.x] = 0u;
    __syncthreads();
    XcdBarrier bar = xcd_barrier_post(p.ctl, misc);
    const int lo = p.ph_lo, hi = p.ph_hi;
#define IN(k) (lo <= (k) && (k) < hi)
#define SEAM(k) do { if (IN(k) && IN((k) + 1)) xcd_barrier(bar); } while (0)
    if (IN(0)) { st_prep(p, sm); } SEAM(0);
    if (IN(1)) { run_gemm(lds, p.H1, p.Wt_in, MPAD, NPROJ, D, pg8::EpiF32{p.Z, NPROJ, nullptr}); } SEAM(1);
    if (IN(2)) { st_post_inproj(p); } SEAM(2);
    if (IN(3)) { st_gdn_naive(p); st_nsa_naive(p, sm); } SEAM(3);
    if (IN(4)) { st_merge(p); } SEAM(4);
    if (IN(5)) { run_gemm(lds, p.MIX, p.Wt_o, MPAD, D, D, pg8::EpiF32{p.T1, D, nullptr}); __syncthreads();
                 run_gemm(lds, p.Pbf, p.Wt_ple, MPAD, D, PLE, pg8::EpiF32{p.PL, D, nullptr}); } SEAM(5);
    if (IN(6)) { st_norm1(p, sm); } SEAM(6);
    if (IN(7)) { run_gemm(lds, p.H2, p.Wt_ffi, MPAD, 2 * FFN, D, pg8::EpiF32{p.FF, 2 * FFN, nullptr}); } SEAM(7);
    if (IN(8)) { st_act(p); } SEAM(8);
    if (IN(9)) { run_gemm(lds, p.ACT, p.Wt_ffo, MPAD, D, FFN, pg8::EpiF32{p.T2, D, nullptr}); } SEAM(9);
    if (IN(10)) { st_norm2(p, sm); } SEAM(10);
    if (IN(11)) { run_gemm(lds, p.X2b, p.Wt_pg, MPAD, D, D, pg8::EpiF32{p.G, D, nullptr}); } SEAM(11);
    if (IN(12)) { st_final(p); }
#undef IN
#undef SEAM
}

extern "C" void kernel_launch(void* const* d_in, const int* in_sizes, int n_in, void* d_out, int out_size, void* d_ws, size_t ws_size, hipStream_t stream) {
    static int grid = 0;
    Params p; memset(&p, 0, sizeof(p));
    const size_t need = carve(p, (unsigned char*)d_ws);
    if (grid == 0) {
        if (n_in != 25 || (long)out_size != O_END || ws_size < need) { fprintf(stderr, "kernel_launch: shape mismatch (n_in %d out %d ws %zu need %zu)\n", n_in, out_size, ws_size, need); grid = -1; return; }
        int dev = 0, cus = 0, per_cu = 0;
        if (hipGetDevice(&dev) != hipSuccess || hipDeviceGetAttribute(&cus, hipDeviceAttributeMultiprocessorCount, dev) != hipSuccess) { grid = -1; return; }
        if (hipFuncSetAttribute((const void*)fwd, hipFuncAttributeMaxDynamicSharedMemorySize, LDS_BYTES) != hipSuccess) { fprintf(stderr, "kernel_launch: hipFuncSetAttribute failed\n"); grid = -1; return; }
        if (hipOccupancyMaxActiveBlocksPerMultiprocessor(&per_cu, (const void*)fwd, 512, LDS_BYTES) != hipSuccess || per_cu < 1) fprintf(stderr, "kernel_launch: occupancy query says %d\n", per_cu);
        (void)hipGetLastError();
        grid = cus;
    }
    if (grid < 0) return;
    fill_inputs(p, d_in, d_out);
    (void)hipMemsetAsync(p.ctl, 0, CTL_BYTES, stream);
#if MK_N_LAUNCHES == 1
    p.ph_lo = 0; p.ph_hi = N_PHASES;
    hipLaunchKernelGGL(fwd, dim3(grid), dim3(512), LDS_BYTES, stream, p);
#else
    for (int k = 0; k < N_PHASES; ++k) { p.ph_lo = k; p.ph_hi = k + 1; hipLaunchKernelGGL(fwd, dim3(grid), dim3(512), LDS_BYTES, stream, p); }
#endif
    const hipError_t le = hipPeekAtLastError();
    if (le != hipSuccess) fprintf(stderr, "kernel_launch: launch failed: %s\n", hipGetErrorName(le));
}
#else
#include <omp.h>
static void cpu_gemm(const act_t* A, int lda, const float* W, int K, int N, float* C, int ldc, int rows) {
#pragma omp parallel for schedule(dynamic, 4)
    for (int m = 0; m < rows; ++m) { float* c = C + (size_t)m * ldc; for (int n = 0; n < N; ++n) c[n] = 0.f;
        for (int k = 0; k < K; ++k) { const float a = A[(size_t)m * lda + k]; const float* w = W + (size_t)k * N; for (int n = 0; n < N; ++n) c[n] += a * w[n]; } }
}
template <class F> static void par(F f) {
#pragma omp parallel
    { g_bid = omp_get_thread_num(); g_nblk = omp_get_num_threads(); static thread_local float smbuf[16384]; f(smbuf); }
}
static void run_all_cpu(Params& p) {
    par([&](float* sm) { st_prep(p, sm); });
    cpu_gemm(p.H1, D, p.w_in, D, PROJ, p.Z, NPROJ, M);
    par([&](float*) { st_post_inproj(p); });
    par([&](float* sm) { st_gdn_naive(p); st_nsa_naive(p, sm); });
    par([&](float*) { st_merge(p); });
    cpu_gemm(p.MIX, D, p.w_o, D, D, p.T1, D, M); cpu_gemm(p.Pbf, PLE, p.w_ple, PLE, D, p.PL, D, M);
    par([&](float* sm) { st_norm1(p, sm); });
    cpu_gemm(p.H2, D, p.w_ffn_in, D, 2 * FFN, p.FF, 2 * FFN, M);
    par([&](float*) { st_act(p); });
    cpu_gemm(p.ACT, FFN, p.w_ffn_out, FFN, D, p.T2, D, M);
    par([&](float* sm) { st_norm2(p, sm); });
    cpu_gemm(p.X2b, D, p.w_ple_gate, D, D, p.G, D, M);
    par([&](float*) { st_final(p); });
}
#endif
```

```cpp
#ifndef CPU_SHIM
#include <hip/hip_runtime.h>
#endif
#include <cstdio>
#include <cstdint>
#include <cstring>
#include <cmath>

#ifndef CFG_D_MODEL
#define CFG_D_MODEL 2048
#define CFG_BATCH 2
#define CFG_SEQ 4096
#define CFG_DEC_BATCH 8
#define CFG_PAST_LEN 16384
#endif
#ifndef DUP_PHASE
#define DUP_PHASE -1
#endif
#ifndef STAGGER_US
#define STAGGER_US 0
#endif
namespace cfg {
constexpr int D = CFG_D_MODEL, BATCH = CFG_BATCH, SEQ = CFG_SEQ, DEC_BATCH = CFG_DEC_BATCH, DEC_SEQ = 4, PAST = CFG_PAST_LEN, PAGE = 128;
constexpr int HD = 128, GH = D / HD, GW = GH * HD, NH = D / HD, NKV = NH / 4, NSAW = NH * HD, KVW = NKV * HD, KV2 = 2 * KVW;
constexpr int FFN = ((8 * D + 3 * 256 - 1) / (3 * 256)) * 256, PLE = 256, WINDOW = 512, WINBUF = (WINDOW < PAST ? WINDOW : PAST);
constexpr int C_QKV = 0, C_Z = 3 * GW, C_A = 4 * GW, C_B = C_A + GH, C_QN = C_B + GH, C_CMP = C_QN + NSAW, C_SEL = C_CMP + KV2, C_WIN = C_SEL + KV2,
              C_GN = C_WIN + KV2, C_GM = C_GN + 3 * NH, PROJ = C_GM + 2 * D;
constexpr int NPROJ = ((PROJ + 255) / 256) * 256;
constexpr int N_PAGES = PAST / PAGE, USED = DEC_BATCH * N_PAGES, N_POOL = USED + (USED / 4 > 1 ? USED / 4 : 1);
constexpr int MPR = BATCH * SEQ, MSA = DEC_BATCH * DEC_SEQ, M = MPR + MSA, MPAD = ((M + 255) / 256) * 256;
constexpr int NCP = SEQ / 32, NSP = (SEQ + 63) / 64;
constexpr int TKS = PAST + DEC_SEQ, NCS = TKS / 32, NSS = (TKS + 63) / 64;
constexpr int KSEL_P = NSP < 16 ? NSP : 16, KSEL_S = NSS < 16 ? NSS : 16;
static_assert(SEQ % 64 == 0 && SEQ >= WINDOW && PAST % 128 == 0 && PAST >= WINDOW && D % 256 == 0, "shape assumptions");
constexpr long O_YP = 0, O_YS = O_YP + (long)MPR * D, O_CMPP = O_YS + (long)MSA * D, O_SELP = O_CMPP + (long)MPR * KV2, O_WINP = O_SELP + (long)MPR * KV2,
               O_GDNP = O_WINP + (long)BATCH * WINBUF * KV2, O_CONVP = O_GDNP + (long)BATCH * GH * HD * HD, O_CMPS = O_CONVP + (long)BATCH * 3 * 3 * GW,
               O_SELS = O_CMPS + (long)MSA * KV2, O_WINS = O_SELS + (long)MSA * KV2, O_GDNS = O_WINS + (long)DEC_BATCH * WINBUF * KV2,
               O_CONVS = O_GDNS + (long)DEC_BATCH * GH * HD * HD, O_END = O_CONVS + (long)DEC_BATCH * 3 * 3 * GW;
constexpr int KN2_W = 24576;
constexpr float RMS_EPS = 1e-6f, NEG_INF = -1e30f, FORCE_BONUS = 5.0f, QSCALE = 0.08838834764831845f;
}
using namespace cfg;

typedef unsigned short bf16_t;
#ifdef CPU_SHIM
typedef float act_t;
#else
typedef bf16_t act_t;
#endif

#ifdef CPU_SHIM
static thread_local int g_bid = 0, g_nblk = 1;
#define BID g_bid
#define NBLK g_nblk
#define TID 0
#define NTHR 1
#define SYNC() do {} while (0)
#define CFENCE() do {} while (0)
#define UNIFORM(x) (x)
#define DEVFN static inline
#define DEVFN_M inline
#define LDSP
static inline float rsqrt_f(float x) { return 1.0f / sqrtf(x); }
static inline float exp2_f(float x) { return exp2f(x); }
#else
#define BID ((int)blockIdx.x)
#define NBLK ((int)gridDim.x)
__device__ __forceinline__ int tid_now() { int t = (int)threadIdx.x; asm volatile("" : "+v"(t)); return t; }
#define TID tid_now()
#define NTHR ((int)blockDim.x)
#define SYNC() __syncthreads()
#define CFENCE() asm volatile("" ::: "memory")
#define UNIFORM(x) __builtin_amdgcn_readfirstlane(x)
#define DEVFN __device__ __forceinline__
#define DEVFN_M __host__ __device__ __forceinline__
#define LDSP
__device__ __forceinline__ float rsqrt_f(float x) { return 1.0f / sqrtf(x); }
__device__ __forceinline__ float exp2_f(float x) { return exp2f(x); }
#endif
#define GSL(i, n) for (long i = (long)BID * NTHR + TID; i < (long)(n); i += (long)NBLK * NTHR)
#define BSL(i, n) for (int i = TID; i < (int)(n); i += NTHR)
#define USL(u, n) for (int u = BID; u < (int)(n); u += NBLK)

DEVFN float sigmoid_f(float x) { return 1.0f / (1.0f + expf(-x)); }
DEVFN float silu_f(float x) { return x / (1.0f + expf(-x)); }
DEVFN float softplus_f(float x) { return fmaxf(x, 0.0f) + log1pf(expf(-fabsf(x))); }
DEVFN bf16_t f2bf(float f) { unsigned u; memcpy(&u, &f, 4); u += 0x7FFFu + ((u >> 16) & 1u); return (bf16_t)(u >> 16); }
DEVFN float bf2f(bf16_t b) { unsigned u = ((unsigned)b) << 16; float f; memcpy(&f, &u, 4); return f; }
#ifdef CPU_SHIM
DEVFN act_t to_act(float f) { return f; }
DEVFN float from_act(act_t a) { return a; }
#else
DEVFN act_t to_act(float f) { return f2bf(f); }
DEVFN float from_act(act_t a) { return bf2f(a); }
#endif

constexpr size_t CTL_BYTES = 131072, NCHUNKS = (size_t)BATCH * GH * (SEQ / 64);
#ifdef CPU_SHIM
constexpr size_t CPU_ONLY = 1;
#else
constexpr size_t CPU_ONLY = 0;
#endif
constexpr size_t ws_al(size_t x) { return (x + 255) / 256 * 256; }
struct WsLayout { size_t T1b, T2b, PLb, RXS, QKVb, ZAs, GMs, SMf, ctl, Wt_in, Wt_o, Wt_ffi, Wt_ffo, Wt_pg, Wt_ple, H1, Pbf, MIX, H2, ACT, X2b, Z, QKVc, GB, OA, KVCp, KVCs, On, T1, X1, FF, T2, X2, G, PL, GNW, GQG, GKD, GQK, GU, GEL, QN, SELK, SELV, WINK, WINV, CMPK, CMPV, end; };
constexpr WsLayout make_ws_layout() { WsLayout L{}; size_t o = 0;
    L.ctl = o; o += ws_al(sizeof(unsigned) * (CTL_BYTES / 4));
    L.QKVb = o; o += ws_al(sizeof(bf16_t) * ((size_t)MPAD * 3 * GW)); L.ZAs = o; o += ws_al(sizeof(bf16_t) * ((size_t)MPAD * GW));
    L.GMs = o; o += ws_al(sizeof(bf16_t) * ((size_t)MPAD * 2 * D)); L.SMf = o; o += ws_al(sizeof(float) * ((size_t)MPAD * 128));
    L.Wt_in = o; o += ws_al(sizeof(act_t) * ((size_t)NPROJ * D));
    L.Wt_o = o; o += ws_al(sizeof(act_t) * ((size_t)D * D));
    L.Wt_ffi = o; o += ws_al(sizeof(act_t) * ((size_t)2 * FFN * D));
    L.Wt_ffo = o; o += ws_al(sizeof(act_t) * ((size_t)D * FFN));
    L.Wt_pg = o; o += ws_al(sizeof(act_t) * ((size_t)D * D));
    L.Wt_ple = o; o += ws_al(sizeof(act_t) * ((size_t)D * PLE));
    L.H1 = o; o += ws_al(sizeof(act_t) * ((size_t)MPAD * D));
    L.Pbf = o; o += ws_al(sizeof(act_t) * ((size_t)MPAD * PLE));
    L.MIX = o; o += ws_al(sizeof(act_t) * ((size_t)MPAD * D));
    L.H2 = o; o += ws_al(sizeof(act_t) * ((size_t)MPAD * D));
    L.ACT = o; o += ws_al(sizeof(act_t) * ((size_t)MPAD * FFN));
    L.X2b = o; o += ws_al(sizeof(act_t) * ((size_t)MPAD * D));
    L.Z = o; o += ws_al(sizeof(float) * ((size_t)MPAD * NPROJ) * CPU_ONLY);
    L.QKVc = o; o += ws_al(sizeof(float) * ((size_t)(CPU_ONLY ? M : MSA) * 3 * GW));
    L.GB = o; o += ws_al(sizeof(float) * ((size_t)M * 2 * GH));
    L.OA = o; o += ws_al(sizeof(float) * ((size_t)M * GW));
    L.KVCp = o; o += ws_al(sizeof(float) * ((size_t)BATCH * NCP * KV2) * CPU_ONLY);
    L.KVCs = o; o += ws_al(sizeof(float) * ((size_t)DEC_BATCH * NCS * KV2));
    L.On = o; o += ws_al(sizeof(float) * ((size_t)M * NSAW));
    L.T1 = o; o += ws_al(sizeof(float) * ((size_t)MPAD * D));
    L.X1 = o; o += ws_al(sizeof(float) * ((size_t)M * D));
    L.FF = o; o += ws_al(sizeof(float) * ((size_t)MPAD * 2 * FFN) * CPU_ONLY);
    L.T2 = o; o += ws_al(sizeof(float) * ((size_t)MPAD * D));
    L.X2 = o; o += ws_al(sizeof(float) * ((size_t)M * D));
    L.G = o; o += ws_al(sizeof(float) * ((size_t)MPAD * D) * CPU_ONLY);
    L.PL = o; o += ws_al(sizeof(float) * ((size_t)MPAD * D));
    L.GNW = o; o += ws_al(sizeof(act_t) * (NCHUNKS * 64 * HD));
    L.GQG = o; o += ws_al(sizeof(act_t) * (NCHUNKS * 64 * HD));
    L.GKD = o; o += ws_al(sizeof(act_t) * (NCHUNKS * 64 * HD));
    L.GQK = o; o += ws_al(sizeof(act_t) * (NCHUNKS * 64 * 64));
    L.GU = o; o += ws_al(sizeof(float) * (NCHUNKS * 64 * HD));
    L.GEL = o; o += ws_al(sizeof(float) * (NCHUNKS));
    L.QN = o; o += ws_al(sizeof(bf16_t) * ((size_t)MPAD * NSAW));
    L.SELK = o; o += ws_al(sizeof(bf16_t) * ((size_t)MPR * KVW));
    L.SELV = o; o += ws_al(sizeof(bf16_t) * ((size_t)MPR * KVW));
    L.WINK = o; o += ws_al(sizeof(bf16_t) * ((size_t)MPR * KVW));
    L.WINV = o; o += ws_al(sizeof(bf16_t) * ((size_t)MPR * KVW));
    L.CMPK = o; o += ws_al(sizeof(bf16_t) * ((size_t)BATCH * NKV * NCP * HD));
    L.CMPV = o; o += ws_al(sizeof(bf16_t) * ((size_t)BATCH * NKV * NCP * HD));
    L.T1b = o; o += ws_al(sizeof(bf16_t) * ((size_t)MPAD * D)); L.T2b = o; o += ws_al(sizeof(bf16_t) * ((size_t)MPAD * D)); L.PLb = o; o += ws_al(sizeof(bf16_t) * ((size_t)MPAD * D));
    L.RXS = o; o += ws_al(sizeof(float) * ((size_t)4 * 64 * 64 * 256));
    L.end = o; return L; }
constexpr WsLayout WSL = make_ws_layout();
struct Params {
    const float *x_prompt, *x_sample, *cache_cmp, *cache_sel; const int* page_table;
    const float *state_win, *state_gdn, *state_conv, *p_prompt, *p_sample, *g_pre1, *w_in, *conv_w, *A_log, *dt_bias, *gdn_norm_w, *w_cmp,
                *w_o, *g_post1, *g_pre2, *w_ffn_in, *w_ffn_out, *g_post2, *w_ple, *w_ple_gate;
    float* out;
    unsigned char* ws;
    int ph_lo, ph_hi;
    DEVFN_M unsigned* ctl() const { return (unsigned*)(ws + WSL.ctl); }
    DEVFN_M bf16_t* T1b() const { return (bf16_t*)(ws + WSL.T1b); }
    DEVFN_M bf16_t* T2b() const { return (bf16_t*)(ws + WSL.T2b); }
    DEVFN_M bf16_t* PLb() const { return (bf16_t*)(ws + WSL.PLb); }
    DEVFN_M float* RXS() const { return (float*)(ws + WSL.RXS); }
    DEVFN_M bf16_t* QKVb() const { return (bf16_t*)(ws + WSL.QKVb); }
    DEVFN_M bf16_t* ZAs() const { return (bf16_t*)(ws + WSL.ZAs); }
    DEVFN_M bf16_t* GMs() const { return (bf16_t*)(ws + WSL.GMs); }
    DEVFN_M float* SMf() const { return (float*)(ws + WSL.SMf); }
    DEVFN_M act_t* Wt_in() const { return (act_t*)(ws + WSL.Wt_in); }
    DEVFN_M act_t* Wt_o() const { return (act_t*)(ws + WSL.Wt_o); }
    DEVFN_M act_t* Wt_ffi() const { return (act_t*)(ws + WSL.Wt_ffi); }
    DEVFN_M act_t* Wt_ffo() const { return (act_t*)(ws + WSL.Wt_ffo); }
    DEVFN_M act_t* Wt_pg() const { return (act_t*)(ws + WSL.Wt_pg); }
    DEVFN_M act_t* Wt_ple() const { return (act_t*)(ws + WSL.Wt_ple); }
    DEVFN_M act_t* H1() const { return (act_t*)(ws + WSL.H1); }
    DEVFN_M act_t* Pbf() const { return (act_t*)(ws + WSL.Pbf); }
    DEVFN_M act_t* MIX() const { return (act_t*)(ws + WSL.MIX); }
    DEVFN_M act_t* H2() const { return (act_t*)(ws + WSL.H2); }
    DEVFN_M act_t* ACT() const { return (act_t*)(ws + WSL.ACT); }
    DEVFN_M act_t* X2b() const { return (act_t*)(ws + WSL.X2b); }
    DEVFN_M float* Z() const { return (float*)(ws + WSL.Z); }
    DEVFN_M float* QKVc() const { return (float*)(ws + WSL.QKVc) - (CPU_ONLY ? 0 : (size_t)MPR * 3 * GW); }
    DEVFN_M float* GB() const { return (float*)(ws + WSL.GB); }
    DEVFN_M float* OA() const { return (float*)(ws + WSL.OA); }
    DEVFN_M bf16_t* OAh() const { return (bf16_t*)(ws + WSL.OA); }
    DEVFN_M float* KVCp() const { return (float*)(ws + WSL.KVCp); }
    DEVFN_M float* KVCs() const { return (float*)(ws + WSL.KVCs); }
    DEVFN_M float* On() const { return (float*)(ws + WSL.On); }
    DEVFN_M bf16_t* Onh() const { return (bf16_t*)(ws + WSL.On); }
    DEVFN_M float* T1() const { return (float*)(ws + WSL.T1); }
    DEVFN_M float* X1() const { return (float*)(ws + WSL.X1); }
    DEVFN_M bf16_t* X1h() const { return (bf16_t*)(ws + WSL.X1); }
    DEVFN_M float* FF() const { return (float*)(ws + WSL.FF); }
    DEVFN_M float* T2() const { return (float*)(ws + WSL.T2); }
    DEVFN_M float* X2() const { return (float*)(ws + WSL.X2); }
    DEVFN_M float* G() const { return (float*)(ws + WSL.G); }
    DEVFN_M float* PL() const { return (float*)(ws + WSL.PL); }
    DEVFN_M act_t* GNW() const { return (act_t*)(ws + WSL.GNW); }
    DEVFN_M act_t* GQG() const { return (act_t*)(ws + WSL.GQG); }
    DEVFN_M act_t* GKD() const { return (act_t*)(ws + WSL.GKD); }
    DEVFN_M act_t* GQK() const { return (act_t*)(ws + WSL.GQK); }
    DEVFN_M float* GU() const { return (float*)(ws + WSL.GU); }
    DEVFN_M float* GEL() const { return (float*)(ws + WSL.GEL); }
    DEVFN_M bf16_t* QN() const { return (bf16_t*)(ws + WSL.QN); }
    DEVFN_M bf16_t* SELK() const { return (bf16_t*)(ws + WSL.SELK); }
    DEVFN_M bf16_t* SELV() const { return (bf16_t*)(ws + WSL.SELV); }
    DEVFN_M bf16_t* WINK() const { return (bf16_t*)(ws + WSL.WINK); }
    DEVFN_M bf16_t* WINV() const { return (bf16_t*)(ws + WSL.WINV); }
    DEVFN_M bf16_t* CMPK() const { return (bf16_t*)(ws + WSL.CMPK); }
    DEVFN_M bf16_t* CMPV() const { return (bf16_t*)(ws + WSL.CMPV); }
};

DEVFN const float* x_row(const Params& p, int m) { return m < MPR ? p.x_prompt + (size_t)m * D : p.x_sample + (size_t)(m - MPR) * D; }
#ifndef CPU_SHIM
namespace pg8 {
#define PG8_LAS __attribute__((address_space(3)))
typedef unsigned short bf16_t;
typedef short bf16x8 __attribute__((ext_vector_type(8)));
typedef float f32x4 __attribute__((ext_vector_type(4)));
typedef unsigned u32x4 __attribute__((ext_vector_type(4)));
constexpr int BM = 256, BK = 64, HALF = 128, HTB = HALF * BK * 2  , STAGE_BYTES = 8 * HTB, NXCD = 8, WGM = 8;

__host__ __device__ __forceinline__ int lds_byte(int r, int c) { const int st = (r >> 4) * 2 + (c >> 5), rr = r & 15, cc = c & 31, ob = rr * 64 + cc * 2; return st * 1024 + (ob ^ (((ob >> 9) & 1) << 5)); }
__host__ __device__ __forceinline__ void stage_rc(int b, int& R, int& C) { const int st = b / 1024, sb = b % 1024, swz = sb ^ (((sb >> 9) & 1) << 5); R = (st >> 1) * 16 + swz / 64; C = (st & 1) * 32 + (swz % 64) / 2; }
__host__ __device__ __forceinline__ int perm32(int rho) { const int n = rho >> 4, i = rho & 15; return 8 * (i >> 2) + 4 * n + (i & 3); }

struct Unit { int pm, pn; };
struct Gemm { const bf16_t* A; const bf16_t* Bt; int M, N, K; };

struct StaticOrder {
    int nM, nN, nwg, G, c;
    __host__ __device__ void init(int M, int N, int G_, int c_) { nM = M / BM; nN = N / BM; nwg = nM * nN; G = G_; c = c_; }
    __host__ __device__ bool next(int i, Unit& u) const {
        const long L = (long)i * G + c; if (L >= nwg) return false;
        int wgid = (int)L; { const int q = nwg / NXCD, r = nwg % NXCD, xcd = wgid % NXCD, off = wgid / NXCD; wgid = (xcd < r ? xcd * (q + 1) : r * (q + 1) + (xcd - r) * q) + off; }
        const int nig = WGM * nN, gid = wgid / nig, fm = gid * WGM, gsz = (nM - fm) < WGM ? (nM - fm) : WGM;
        u.pm = fm + ((wgid % nig) % gsz); u.pn = (wgid % nig) / gsz; return true;
    }
    __device__ __forceinline__ void a_ready(const Unit&) const {}
    __device__ __forceinline__ void done(const Unit&) const {}
};
struct CountedOrder : StaticOrder {
    const unsigned* ready; unsigned need; unsigned* tmo;
    __device__ __forceinline__ void a_ready(const Unit& u) const {
        if (threadIdx.x < 64) {
            const unsigned long long t0 = __builtin_amdgcn_s_memrealtime(); unsigned polls = 0;
            while ((unsigned)__builtin_amdgcn_readfirstlane(__hip_atomic_load(ready + 64 * u.pm, __ATOMIC_RELAXED, __HIP_MEMORY_SCOPE_AGENT)) < need) {
                if ((++polls & 255u) == 0u && __builtin_amdgcn_readfirstlane(__hip_atomic_load(tmo, __ATOMIC_RELAXED, __HIP_MEMORY_SCOPE_AGENT)) != 0u) break;
                if (__builtin_amdgcn_s_memrealtime() - t0 > 2000000ull) {
                    if (threadIdx.x == 0) { unsigned expect = 0u; __hip_atomic_compare_exchange_strong(tmo + 1, &expect, 0x600u | (unsigned)(u.pm & 0xff), __ATOMIC_RELAXED, __ATOMIC_RELAXED, __HIP_MEMORY_SCOPE_AGENT); __hip_atomic_store(tmo, 1u, __ATOMIC_RELAXED, __HIP_MEMORY_SCOPE_AGENT); }
                    break; }
                __builtin_amdgcn_s_sleep(2); }
            __builtin_amdgcn_fence(__ATOMIC_ACQUIRE, "agent");
            asm volatile("s_waitcnt vmcnt(0)" ::: "memory");
        }
#if !defined(BROKEN_HOOK_NO_BARRIER)
        asm volatile("" ::: "memory"); __builtin_amdgcn_s_barrier(); asm volatile("" ::: "memory");
#endif
    }
};

__device__ __forceinline__ unsigned cvt_pk_bf16(float lo, float hi) { unsigned r; asm volatile("v_cvt_pk_bf16_f32 %0, %1, %2" : "=v"(r) : "v"(lo), "v"(hi)); return r; }
typedef float f32x2 __attribute__((ext_vector_type(2)));
__device__ __forceinline__ f32x2 gelu_pk(f32x2 v) {
    const f32x2 av = __builtin_elementwise_abs(v), d = av * 0.2316418882f + 1.0f;
    f32x2 t; t.x = __builtin_amdgcn_rcpf(d.x); t.y = __builtin_amdgcn_rcpf(d.y);
    f32x2 q = t * 0.5307027145f + (-0.7265760135f); q = q * t + 0.7107068705f; q = q * t + (-0.142248368f); q = q * t + 0.127414796f; q = q * t;
    const f32x2 s = (v * v) * (-0.72134752044f);
    f32x2 e; e.x = __builtin_amdgcn_exp2f(s.x); e.y = __builtin_amdgcn_exp2f(s.y);
    const f32x2 m = v * (q * e), r = v - m;
    f32x2 o; o.x = v.x < 0.f ? m.x : r.x; o.y = v.y < 0.f ? m.y : r.y; return o;
}

struct EpiF32 {
    static constexpr bool PERM = false, AFTER_DRAIN = false;
    float* C; int ldc; const float* bias;
    __device__ __forceinline__ void operator()(const f32x4 (&acc)[2][2][4][2], const Unit& u, int wr, int wc, int fr, int fq) const {
        const int row0 = u.pm * BM + wr * 64 + fr, col0 = u.pn * BM + wc * 32 + 4 * fq;
        f32x4 bv[2][2];
#pragma unroll
        for (int bj = 0; bj < 2; ++bj)
#pragma unroll
            for (int n = 0; n < 2; ++n) bv[bj][n] = bias ? *(const f32x4*)(bias + col0 + bj * HALF + n * 16) : (f32x4){0.f, 0.f, 0.f, 0.f};
#pragma unroll
        for (int ai = 0; ai < 2; ++ai)
#pragma unroll
            for (int m = 0; m < 4; ++m) { float* rowp = C + (size_t)(row0 + ai * HALF + m * 16) * ldc + col0;
#pragma unroll
                for (int bj = 0; bj < 2; ++bj)
#pragma unroll
                    for (int n = 0; n < 2; ++n) *(f32x4*)(rowp + bj * HALF + n * 16) = acc[ai][bj][m][n] + bv[bj][n]; }
    }
};
template <int ACT  > struct EpiBf16 {
    static constexpr bool PERM = true, AFTER_DRAIN = false;
    bf16_t* O; int ldc; const float* bias; int split_cols; size_t split_stride;
    __device__ __forceinline__ void operator()(const f32x4 (&acc)[2][2][4][2], const Unit& u, int wr, int wc, int fr, int fq) const {
        const int row0 = u.pm * BM + wr * 64 + fr; int colt = u.pn * BM; bf16_t* base = O;
        if (split_cols) { const int t = colt / split_cols; base += (size_t)t * split_stride; colt -= t * split_cols; }
        const int col0 = colt + wc * 32 + 8 * fq, bcol0 = u.pn * BM + wc * 32 + 8 * fq;
        f32x4 bv[2][2];
#pragma unroll
        for (int bj = 0; bj < 2; ++bj)
#pragma unroll
            for (int n = 0; n < 2; ++n) bv[bj][n] = bias ? *(const f32x4*)(bias + bcol0 + bj * HALF + 4 * n) : (f32x4){0.f, 0.f, 0.f, 0.f};
#pragma unroll
        for (int ai = 0; ai < 2; ++ai)
#pragma unroll
            for (int m = 0; m < 4; ++m) { bf16_t* rowp = base + (size_t)(row0 + ai * HALF + m * 16) * ldc + col0;
#pragma unroll
                for (int bj = 0; bj < 2; ++bj) { f32x4 v0 = acc[ai][bj][m][0] + bv[bj][0], v1 = acc[ai][bj][m][1] + bv[bj][1];
                    if (ACT == 1) { f32x2 a = gelu_pk((f32x2){v0[0], v0[1]}), b = gelu_pk((f32x2){v0[2], v0[3]}), c = gelu_pk((f32x2){v1[0], v1[1]}), d = gelu_pk((f32x2){v1[2], v1[3]});
                        v0 = (f32x4){a.x, a.y, b.x, b.y}; v1 = (f32x4){c.x, c.y, d.x, d.y}; }
                    if (ACT == 2) {
#pragma unroll
                        for (int j = 0; j < 4; ++j) { v0[j] = 0.5f * v0[j] * (1.0f + erff(v0[j] * 0.70710678f)); v1[j] = 0.5f * v1[j] * (1.0f + erff(v1[j] * 0.70710678f)); } }
                    u32x4 w; w.x = cvt_pk_bf16(v0[0], v0[1]); w.y = cvt_pk_bf16(v0[2], v0[3]); w.z = cvt_pk_bf16(v1[0], v1[1]); w.w = cvt_pk_bf16(v1[2], v1[3]);
                    *(u32x4*)(rowp + bj * HALF) = w; } }
    }
};
template <class Epi, class Sched, bool STAMP = false>
__device__ __forceinline__ void gemm_phase(PG8_LAS unsigned char* lds, const Gemm g, const Sched& S, const Epi& E, unsigned long long* stamps) {
    const int tid = threadIdx.x, wid = __builtin_amdgcn_readfirstlane(tid >> 6), lane = tid & 63, wr = wid >> 2, wc = wid & 3, fr = lane & 15, fq = lane >> 4;
    const int K = g.K, nt = K / BK;
    int ts_lo = 0, ts_hi = 0, nts = 0; const unsigned long long rt_entry = STAMP ? (unsigned long long)wall_clock64() : 0ull;
#define PG8_STAMP() do { if (STAMP && wid == 0 && nts < 64) { const unsigned long long _c = (unsigned long long)clock64(); \
        ts_lo = (lane == nts) ? (int)(unsigned)_c : ts_lo; ts_hi = (lane == nts) ? (int)(unsigned)(_c >> 32) : ts_hi; ++nts; } } while (0)
    PG8_STAMP();
    unsigned voffA[2], voffB[2];
#pragma unroll
    for (int i = 0; i < 2; ++i) { int R, C; stage_rc(tid * 16 + i * 8192, R, C); const int Rb = Epi::PERM ? ((R & ~31) + perm32(R & 31)) : R;
        voffA[i] = (unsigned)(R * K + C) * 2u; voffB[i] = (unsigned)(Rb * K + C) * 2u; }
    const size_t kstep = (size_t)(BK * 2);
    const size_t hstep = (size_t)HALF * K * 2;
    const size_t tstep = 2 * hstep;
    const unsigned ldsw = (unsigned)wid * 1024u;
    const int aoff = lds_byte(wr * 64 + fr, fq * 8), boff = lds_byte(wc * 32 + fr, fq * 8);
#define PG8_SA(b, h) (((b) * 2 + (h)) * HTB)
#define PG8_SB(b, h) ((4 + (b) * 2 + (h)) * HTB)
#define PG8_STAGE(bufoff, gbase, voff) do { _Pragma("unroll") for (int _i = 0; _i < 2; ++_i) \
        __builtin_amdgcn_global_load_lds((const unsigned*)((const char*)(gbase) + (voff)[_i]), (PG8_LAS unsigned*)(lds + (bufoff) + ldsw + _i * 8192), 16, 0, 0); } while (0)
#define PG8_LDA(dst, b, h) do { _Pragma("unroll") for (int m = 0; m < 4; ++m) _Pragma("unroll") for (int k = 0; k < 2; ++k) dst[m][k] = *(const PG8_LAS bf16x8*)(lds + PG8_SA(b, h) + aoff + m * 2048 + k * 1024); } while (0)
#define PG8_LDB(dst, b, h) do { _Pragma("unroll") for (int n = 0; n < 2; ++n) _Pragma("unroll") for (int k = 0; k < 2; ++k) dst[n][k] = *(const PG8_LAS bf16x8*)(lds + PG8_SB(b, h) + boff + n * 2048 + k * 1024); } while (0)
#define PG8_MMA(ai, bj, At, Bt) do { __builtin_amdgcn_s_setprio(1); _Pragma("unroll") for (int m = 0; m < 4; ++m) _Pragma("unroll") for (int n = 0; n < 2; ++n) _Pragma("unroll") for (int k = 0; k < 2; ++k) \
        acc[ai][bj][m][n] = __builtin_amdgcn_mfma_f32_16x16x32_bf16(Bt[n][k], At[m][k], acc[ai][bj][m][n], 0, 0, 0); __builtin_amdgcn_s_setprio(0); } while (0)
#define PG8_WAIT_V(n) asm volatile("s_waitcnt vmcnt(" #n ")" ::: "memory")
#define PG8_WAIT_L(n) asm volatile("s_waitcnt lgkmcnt(" #n ")" ::: "memory")
#define PG8_BAR __builtin_amdgcn_s_barrier()
#define PG8_SCHED __builtin_amdgcn_sched_barrier(0)
    Unit cur, nxt; int ui = 0;
    if (!S.next(0, cur)) return;
    f32x4 acc[2][2][4][2];
#pragma unroll
    for (int a = 0; a < 2; ++a)
#pragma unroll
        for (int b = 0; b < 2; ++b)
#pragma unroll
            for (int m = 0; m < 4; ++m)
#pragma unroll
                for (int n = 0; n < 2; ++n) acc[a][b][m][n] = (f32x4){0.f, 0.f, 0.f, 0.f};
    bf16x8 At[4][2], B0[2][2], B1[2][2];
    const char* cA = (const char*)g.A + (size_t)cur.pm * tstep; const char* cB = (const char*)g.Bt + (size_t)cur.pn * tstep;
    S.a_ready(cur);
    PG8_STAGE(PG8_SB(0, 0), cB, voffB); PG8_STAGE(PG8_SA(0, 0), cA, voffA); PG8_STAGE(PG8_SB(0, 1), cB + hstep, voffB); PG8_STAGE(PG8_SA(0, 1), cA + hstep, voffA);
    if (wr == 1) PG8_BAR;
    PG8_WAIT_V(4); PG8_BAR;
    PG8_STAGE(PG8_SB(1, 0), cB + kstep, voffB); PG8_STAGE(PG8_SA(1, 0), cA + kstep, voffA); PG8_STAGE(PG8_SB(1, 1), cB + hstep + kstep, voffB);
    PG8_WAIT_V(6); PG8_BAR;
    PG8_STAMP();
    for (;;) {
        const bool has_next = S.next(ui + 1, nxt);
        const char* nA = has_next ? (const char*)g.A + (size_t)nxt.pm * tstep : cA; const char* nB = has_next ? (const char*)g.Bt + (size_t)nxt.pn * tstep : cB;
        for (int t = 0; t < nt; t += 2) {
            const bool last = (t == nt - 2);
            const char* a1 = cA + (size_t)(t + 1) * kstep;
            const char* a2 = last ? nA : cA + (size_t)(t + 2) * kstep; const char* b2 = last ? nB : cB + (size_t)(t + 2) * kstep;
            const char* a3 = a2 + kstep; const char* b3 = b2 + kstep;
            if (last && has_next) S.a_ready(nxt);
            PG8_LDB(B0, 0, 0); PG8_SCHED; PG8_LDA(At, 0, 0); PG8_STAGE(PG8_SA(1, 1), a1 + hstep, voffA);
            PG8_WAIT_L(8); PG8_BAR; PG8_WAIT_L(0); PG8_MMA(0, 0, At, B0); PG8_BAR; PG8_SCHED;
            PG8_LDB(B1, 0, 1); PG8_STAGE(PG8_SB(0, 0), b2, voffB);
            PG8_BAR; PG8_WAIT_L(0); PG8_MMA(0, 1, At, B1); PG8_BAR;
            PG8_LDA(At, 0, 1); PG8_STAGE(PG8_SA(0, 0), a2, voffA);
            PG8_BAR; PG8_WAIT_L(0); PG8_MMA(1, 0, At, B0); PG8_BAR; PG8_SCHED;
            PG8_STAGE(PG8_SB(0, 1), b2 + hstep, voffB);
            PG8_WAIT_V(6); PG8_BAR; PG8_MMA(1, 1, At, B1); PG8_BAR;
            PG8_LDB(B0, 1, 0); PG8_SCHED; PG8_LDA(At, 1, 0); PG8_STAGE(PG8_SA(0, 1), a2 + hstep, voffA);
            PG8_WAIT_L(8); PG8_BAR; PG8_WAIT_L(0); PG8_MMA(0, 0, At, B0); PG8_BAR; PG8_SCHED;
            PG8_LDB(B1, 1, 1); PG8_STAGE(PG8_SB(1, 0), b3, voffB);
            PG8_BAR; PG8_WAIT_L(0); PG8_MMA(0, 1, At, B1); PG8_BAR;
            PG8_LDA(At, 1, 1); PG8_STAGE(PG8_SA(1, 0), a3, voffA);
            PG8_BAR; PG8_WAIT_L(0); PG8_MMA(1, 0, At, B0); PG8_BAR; PG8_SCHED;
            PG8_STAGE(PG8_SB(1, 1), b3 + hstep, voffB);
            PG8_WAIT_V(6); PG8_BAR; PG8_MMA(1, 1, At, B1); PG8_BAR;
        }
        PG8_STAMP();
        if constexpr (!Epi::AFTER_DRAIN) { E(acc, cur, wr, wc, fr, fq); S.done(cur); }
        PG8_STAMP();
        if (!has_next) break;
#pragma unroll
        for (int a = 0; a < 2; ++a)
#pragma unroll
            for (int b = 0; b < 2; ++b)
#pragma unroll
                for (int m = 0; m < 4; ++m)
#pragma unroll
                    for (int n = 0; n < 2; ++n) acc[a][b][m][n] = (f32x4){0.f, 0.f, 0.f, 0.f};
        cur = nxt; cA = nA; cB = nB; ++ui;
    }
    PG8_WAIT_V(0);
    if (wr == 0) PG8_BAR;
    PG8_BAR;
    if constexpr (Epi::AFTER_DRAIN) { E.fused(acc, cur, wr, wc, fr, fq, lds, wid, lane); S.done(cur); }
    PG8_STAMP();
    if (STAMP && wid == 0) { stamps[lane] = lane < nts ? (((unsigned long long)(unsigned)ts_hi << 32) | (unsigned)ts_lo) : 0ull;
        if (lane == 62) stamps[62] = rt_entry; if (lane == 63) stamps[63] = (unsigned long long)wall_clock64(); }
#undef PG8_STAMP
#undef PG8_SA
#undef PG8_SB
#undef PG8_STAGE
#undef PG8_LDA
#undef PG8_LDB
#undef PG8_MMA
#undef PG8_WAIT_V
#undef PG8_WAIT_L
#undef PG8_BAR
#undef PG8_SCHED
}
}
#define XB_TMO      128
#define XB_XCNT(j)  (256  + 64 * (j))
#define XB_XSUB(j)  (1280 + 64 * (j))
#define XB_XGEN(j)  (2304 + 64 * (j))
#define XB_TOP      3328
#define XB_TOPGEN   3392
#define XCD_BAR_WORDS 3456
#define XB_SPIN_CAP (1u << 23)
#define LAS __attribute__((address_space(3)))

__device__ __forceinline__ unsigned xb_ld(unsigned* p)              { return __hip_atomic_load(p, __ATOMIC_RELAXED, __HIP_MEMORY_SCOPE_AGENT); }
__device__ __forceinline__ unsigned xb_add(unsigned* p, unsigned v) { return __hip_atomic_fetch_add(p, v, __ATOMIC_RELAXED, __HIP_MEMORY_SCOPE_AGENT); }
__device__ __forceinline__ unsigned xb_xcc_id() { return (unsigned)__builtin_amdgcn_s_getreg((3 << 11) | 20) & 0xFu; }
#define XB_SPIN(cond, bar) do { unsigned _sp = 0; while (cond) { __builtin_amdgcn_s_sleep(1); \
    if ((++_sp & 255u) == 0u) { if (xb_ld(&(bar)[XB_TMO])) break; if (_sp > XB_SPIN_CAP) { atomicAdd(&(bar)[XB_TMO], 1u); break; } } } } while (0)

struct XcdBarrier {
    unsigned* bar; unsigned x;
    volatile LAS unsigned* st;
};

__device__ __forceinline__ XcdBarrier xcd_barrier_post(unsigned* bar, volatile LAS unsigned* st) {
    XcdBarrier b; b.bar = bar; b.x = xb_xcc_id(); b.st = st;
    if (threadIdx.x == 0) (void)xb_add(&bar[XB_XCNT(b.x)], 1u);
    return b;
}
__device__ __forceinline__ void xcd_barrier_complete(unsigned* bar, unsigned x, unsigned& nloc, unsigned& nx) {
    const unsigned G = gridDim.x * gridDim.y * gridDim.z;
    unsigned sum, cnt, mine, sp = 0u;
    for (;;) {
        sum = 0u; cnt = 0u; mine = 0u;
#pragma unroll
        for (unsigned j = 0; j < 16; ++j) { const unsigned c = xb_ld(&bar[XB_XCNT(j)]); sum += c; cnt += (c > 0u) ? 1u : 0u; mine = (j == x) ? c : mine; }
        if (sum == G) break;
        __builtin_amdgcn_s_sleep(1);
        if ((++sp & 255u) == 0u) { if (xb_ld(&bar[XB_TMO])) break; if (sp > XB_SPIN_CAP) { atomicAdd(&bar[XB_TMO], 1u); break; } }
    }
    nloc = mine > 0u ? mine : 1u; nx = cnt > 0u ? cnt : 1u;
}

__device__ __forceinline__ void xcd_barrier(const XcdBarrier& b) {
    asm volatile("s_waitcnt vmcnt(0)" ::: "memory");
    __syncthreads();
    if (threadIdx.x == 0) {
        unsigned* bar = b.bar;
        __builtin_amdgcn_s_waitcnt(0);
        unsigned nloc = b.st[0], nx = b.st[1];
        if (nloc == 0u) { xcd_barrier_complete(bar, b.x, nloc, nx); b.st[0] = nloc; b.st[1] = nx; }
        const unsigned old = xb_add(&bar[XB_XSUB(b.x)], 1u);
        const unsigned gen = old / nloc;
        if (old + 1u == (gen + 1u) * nloc) {
            __builtin_amdgcn_fence(__ATOMIC_RELEASE, "agent");
            asm volatile("s_waitcnt vmcnt(0)" ::: "memory");
            const unsigned og = xb_add(&bar[XB_TOP], 1u);
            const unsigned tg = og / nx;
            if (og + 1u == (tg + 1u) * nx) xb_add(&bar[XB_TOPGEN], 1u);
            else XB_SPIN(xb_ld(&bar[XB_TOPGEN]) == tg, bar);
            __builtin_amdgcn_fence(__ATOMIC_ACQUIRE, "agent");
            xb_add(&bar[XB_XGEN(b.x)], 1u);
            asm volatile("s_waitcnt vmcnt(0)" ::: "memory");
        } else {
            XB_SPIN(xb_ld(&bar[XB_XGEN(b.x)]) == gen, bar);
            __builtin_amdgcn_fence(__ATOMIC_ACQUIRE, "agent");
            asm volatile("s_waitcnt vmcnt(0)" ::: "memory");
        }
    }
    __syncthreads();
}
#endif
DEVFN float block_sum(float v, float* red) {
    red[TID] = v; SYNC();
    for (int s = NTHR >> 1; s > 0; s >>= 1) { if (TID < s) red[TID] += red[TID + s]; SYNC(); }
    const float r = red[0]; SYNC(); return r;
}

DEVFN void tr_weight(const float* W, int K, int N, int NP, act_t* Wt) {
    GSL(i, (long)NP * K) { const int n = (int)(i / K), k = (int)(i % K); Wt[i] = n < N ? to_act(W[(size_t)k * N + n]) : to_act(0.f); }
}
DEVFN void st_prep_kvcs(const Params& p) {
    GSL(i, (long)DEC_BATCH * NCS * KV2) {
        const int c = (int)(i % KV2), n = (int)((i / KV2) % NCS), bs = (int)(i / ((long)KV2 * NCS));
        const float* base = p.cache_cmp + ((size_t)p.page_table[bs * N_PAGES + (32 * n) / PAGE] * PAGE + (32 * n) % PAGE) * KV2 + c;
        float acc = 0.f;
#pragma unroll 8
        for (int cc = 0; cc < 32; ++cc) acc += base[(size_t)cc * KV2] * p.w_cmp[cc * KV2 + c];
        p.KVCs()[i] = acc;
    }
}
DEVFN void st_prep(const Params& p, float* sm) {
#if 0
    tr_weight(p.w_in, D, PROJ, NPROJ, p.Wt_in()); tr_weight(p.w_o, D, D, D, p.Wt_o()); tr_weight(p.w_ffn_in, D, 2 * FFN, 2 * FFN, p.Wt_ffi());
    tr_weight(p.w_ffn_out, FFN, D, D, p.Wt_ffo()); tr_weight(p.w_ple_gate, D, D, D, p.Wt_pg()); tr_weight(p.w_ple, PLE, D, D, p.Wt_ple());
#endif
    USL(m, MPAD) {
        act_t* h = p.H1() + (size_t)m * D; act_t* pb = p.Pbf() + (size_t)m * PLE;
        if (m >= M) { BSL(k, D) h[k] = to_act(0.f); BSL(k, PLE) pb[k] = to_act(0.f); continue; }
        const float* x = x_row(p, m);
        float part = 0.f; BSL(k, D) part += x[k] * x[k];
        const float r = rsqrt_f(block_sum(part, sm) / (float)D + RMS_EPS);
        BSL(k, D) h[k] = to_act(x[k] * r * p.g_pre1[k]);
        const float* pl = m < MPR ? p.p_prompt + (size_t)m * PLE : p.p_sample + (size_t)(m - MPR) * PLE;
        BSL(k, PLE) pb[k] = to_act(pl[k]);
    }
    st_prep_kvcs(p);
}

DEVFN float conv_tap(const Params& p, int m, int j, int c) {
    if (m < MPR) { const int b = m / SEQ, tt = m % SEQ + j - 3; return tt >= 0 ? p.Z()[(size_t)(b * SEQ + tt) * NPROJ + C_QKV + c] : 0.f; }
    const int bs = (m - MPR) / DEC_SEQ, tt = (m - MPR) % DEC_SEQ + j - 3;
    return tt >= 0 ? p.Z()[(size_t)(MPR + bs * DEC_SEQ + tt) * NPROJ + C_QKV + c] : p.state_conv[(size_t)(bs * 3 + tt + 3) * (3 * GW) + c];
}
DEVFN void st_post_inproj(const Params& p) {
    GSL(i, (long)M * KV2) { const int c = (int)(i % KV2), m = (int)(i / KV2);
        const float vc = p.Z()[(size_t)m * NPROJ + C_CMP + c], vs = p.Z()[(size_t)m * NPROJ + C_SEL + c];
        if (m < MPR) { p.out[O_CMPP + i] = vc; p.out[O_SELP + i] = vs; } else { const long o = i - (long)MPR * KV2; p.out[O_CMPS + o] = vc; p.out[O_SELS + o] = vs; } }
    GSL(i, (long)BATCH * WINBUF * KV2) { const int c = (int)(i % KV2), j = (int)((i / KV2) % WINBUF), b = (int)(i / ((long)KV2 * WINBUF));
        p.out[O_WINP + i] = p.Z()[(size_t)(b * SEQ + SEQ - WINBUF + j) * NPROJ + C_WIN + c]; }
    GSL(i, (long)DEC_BATCH * WINBUF * KV2) { const int c = (int)(i % KV2), j = (int)((i / KV2) % WINBUF), bs = (int)(i / ((long)KV2 * WINBUF));
        const int jj = j + DEC_SEQ;
        p.out[O_WINS + i] = jj < WINBUF ? p.state_win[((size_t)bs * WINBUF + jj) * KV2 + c] : p.Z()[(size_t)(MPR + bs * DEC_SEQ + jj - WINBUF) * NPROJ + C_WIN + c]; }
    GSL(i, (long)BATCH * 3 * 3 * GW) { const int c = (int)(i % (3 * GW)), j = (int)((i / (3 * GW)) % 3), b = (int)(i / (9L * GW));
        p.out[O_CONVP + i] = p.Z()[(size_t)(b * SEQ + SEQ - 3 + j) * NPROJ + C_QKV + c]; }
    GSL(i, (long)DEC_BATCH * 3 * 3 * GW) { const int c = (int)(i % (3 * GW)), j = (int)((i / (3 * GW)) % 3), bs = (int)(i / (9L * GW));
        p.out[O_CONVS + i] = p.Z()[(size_t)(MPR + bs * DEC_SEQ + DEC_SEQ - 3 + j) * NPROJ + C_QKV + c]; }
    GSL(i, (long)MSA * 3 * GH) { const int h = (int)(i % GH), part = (int)((i / GH) % 3), m = MPR + (int)(i / (3 * GH));
        float* dst = p.QKVc() + (size_t)m * 3 * GW + part * GW + h * HD; float ss = 0.f;
        for (int d = 0; d < HD; ++d) { const int c = part * GW + h * HD + d; float a = 0.f;
            for (int j = 0; j < 4; ++j) a += conv_tap(p, m, j, c) * p.conv_w[(size_t)j * 3 * GW + c];
            const float v = silu_f(a); dst[d] = v; ss += v * v; }
        if (part < 2) { const float r = rsqrt_f(ss + RMS_EPS) * (part == 0 ? QSCALE : 1.0f); for (int d = 0; d < HD; ++d) dst[d] *= r; } }
    GSL(i, (long)M * GH) { const int h = (int)(i % GH), m = (int)(i / GH);
        p.GB()[(size_t)m * 2 * GH + h] = -expf(p.A_log[h]) * softplus_f(p.Z()[(size_t)m * NPROJ + C_A + h] + p.dt_bias[h]);
        p.GB()[(size_t)m * 2 * GH + GH + h] = sigmoid_f(p.Z()[(size_t)m * NPROJ + C_B + h]); }
    GSL(i, (long)BATCH * NCP * KV2) { const int c = (int)(i % KV2), n = (int)((i / KV2) % NCP), b = (int)(i / ((long)KV2 * NCP)); float acc = 0.f;
        for (int cc = 0; cc < 32; ++cc) acc += p.Z()[(size_t)(b * SEQ + 32 * n + cc) * NPROJ + C_CMP + c] * p.w_cmp[cc * KV2 + c];
        p.KVCp()[i] = acc; }
}

DEVFN void st_gdn_naive(const Params& p, int s_lo) {
    GSL(item, (long)(BATCH + DEC_BATCH - s_lo) * GH * HD) {
        const int v = (int)(item % HD), h = (int)((item / HD) % GH), s = s_lo + (int)(item / (HD * GH));
        float S[HD]; int m0, T; float* sout;
        if (s < BATCH) { m0 = s * SEQ; T = SEQ; sout = p.out + O_GDNP + ((size_t)(s * GH + h) * HD) * HD + v;
#pragma unroll
            for (int k = 0; k < HD; ++k) S[k] = 0.f; }
        else { const int bs = s - BATCH; m0 = MPR + bs * DEC_SEQ; T = DEC_SEQ; sout = p.out + O_GDNS + ((size_t)(bs * GH + h) * HD) * HD + v;
#pragma unroll
            for (int k = 0; k < HD; ++k) S[k] = p.state_gdn[((size_t)(bs * GH + h) * HD + k) * HD + v]; }
        for (int t = 0; t < T; ++t) { const int m = UNIFORM(m0 + t); const int hu = UNIFORM(h);
            const float* q = p.QKVc() + (size_t)m * 3 * GW + hu * HD; const float* kk = q + GW; const float vv = q[2 * GW + v];
            const float eg = expf(p.GB()[(size_t)m * 2 * GH + hu]), beta = p.GB()[(size_t)m * 2 * GH + GH + hu];
            float dot = 0.f;
#pragma unroll
            for (int c = 0; c < HD / 16; ++c) {
#pragma unroll
                for (int k = 0; k < 16; ++k) dot += S[c * 16 + k] * kk[c * 16 + k];
                CFENCE(); }
            const float vn = beta * (vv - eg * dot); float o = 0.f;
#pragma unroll
            for (int c = 0; c < HD / 16; ++c) {
#pragma unroll
                for (int k = 0; k < 16; ++k) { S[c * 16 + k] = eg * S[c * 16 + k] + kk[c * 16 + k] * vn; o += S[c * 16 + k] * q[c * 16 + k]; }
                CFENCE(); }
            p.OA()[(size_t)m * GW + h * HD + v] = o; }
#pragma unroll
        for (int k = 0; k < HD; ++k) sout[(size_t)k * HD] = S[k];
    }
}

constexpr int SCW = 1024;
static_assert(NCP <= SCW && NCS <= SCW && WINDOW <= SCW, "score buffer");
constexpr int NSMAX = NSP > NSS ? NSP : NSS;
DEVFN const float* sel_row(const Params& p, bool smp, int b, int kpos, int x, int g) {
    if (!smp) return p.Z() + (size_t)(b * SEQ + kpos) * NPROJ + C_SEL + x * KVW + g * HD;
    if (kpos < PAST) return p.cache_sel + ((size_t)p.page_table[b * N_PAGES + kpos / PAGE] * PAGE + kpos % PAGE) * KV2 + x * KVW + g * HD;
    return p.Z() + (size_t)(MPR + b * DEC_SEQ + kpos - PAST) * NPROJ + C_SEL + x * KVW + g * HD;
}
DEVFN const float* win_row(const Params& p, bool smp, int b, int wpos, int x, int g) {
    if (!smp) return p.Z() + (size_t)(b * SEQ + wpos) * NPROJ + C_WIN + x * KVW + g * HD;
    if (wpos < PAST) return p.state_win + ((size_t)b * WINBUF + (wpos - (PAST - WINBUF))) * KV2 + x * KVW + g * HD;
    return p.Z() + (size_t)(MPR + b * DEC_SEQ + wpos - PAST) * NPROJ + C_WIN + x * KVW + g * HD;
}
DEVFN void nsa_softmax(float* ssc, float* sstat, int n) {
    BSL(r, 4) { float mx = -3.0e38f; for (int i = 0; i < n; ++i) mx = fmaxf(mx, ssc[r * SCW + i]);
        if (mx < -1e29f) { sstat[r] = 0.f; sstat[4 + r] = 0.f; }
        else { float sum = 0.f; for (int i = 0; i < n; ++i) { const float s = ssc[r * SCW + i]; if (s > -1e29f) sum += expf(s - mx); } sstat[r] = mx; sstat[4 + r] = 1.0f / sum; } }
    SYNC();
    BSL(i, 4 * n) { const int r = i / n, ii = i % n; const float s = ssc[r * SCW + ii]; ssc[r * SCW + ii] = s > -1e29f ? expf(s - sstat[r]) * sstat[4 + r] : 0.f; }
    SYNC();
}
DEVFN void st_nsa_naive(const Params& p, float* sm, int m_lo) {
    float* sq = sm; float* sgate = sq + 4 * HD; float* so = sgate + 16; float* sstat = so + 4 * HD; float* sscore = sstat + 16; int* sidx = (int*)(sscore + ((NSMAX + 15) / 16) * 16);
    float* ssc = (float*)(sidx + 16);
    USL(u, (M - m_lo) * NKV) {
        const int m = m_lo + u / NKV, g = u % NKV; const bool smp = m >= MPR;
        const int b = smp ? (m - MPR) / DEC_SEQ : m / SEQ, tpos = smp ? PAST + (m - MPR) % DEC_SEQ : m % SEQ;
        const int NC = smp ? NCS : NCP, NS = smp ? NSS : NSP, ksel = smp ? KSEL_S : KSEL_P;
        const float* kvc = smp ? p.KVCs() + (size_t)b * NCS * KV2 : p.KVCp() + (size_t)b * NCP * KV2;
        BSL(i, 4 * HD) sq[i] = p.Z()[(size_t)m * NPROJ + C_QN + g * 4 * HD + i] * QSCALE;
        BSL(i, 12) sgate[i] = sigmoid_f(p.Z()[(size_t)m * NPROJ + C_GN + g * 12 + i]);
        SYNC();
        BSL(i, 4 * NC) { const int r = i / NC, n = i % NC, cend = 32 * n + 31; float s = NEG_INF;
            if (tpos >= cend) { const float* kr = kvc + (size_t)n * KV2 + g * HD; float a = 0.f; for (int d = 0; d < HD; ++d) a += sq[r * HD + d] * kr[d];
                s = a - exp2_f(-8.0f * (float)(g * 4 + r + 1) / (float)NH) * (float)(tpos - cend); }
            ssc[r * SCW + n] = s; }
        SYNC();
        nsa_softmax(ssc, sstat, NC);
        BSL(i, 4 * HD) { const int r = i / HD, d = i % HD; float a = 0.f;
            for (int n = 0; n < NC; ++n) { const float pr = ssc[r * SCW + n]; if (pr != 0.f) a += pr * kvc[(size_t)n * KV2 + KVW + g * HD + d]; }
            so[i] = sgate[r * 3 + 0] * a; }
        BSL(j, NS) { float imp = 0.f;
            for (int r = 0; r < 4; ++r) { if (2 * j < NC) imp += ssc[r * SCW + 2 * j]; if (2 * j + 1 < NC) imp += ssc[r * SCW + 2 * j + 1]; }
            const int cur = tpos / 64; const bool forced = (j == 0) || (j == cur) || (j == cur - 1), avail = j * 64 <= tpos;
            sscore[j] = forced ? imp + FORCE_BONUS : (avail ? imp : -1.0f); }
        SYNC();
        if (TID == 0) for (int kk = 0; kk < ksel; ++kk) { int best = 0; float bv = -3.0e38f;
            for (int j = 0; j < NS; ++j) if (sscore[j] > bv) { bv = sscore[j]; best = j; }
            sidx[kk] = best; sscore[best] = -3.0e38f; }
        SYNC();
        BSL(i, 4 * ksel * 64) { const int r = i / (ksel * 64), kk = i % (ksel * 64), kpos = sidx[kk / 64] * 64 + kk % 64; float s = NEG_INF;
            if (kpos <= tpos) { const float* kr = sel_row(p, smp, b, kpos, 0, g); float a = 0.f; for (int d = 0; d < HD; ++d) a += sq[r * HD + d] * kr[d];
                s = a - exp2_f(-8.0f * (float)(g * 4 + r + 1) / (float)NH) * (float)(tpos - kpos); }
            ssc[r * SCW + kk] = s; }
        SYNC();
        nsa_softmax(ssc, sstat, ksel * 64);
        BSL(i, 4 * HD) { const int r = i / HD, d = i % HD; float a = 0.f;
            for (int kk = 0; kk < ksel * 64; ++kk) { const float pr = ssc[r * SCW + kk]; if (pr != 0.f) a += pr * sel_row(p, smp, b, sidx[kk / 64] * 64 + kk % 64, 1, g)[d]; }
            so[i] += sgate[r * 3 + 1] * a; }
        SYNC();
        const int wmin = smp ? PAST - WINBUF : 0;
        BSL(i, 4 * WINDOW) { const int r = i / WINDOW, kk = i % WINDOW, wpos = tpos - (WINDOW - 1) + kk; float s = NEG_INF;
            if (wpos >= wmin) { const float* kr = win_row(p, smp, b, wpos, 0, g); float a = 0.f; for (int d = 0; d < HD; ++d) a += sq[r * HD + d] * kr[d];
                s = a - exp2_f(-8.0f * (float)(g * 4 + r + 1) / (float)NH) * (float)(tpos - wpos); }
            ssc[r * SCW + kk] = s; }
        SYNC();
        nsa_softmax(ssc, sstat, WINDOW);
        BSL(i, 4 * HD) { const int r = i / HD, d = i % HD; float a = 0.f;
            for (int kk = 0; kk < WINDOW; ++kk) { const float pr = ssc[r * SCW + kk]; if (pr != 0.f) a += pr * win_row(p, smp, b, tpos - (WINDOW - 1) + kk, 1, g)[d]; }
            p.On()[(size_t)m * NSAW + g * 4 * HD + i] = so[i] + sgate[r * 3 + 2] * a; }
        SYNC();
    }
}

DEVFN void st_merge(const Params& p) {
    GSL(i, (long)MPAD * GH) { const int h = (int)(i % GH), m = (int)(i / GH); act_t* dst = p.MIX() + (size_t)m * D + h * HD;
        if (m >= M) { for (int d = 0; d < HD; ++d) dst[d] = to_act(0.f); continue; }
        const float* o = p.OA() + (size_t)m * GW + h * HD; float ss = 0.f;
        for (int d = 0; d < HD; ++d) ss += o[d] * o[d];
        const float r = rsqrt_f(ss / (float)HD + RMS_EPS); const float* z = p.Z() + (size_t)m * NPROJ;
        for (int d = 0; d < HD; ++d) { const int c = h * HD + d;
            const float oa = o[d] * r * p.gdn_norm_w[d] * silu_f(z[C_Z + c]);
            dst[d] = to_act(sigmoid_f(z[C_GM + c]) * oa + sigmoid_f(z[C_GM + D + c]) * p.On()[(size_t)m * NSAW + c]); } }
}
DEVFN void st_norm1(const Params& p, float* sm) {
    USL(m, MPAD) { act_t* h2 = p.H2() + (size_t)m * D;
        if (m >= M) { BSL(k, D) h2[k] = to_act(0.f); continue; }
        const float* t1 = p.T1() + (size_t)m * D; const float* x = x_row(p, m); float* x1 = p.X1() + (size_t)m * D;
        float part = 0.f; BSL(k, D) part += t1[k] * t1[k];
        const float r1 = rsqrt_f(block_sum(part, sm) / (float)D + RMS_EPS);
        part = 0.f; BSL(k, D) { const float v = x[k] + t1[k] * r1 * p.g_post1[k]; x1[k] = v; part += v * v; }
        const float r2 = rsqrt_f(block_sum(part, sm) / (float)D + RMS_EPS);
        BSL(k, D) h2[k] = to_act(x1[k] * r2 * p.g_pre2[k]); }
}
DEVFN void st_act(const Params& p) {
    GSL(i, (long)MPAD * FFN) { const int j = (int)(i % FFN), m = (int)(i / FFN);
        p.ACT()[i] = m < M ? to_act(silu_f(p.FF()[(size_t)m * 2 * FFN + j]) * p.FF()[(size_t)m * 2 * FFN + FFN + j]) : to_act(0.f); }
}
DEVFN void st_norm2(const Params& p, float* sm) {
    USL(m, MPAD) { act_t* xb = p.X2b() + (size_t)m * D;
        if (m >= M) { BSL(k, D) xb[k] = to_act(0.f); continue; }
        const float* t2 = p.T2() + (size_t)m * D; const float* x1 = p.X1() + (size_t)m * D; float* x2 = p.X2() + (size_t)m * D;
        float part = 0.f; BSL(k, D) part += t2[k] * t2[k];
        const float r = rsqrt_f(block_sum(part, sm) / (float)D + RMS_EPS);
        BSL(k, D) { const float v = x1[k] + t2[k] * r * p.g_post2[k]; x2[k] = v; xb[k] = to_act(v); } }
}
DEVFN void st_final(const Params& p) {
    GSL(i, (long)M * D) { const int m = (int)(i / D);
        const float y = p.X2()[i] + sigmoid_f(p.G()[i]) * p.PL()[i];
        if (m < MPR) p.out[O_YP + i] = y; else p.out[O_YS + (i - (long)MPR * D)] = y; }
}

constexpr int GC = 64, NCHK = SEQ / GC;
constexpr int G1_LP = GC + 4, HP = HD + 1;
DEVFN void st_gdn_g1(const Params& p, float* sm) {
    float* Qh = sm; float* Kh = Qh + GC * HP; float* Vh = Kh + GC * HP; float* Lm = Vh + GC * HP; float* gcs = Lm + GC * G1_LP; float* bet = gcs + GC; float* rs = bet + GC;
    USL(u, BATCH * GH * NCHK) {
        const int c = u % NCHK, h = (u / NCHK) % GH, b = u / (NCHK * GH); const int m0 = b * SEQ + c * GC;
        BSL(i, GC * 3 * HD) { const int d = i % HD, part = (i / HD) % 3, r = i / (3 * HD); const int ch = part * GW + h * HD + d; float a = 0.f;
            for (int j = 0; j < 4; ++j) a += conv_tap(p, m0 + r, j, ch) * p.conv_w[(size_t)j * 3 * GW + ch];
            const float v = silu_f(a); if (part == 0) Qh[r * HP + d] = v; else if (part == 1) Kh[r * HP + d] = v; else Vh[r * HP + d] = v; }
        BSL(r, GC) { const float* z = p.Z() + (size_t)(m0 + r) * NPROJ; gcs[r] = -expf(p.A_log[h]) * softplus_f(z[C_A + h] + p.dt_bias[h]); bet[r] = sigmoid_f(z[C_B + h]); }
        SYNC();
        BSL(i, 2 * GC) { const int r = i % GC; const float* src = (i < GC ? Qh : Kh) + r * HP; float ss = 0.f; for (int d = 0; d < HD; ++d) ss += src[d] * src[d];
            rs[i] = rsqrt_f(ss + RMS_EPS) * (i < GC ? QSCALE : 1.0f); }
        if (TID == 0) { float a = 0.f; for (int r = 0; r < GC; ++r) { a += gcs[r]; gcs[r] = a; } }
        SYNC();
        BSL(i, GC * HD) { const int r = i / HD, x = r * HP + i % HD; Qh[x] *= rs[r]; Kh[x] *= rs[GC + r]; Vh[x] *= bet[r]; }
        SYNC();
        const size_t cu = (size_t)u;
        BSL(i, GC * GC) { const int j = i % GC, r = i / GC; float kk = 0.f, qk = 0.f;
            if (j <= r) { for (int d = 0; d < HD; ++d) { const float kj = Kh[j * HP + d]; kk += Kh[r * HP + d] * kj; qk += Qh[r * HP + d] * kj; } }
            const float dec = j <= r ? expf(gcs[r] - gcs[j]) : 0.f;
            Lm[r * G1_LP + j] = j < r ? kk * dec * bet[r] : 0.f;
            p.GQK()[cu * GC * GC + i] = to_act(qk * dec); }
        SYNC();
        BSL(i, GC * HD) { const int r = i / HD, x = r * HP + i % HD; p.GQG()[cu * GC * HD + i] = to_act(Qh[x] * expf(gcs[r])); p.GKD()[(cu * HD + i % HD) * GC + r] = to_act(Kh[x] * expf(gcs[GC - 1] - gcs[r])); }
        SYNC();
        BSL(i, GC * HD) { const int r = i / HD; Kh[r * HP + i % HD] *= bet[r] * expf(gcs[r]); }
        SYNC();
        BSL(col, 2 * HD) { float* X = col < HD ? Vh + col : Kh + (col - HD);
            for (int r = 1; r < GC; ++r) { float a = X[r * HP]; const float* lr = Lm + r * G1_LP;
                for (int j = 0; j < r; ++j) a -= lr[j] * X[j * HP];
                X[r * HP] = a; } }
        SYNC();
        BSL(i, GC * HD) { const int x = (i / HD) * HP + i % HD; p.GU()[cu * GC * HD + i] = Vh[x]; p.GNW()[cu * GC * HD + i] = to_act(-Kh[x]); }
        if (TID == 0) p.GEL()[cu] = expf(gcs[GC - 1]);
        SYNC();
    }
}
constexpr int G2_SL = 16, G2_NSL = HD / G2_SL;
DEVFN void st_gdn_g2(const Params& p, float* sm) {
    float* S = sm; float* Us = S + HD * G2_SL; float* VN = Us + GC * G2_SL; float* O1 = VN + GC * G2_SL; act_t* NW = (act_t*)(O1 + GC * G2_SL); act_t* QG = NW + GC * HD; act_t* KD = QG + GC * HD; act_t* QK = KD + GC * HD;
    USL(u, BATCH * GH * G2_NSL) {
        const int sl = u % G2_NSL, h = (u / G2_NSL) % GH, b = u / (G2_NSL * GH); const int v0 = sl * G2_SL;
        BSL(i, HD * G2_SL) S[i] = 0.f;
        SYNC();
        for (int c = 0; c < NCHK; ++c) {
            const size_t cu = (size_t)(b * GH + h) * NCHK + c;
            BSL(i, GC * HD) { NW[i] = p.GNW()[cu * GC * HD + i]; QG[i] = p.GQG()[cu * GC * HD + i]; KD[i] = p.GKD()[(cu * HD + i % HD) * GC + i / HD]; }
            BSL(i, GC * GC) QK[i] = p.GQK()[cu * GC * GC + i];
            BSL(i, GC * G2_SL) { const int v = i % G2_SL, r = i / G2_SL; Us[i] = p.GU()[(cu * GC + r) * HD + v0 + v]; }
            const float egl = p.GEL()[cu];
            SYNC();
            BSL(i, GC * G2_SL) { const int v = i % G2_SL, r = i / G2_SL; float a = Us[i], o = 0.f;
                for (int k = 0; k < HD; ++k) { const float s = S[k * G2_SL + v]; a += from_act(NW[r * HD + k]) * s; o += from_act(QG[r * HD + k]) * s; }
                VN[i] = a; O1[i] = o; }
            SYNC();
            BSL(i, GC * G2_SL) { const int v = i % G2_SL, r = i / G2_SL; float o = O1[i];
                for (int j = 0; j <= r; ++j) o += from_act(QK[r * GC + j]) * VN[j * G2_SL + v];
                p.OA()[(size_t)(b * SEQ + c * GC + r) * GW + h * HD + v0 + v] = o; }
            BSL(i, HD * G2_SL) { const int v = i % G2_SL, k = i / G2_SL; float a = S[i] * egl;
                for (int r = 0; r < GC; ++r) a += from_act(KD[r * HD + k]) * VN[r * G2_SL + v];
                S[i] = a; }
            SYNC();
        }
        BSL(i, HD * G2_SL) { const int v = i % G2_SL, k = i / G2_SL; p.out[O_GDNP + ((size_t)(b * GH + h) * HD + k) * HD + v0 + v] = S[i]; }
        SYNC();
    }
}
#ifndef CPU_SHIM
DEVFN void st_attn_operands(const Params& p) {
    constexpr float QS2 = QSCALE * 1.4426950408889634f;
    GSL(i, (long)MPR * NSAW) { const int c = (int)(i % NSAW), m = (int)(i / NSAW); p.QN()[i] = f2bf(p.Z()[(size_t)m * NPROJ + C_QN + c] * QS2); }
    GSL(i, (long)BATCH * NKV * SEQ * HD) { const int d = (int)(i % HD), pos = (int)((i / HD) % SEQ), g = (int)((i / ((long)HD * SEQ)) % NKV), b = (int)(i / ((long)HD * SEQ * NKV));
        const float* z = p.Z() + (size_t)(b * SEQ + pos) * NPROJ;
        p.SELK()[i] = f2bf(z[C_SEL + g * HD + d]); p.SELV()[i] = f2bf(z[C_SEL + KVW + g * HD + d]);
        p.WINK()[i] = f2bf(z[C_WIN + g * HD + d]); p.WINV()[i] = f2bf(z[C_WIN + KVW + g * HD + d]); }
    GSL(i, (long)BATCH * NKV * NCP * HD) { const int d = (int)(i % HD), n = (int)((i / HD) % NCP), g = (int)((i / ((long)HD * NCP)) % NKV), b = (int)(i / ((long)HD * NCP * NKV));
        float ak = 0.f, av = 0.f;
        for (int cc = 0; cc < 32; ++cc) { const float* z = p.Z() + (size_t)(b * SEQ + 32 * n + cc) * NPROJ + C_CMP + g * HD + d;
            ak += z[0] * p.w_cmp[cc * KV2 + g * HD + d]; av += z[KVW] * p.w_cmp[cc * KV2 + KVW + g * HD + d]; }
        p.CMPK()[i] = f2bf(ak); p.CMPV()[i] = f2bf(av); }
}

namespace na {
using bf16x8 = __attribute__((ext_vector_type(8))) short;
using s16x4  = __attribute__((ext_vector_type(4))) short;
using f32x16 = __attribute__((ext_vector_type(16))) float;
using u32x4  = __attribute__((ext_vector_type(4))) unsigned;
constexpr int TILE_B = 64 * HD * 2;
constexpr int OFF_V = 0, OFF_K = 2 * TILE_B, OFF_WS = 4 * TILE_B, OFF_IMP = OFF_WS + 8 * 512, OFF_MASK = OFF_IMP + 64 * 64 * 4, OFF_ACC = OFF_MASK + 64 * 8, OFF_END = OFF_ACC + 8 * 32 * 64 * 4;
constexpr float NEGM = -1.0e5f, MFLOOR = -3.0e4f, THR2 = 8.0f;
#define NA_KSWZ(row, colB) ((row) * 256 + ((colB) ^ (((row) & 7) << 4)))
#define NA_SBAR() __builtin_amdgcn_sched_barrier(0)
__device__ __forceinline__ int crow(int r, int hi) { return (r & 3) + 8 * (r >> 2) + 4 * hi; }
__device__ __forceinline__ unsigned cvtpk(float lo, float hi) { unsigned r; asm volatile("v_cvt_pk_bf16_f32 %0, %1, %2" : "=v"(r) : "v"(lo), "v"(hi)); return r; }
__device__ __forceinline__ int v_st(int k, int c) { const int kk = (k & ~0xC) | ((k & 4) << 1) | ((k & 8) >> 1); return ((kk >> 3) * 4 + (c >> 5)) * 512 + ((kk & 7) * 32 + (c & 31)) * 2; }
__device__ __forceinline__ int v_rd_base(int lane) { return ((lane & 3) << 3) | (((lane >> 2) & 3) << 6) | (((lane >> 4) & 1) << 5) | (((lane >> 5) & 1) << 8); }
constexpr int v_rd_off(int d0, int ks, int half) { return d0 * 512 + ks * 4096 + half * 2048; }
template <int OFF> __device__ __forceinline__ s16x4 tr_read(int vb) { s16x4 r; asm volatile("ds_read_b64_tr_b16 %0, %1 offset:%2" : "=&v"(r) : "v"(vb), "i"(OFF) : "memory"); return r; }
template <int D0> __device__ __forceinline__ void pv_one(f32x16& od, int vb, bf16x8 pa0, bf16x8 pa1, bf16x8 pa2, bf16x8 pa3) {
    const s16x4 l0 = tr_read<v_rd_off(D0, 0, 0)>(vb), h0 = tr_read<v_rd_off(D0, 0, 1)>(vb), l1 = tr_read<v_rd_off(D0, 1, 0)>(vb), h1 = tr_read<v_rd_off(D0, 1, 1)>(vb);
    const s16x4 l2 = tr_read<v_rd_off(D0, 2, 0)>(vb), h2 = tr_read<v_rd_off(D0, 2, 1)>(vb), l3 = tr_read<v_rd_off(D0, 3, 0)>(vb), h3 = tr_read<v_rd_off(D0, 3, 1)>(vb);
    asm volatile("s_waitcnt lgkmcnt(0)" ::: "memory"); NA_SBAR();
#define NA_PK(L, H) (bf16x8){L[0], L[1], L[2], L[3], H[0], H[1], H[2], H[3]}
    od = __builtin_amdgcn_mfma_f32_32x32x16_bf16(pa0, NA_PK(l0, h0), od, 0, 0, 0);
    od = __builtin_amdgcn_mfma_f32_32x32x16_bf16(pa1, NA_PK(l1, h1), od, 0, 0, 0);
    od = __builtin_amdgcn_mfma_f32_32x32x16_bf16(pa2, NA_PK(l2, h2), od, 0, 0, 0);
    od = __builtin_amdgcn_mfma_f32_32x32x16_bf16(pa3, NA_PK(l3, h3), od, 0, 0, 0);
#undef NA_PK
}
__device__ __forceinline__ void pv_d0(f32x16* o, int vb, bf16x8 pa0, bf16x8 pa1, bf16x8 pa2, bf16x8 pa3) {
    pv_one<0>(o[0], vb, pa0, pa1, pa2, pa3); pv_one<1>(o[1], vb, pa0, pa1, pa2, pa3); pv_one<2>(o[2], vb, pa0, pa1, pa2, pa3); pv_one<3>(o[3], vb, pa0, pa1, pa2, pa3);
}
template <bool EDGE = true> __device__ __forceinline__ void qkt_bias(f32x16& p0, f32x16& p1, const char* Ks, const bf16x8* qr, int r32, int hi, float A, float Bv, int lo, int hi_lim) {
    const float B0 = fmaf(A, (float)(4 * hi), Bv), B1 = fmaf(A, 32.0f, B0); const int l0 = lo - 4 * hi, h0 = hi_lim - 4 * hi;
#pragma unroll
    for (int r = 0; r < 16; ++r) { const int c = (r & 3) + 8 * (r >> 2);
        if (EDGE) { p0[r] = (c >= l0 && c <= h0) ? fmaf(A, (float)c, B0) : NEGM; p1[r] = (c + 32 >= l0 && c + 32 <= h0) ? fmaf(A, (float)c, B1) : NEGM; }
        else { p0[r] = fmaf(A, (float)c, B0); p1[r] = fmaf(A, (float)c, B1); } }
#pragma unroll
    for (int d0 = 0; d0 < 8; ++d0) { const int cb = (d0 * 16 + hi * 8) * 2;
        const bf16x8 b0 = *reinterpret_cast<const bf16x8*>(Ks + NA_KSWZ(r32, cb));
        const bf16x8 b1 = *reinterpret_cast<const bf16x8*>(Ks + NA_KSWZ(32 + r32, cb));
        p0 = __builtin_amdgcn_mfma_f32_32x32x16_bf16(b0, qr[d0], p0, 0, 0, 0);
        p1 = __builtin_amdgcn_mfma_f32_32x32x16_bf16(b1, qr[d0], p1, 0, 0, 0); }
}
__device__ __forceinline__ void softmax_pack(f32x16& p0, f32x16& p1, float& m_reg, float& l_reg, float& alpha, bf16x8& pa0, bf16x8& pa1, bf16x8& pa2, bf16x8& pa3) {
    float pmax = p0[0];
#pragma unroll
    for (int r = 1; r < 16; ++r) pmax = fmaxf(pmax, p0[r]);
#pragma unroll
    for (int r = 0; r < 16; ++r) pmax = fmaxf(pmax, p1[r]);
    { auto rr = __builtin_amdgcn_permlane32_swap(__float_as_uint(pmax), __float_as_uint(pmax), false, false); pmax = fmaxf(__uint_as_float(rr[0]), __uint_as_float(rr[1])); }
    float mn;
    if (__all(pmax - m_reg <= THR2)) { mn = m_reg; alpha = 1.f; }
    else { mn = fmaxf(m_reg, pmax); alpha = __builtin_amdgcn_exp2f(m_reg - mn); m_reg = mn; }
    float ps = 0.f;
#pragma unroll
    for (int r = 0; r < 16; ++r) { p0[r] = __builtin_amdgcn_exp2f(p0[r] - mn); p1[r] = __builtin_amdgcn_exp2f(p1[r] - mn); ps += p0[r] + p1[r]; }
    { auto rr = __builtin_amdgcn_permlane32_swap(__float_as_uint(ps), __float_as_uint(ps), false, false); ps = __uint_as_float(rr[0]) + __uint_as_float(rr[1]); }
    l_reg = l_reg * alpha + ps;
#define NA_PK4(P, BASE, OUT) do { unsigned a0 = cvtpk(P[BASE + 0], P[BASE + 1]), a1 = cvtpk(P[BASE + 2], P[BASE + 3]);   \
    unsigned b0 = cvtpk(P[BASE + 4], P[BASE + 5]), b1 = cvtpk(P[BASE + 6], P[BASE + 7]);                              \
    auto r0 = __builtin_amdgcn_permlane32_swap(a0, b0, false, false); auto r1 = __builtin_amdgcn_permlane32_swap(a1, b1, false, false); \
    u32x4 w = {r0[0], r1[0], r0[1], r1[1]}; OUT = *reinterpret_cast<bf16x8*>(&w); } while (0)
    NA_PK4(p0, 0, pa0); NA_PK4(p0, 8, pa1); NA_PK4(p1, 0, pa2); NA_PK4(p1, 8, pa3);
#undef NA_PK4
}

struct Tile { const bf16_t* K; const bf16_t* V; };

__device__ __forceinline__ void nsa_unit(const Params& p, char* lds, int b, int i, int g) {
    const int tid = tid_now(), wid = tid >> 6, lane = tid & 63, r32 = lane & 31, hi = lane >> 5;
    const int tl = r32 >> 2, rh = r32 & 3, row = 8 * wid + tl, t = 64 * i + row, h = 4 * g + rh;
    const float slope2 = exp2f(-8.0f * (float)(h + 1) / (float)NH) * 1.4426950408889634f, tf = (float)t;
    char* V_lds = lds + OFF_V; char* K_lds = lds + OFF_K;
    float* ws = (float*)(lds + OFF_WS) + wid * 128; float* li_l = ws; float* al_l = ws + 32;
    float* imp_t = (float*)(lds + OFF_IMP); unsigned* masks = (unsigned*)(lds + OFF_MASK);
    bf16x8 qr[8];
    { const bf16_t* Qw = p.QN() + (size_t)(b * SEQ + t) * NSAW + h * HD + hi * 8;
#pragma unroll
      for (int d0 = 0; d0 < 8; ++d0) qr[d0] = *reinterpret_cast<const bf16x8*>(Qw + d0 * 16); }
    const float* gz = p.SMf() + (size_t)(b * SEQ + t) * 128 + 2 * GH + g * 12 + rh * 3;
#define NA_GATE(x) (gz[x])
    const int sr = tid >> 4, sc = (tid & 15) * 8, vst0 = v_st(sr, sc), vst1 = v_st(32 + sr, sc), kst0 = NA_KSWZ(sr, sc * 2), kst1 = NA_KSWZ(32 + sr, sc * 2);
    const int vb0 = (int)(uintptr_t)V_lds + v_rd_base(lane);
    bf16x8 sK0, sK1, sV0, sV1;
#define NA_SLOAD(T) do { sK0 = *reinterpret_cast<const bf16x8*>((T).K + (size_t)sr * HD + sc); sK1 = *reinterpret_cast<const bf16x8*>((T).K + (size_t)(32 + sr) * HD + sc); \
                         sV0 = *reinterpret_cast<const bf16x8*>((T).V + (size_t)sr * HD + sc); sV1 = *reinterpret_cast<const bf16x8*>((T).V + (size_t)(32 + sr) * HD + sc); } while (0)
#define NA_SWRITE(bf) do { *(bf16x8*)(V_lds + (bf) * TILE_B + vst0) = sV0; *(bf16x8*)(V_lds + (bf) * TILE_B + vst1) = sV1; \
                           *(bf16x8*)(K_lds + (bf) * TILE_B + kst0) = sK0; *(bf16x8*)(K_lds + (bf) * TILE_B + kst1) = sK1; } while (0)
#define NA_RESC(a) do { if (__any((a) < 1.f)) { if (hi == 0) al_l[r32] = (a); asm volatile("s_waitcnt lgkmcnt(0)" ::: "memory"); \
    _Pragma("unroll") for (int d = 0; d < 4; ++d) _Pragma("unroll") for (int r = 0; r < 16; ++r) o[d][r] *= al_l[crow(r, hi)]; } } while (0)
    unsigned* accw = (unsigned*)(lds + OFF_ACC) + wid * (32 * 64) + lane;
#define NA_FOLD(gt, STAGE) do { if (hi == 0) li_l[r32] = l_reg > 0.f ? (gt) / l_reg : 0.f; asm volatile("s_waitcnt lgkmcnt(0)" ::: "memory"); \
    _Pragma("unroll") for (int r = 0; r < 16; ++r) { const int q = crow(r, hi); const float f = li_l[q]; \
        float v0 = o[0][r] * f, v1 = o[1][r] * f, v2 = o[2][r] * f, v3 = o[3][r] * f; \
        if ((STAGE) > 0) { const unsigned w0 = accw[(2 * r) * 64], w1 = accw[(2 * r + 1) * 64]; \
            v0 += __uint_as_float(w0 << 16); v1 += __uint_as_float(w0 & 0xffff0000u); v2 += __uint_as_float(w1 << 16); v3 += __uint_as_float(w1 & 0xffff0000u); } \
        if ((STAGE) < 2) { accw[(2 * r) * 64] = cvtpk(v0, v1); accw[(2 * r + 1) * 64] = cvtpk(v2, v3); } \
        else { bf16_t* dst = p.Onh() + (size_t)(b * SEQ + 64 * i + 8 * wid + (q >> 2)) * NSAW + (4 * g + (q & 3)) * HD + r32; \
            dst[0] = f2bf(v0); dst[32] = f2bf(v1); dst[64] = f2bf(v2); dst[96] = f2bf(v3); } } } while (0)
    f32x16 o[4];
#pragma unroll
    for (int d = 0; d < 4; ++d)
#pragma unroll
        for (int r = 0; r < 16; ++r) o[d][r] = 0.f;
    float m_reg = MFLOOR, l_reg = 0.f, alpha; f32x16 p0, p1; bf16x8 pa0, pa1, pa2, pa3;

    const int ncmp = (2 * i + 1) / 64 + 1;
    const bf16_t* ck = p.CMPK() + ((size_t)(b * NKV + g) * NCP) * HD; const bf16_t* cv = p.CMPV() + ((size_t)(b * NKV + g) * NCP) * HD;
    __syncthreads();
    for (int c = 0; c < ncmp; ++c) { Tile T{ck + (size_t)c * 64 * HD, cv + (size_t)c * 64 * HD}; NA_SLOAD(T); asm volatile("s_waitcnt vmcnt(0)" ::: "memory"); NA_SWRITE(c); }
    __syncthreads();
    const int climb = ((t + 1) >> 5) - 1;
    for (int c = 0; c < ncmp; ++c) {
        qkt_bias(p0, p1, K_lds + c * TILE_B, qr, r32, hi, 32.0f * slope2, slope2 * ((float)(2048 * c + 31) - tf), 0, climb - 64 * c);
        softmax_pack(p0, p1, m_reg, l_reg, alpha, pa0, pa1, pa2, pa3);
        NA_RESC(alpha);
        pv_d0(o, vb0 + c * TILE_B, pa0, pa1, pa2, pa3);
    }
    { const float inv = l_reg > 0.f ? 1.0f / l_reg : 0.f;
      for (int c = 0; c < ncmp; ++c) {
        qkt_bias(p0, p1, K_lds + c * TILE_B, qr, r32, hi, 32.0f * slope2, slope2 * ((float)(2048 * c + 31) - tf), 0, climb - 64 * c);
#pragma unroll
        for (int a = 0; a < 8; ++a) {
            const int r0 = 4 * (a >> 1) + 2 * (a & 1);
            float v0 = (__builtin_amdgcn_exp2f(p0[r0] - m_reg) + __builtin_amdgcn_exp2f(p0[r0 + 1] - m_reg)) * inv;
            float v1 = (__builtin_amdgcn_exp2f(p1[r0] - m_reg) + __builtin_amdgcn_exp2f(p1[r0 + 1] - m_reg)) * inv;
            v0 += __shfl_xor(v0, 1); v0 += __shfl_xor(v0, 2); v1 += __shfl_xor(v1, 1); v1 += __shfl_xor(v1, 2);
            const int jl = 4 * (a >> 1) + 2 * hi + (a & 1);
            if (rh == 0) { imp_t[row * 64 + 32 * c + jl] = v0; imp_t[row * 64 + 32 * c + 16 + jl] = v1; }
        }
      } }
    NA_FOLD(NA_GATE(0), 0);
    asm volatile("s_waitcnt lgkmcnt(0)" ::: "memory");
    for (int k8 = 0; k8 < 8; ++k8) {
        const int rw = 8 * wid + k8;
        const float im = imp_t[rw * 64 + lane];
        const bool forced = (lane == 0) || (lane == i) || (lane == i - 1), avail = lane <= i;
        const float s = forced ? im + FORCE_BONUS : (avail ? im : -1.0f);
        int cnt = 0;
#pragma unroll
        for (int k = 0; k < 64; ++k) { const float sk = __int_as_float(__builtin_amdgcn_readlane(__float_as_int(s), k)); cnt += (sk > s || (sk == s && k < lane)) ? 1 : 0; }
        const unsigned long long mk = __ballot(cnt < 16);
        if (lane == 0) { masks[2 * rw] = (unsigned)mk; masks[2 * rw + 1] = (unsigned)(mk >> 32); }
    }
    __syncthreads();
    unsigned long long umask;
    { unsigned ulo = masks[2 * lane], uhi = masks[2 * lane + 1];
#pragma unroll
      for (int s = 1; s < 64; s <<= 1) { ulo |= __shfl_xor(ulo, s); uhi |= __shfl_xor(uhi, s); }
      umask = (unsigned long long)__builtin_amdgcn_readfirstlane(ulo) | ((unsigned long long)__builtin_amdgcn_readfirstlane(uhi) << 32); }
    unsigned long long wmask;
    { unsigned wlo = masks[2 * row], whi = masks[2 * row + 1];
#pragma unroll
      for (int s = 1; s < 64; s <<= 1) { wlo |= __shfl_xor(wlo, s); whi |= __shfl_xor(whi, s); }
      wmask = (unsigned long long)__builtin_amdgcn_readfirstlane(wlo) | ((unsigned long long)__builtin_amdgcn_readfirstlane(whi) << 32); }

    {
        const bf16_t* kb = p.SELK() + ((size_t)(b * NKV + g) * SEQ) * HD; const bf16_t* vb = p.SELV() + ((size_t)(b * NKV + g) * SEQ) * HD;
        unsigned long long todo = umask & ((i >= 63) ? ~0ull : ((1ull << (i + 1)) - 1ull));
        m_reg = MFLOOR; l_reg = 0.f;
#pragma unroll
        for (int d = 0; d < 4; ++d)
#pragma unroll
            for (int r = 0; r < 16; ++r) o[d][r] = 0.f;
        int buf = 0;
        if (todo) { const int j0 = __builtin_ctzll(todo); Tile T{kb + (size_t)j0 * 64 * HD, vb + (size_t)j0 * 64 * HD}; NA_SLOAD(T); asm volatile("s_waitcnt vmcnt(0)" ::: "memory"); NA_SWRITE(0); }
        __syncthreads();
        while (todo) {
            const int j = __builtin_ctzll(todo); todo &= todo - 1;
            if (todo) { const int jn = __builtin_ctzll(todo); Tile T{kb + (size_t)jn * 64 * HD, vb + (size_t)jn * 64 * HD}; NA_SLOAD(T); }
            if ((wmask >> j) & 1ull) {
            const float pen = ((masks[2 * row + (j >> 5)] >> (j & 31)) & 1u) ? 0.f : NEGM;
            if (j == i) qkt_bias<true>(p0, p1, K_lds + buf * TILE_B, qr, r32, hi, slope2, slope2 * ((float)(64 * j) - tf) + pen, 0, row);
            else qkt_bias<false>(p0, p1, K_lds + buf * TILE_B, qr, r32, hi, slope2, slope2 * ((float)(64 * j) - tf) + pen, 0, 63);
            softmax_pack(p0, p1, m_reg, l_reg, alpha, pa0, pa1, pa2, pa3);
            NA_RESC(alpha);
            pv_d0(o, vb0 + buf * TILE_B, pa0, pa1, pa2, pa3);
            }
            if (todo) { asm volatile("s_waitcnt vmcnt(0)" ::: "memory"); NA_SWRITE(buf ^ 1); }
            __syncthreads();
            if (DUP_PHASE == 340) __syncthreads();
            buf ^= 1;
        }
        NA_FOLD(NA_GATE(1), 1);
    }
    {
        const bf16_t* kb = p.WINK() + ((size_t)(b * NKV + g) * SEQ) * HD; const bf16_t* vb = p.WINV() + ((size_t)(b * NKV + g) * SEQ) * HD;
        const int jlo = i >= 8 ? i - 8 : 0;
        m_reg = MFLOOR; l_reg = 0.f;
#pragma unroll
        for (int d = 0; d < 4; ++d)
#pragma unroll
            for (int r = 0; r < 16; ++r) o[d][r] = 0.f;
        int buf = 0;
        { Tile T{kb + (size_t)jlo * 64 * HD, vb + (size_t)jlo * 64 * HD}; NA_SLOAD(T); asm volatile("s_waitcnt vmcnt(0)" ::: "memory"); NA_SWRITE(0); }
        __syncthreads();
        for (int j = jlo; j <= i; ++j) {
            if (j < i) { Tile T{kb + (size_t)(j + 1) * 64 * HD, vb + (size_t)(j + 1) * 64 * HD}; NA_SLOAD(T); }
            if (j == i || j == i - 8) qkt_bias<true>(p0, p1, K_lds + buf * TILE_B, qr, r32, hi, slope2, slope2 * ((float)(64 * j) - tf), (j == i - 8) ? row + 1 : 0, j == i ? row : 63);
            else qkt_bias<false>(p0, p1, K_lds + buf * TILE_B, qr, r32, hi, slope2, slope2 * ((float)(64 * j) - tf), 0, 63);
            softmax_pack(p0, p1, m_reg, l_reg, alpha, pa0, pa1, pa2, pa3);
            NA_RESC(alpha);
            pv_d0(o, vb0 + buf * TILE_B, pa0, pa1, pa2, pa3);
            if (j < i) { asm volatile("s_waitcnt vmcnt(0)" ::: "memory"); NA_SWRITE(buf ^ 1); }
            __syncthreads();
            buf ^= 1;
        }
        NA_FOLD(NA_GATE(2), 2);
    }
#undef NA_SLOAD
#undef NA_SWRITE
#undef NA_RESC
#undef NA_FOLD
#undef NA_GATE
}
}
DEVFN void st_nsa_fast_prompt(const Params& p, char* lds) {
    constexpr int NU = BATCH * NKV * (SEQ / 64);
    for (int u = blockIdx.x; u < NU; u += gridDim.x) {
        const int i = (SEQ / 64 - 1) - u / (BATCH * NKV), bg = u % (BATCH * NKV), b = bg / NKV, g = bg % NKV;
        na::nsa_unit(p, lds, b, i, g);
    }
}
#endif
#ifndef CPU_SHIM
__device__ __forceinline__ unsigned pk2bf(float lo, float hi) { unsigned r; asm volatile("v_cvt_pk_bf16_f32 %0, %1, %2" : "=v"(r) : "v"(lo), "v"(hi)); return r; }
typedef unsigned v4u __attribute__((ext_vector_type(4)));
typedef float v4f __attribute__((ext_vector_type(4)));
#ifndef NT_STORES
#define NT_STORES 1
#endif
#if NT_STORES
#define NT_ST(ptr, val) __builtin_nontemporal_store((val), (v4u*)(ptr))
#else
#define NT_ST(ptr, val) (*(v4u*)(ptr) = (val))
#endif
__device__ __forceinline__ v4f load_bf4(const bf16_t* src) { const unsigned long long w = *(const unsigned long long*)src; const unsigned lo = (unsigned)w, hi2 = (unsigned)(w >> 32);
    return (v4f){__uint_as_float(lo << 16), __uint_as_float(lo & 0xffff0000u), __uint_as_float(hi2 << 16), __uint_as_float(hi2 & 0xffff0000u)}; }
__device__ __forceinline__ v4f bf4_unpack(unsigned long long w) { const unsigned lo = (unsigned)w, hi2 = (unsigned)(w >> 32);
    return (v4f){__uint_as_float(lo << 16), __uint_as_float(lo & 0xffff0000u), __uint_as_float(hi2 << 16), __uint_as_float(hi2 & 0xffff0000u)}; }
template <class SrcCol> __device__ __forceinline__ void tr_range(const float* W, int K, int N, int NP, bf16_t* Wt, float* scr_base, SrcCol src, int it0, int it1, int stride) {
    const int lane = tid_now() & 63, wave = tid_now() >> 6; float* scr = scr_base + wave * (64 * 65 + 32);
    const int nblk = NP / 64, nitems = it1, kr = lane >> 4, nq = lane & 15, nr = lane >> 3, kc = lane & 7;
    v4f cur[16], nxt[16];
    int it = it0 + wave;
    auto load = [&](int item, v4f (&dst)[16]) { const int kb = item / nblk, nb = item % nblk; const int sc = src(64 * nb + 4 * nq);
#pragma unroll
        for (int i = 0; i < 16; ++i) dst[i] = sc >= 0 ? *(const v4f*)(W + (size_t)(64 * kb + 4 * i + kr) * N + sc) : (v4f){0.f, 0.f, 0.f, 0.f}; };
    if (it < nitems) load(it, cur);
    for (; it < nitems; it += stride) {
        const int kb = it / nblk, nb = it % nblk, k0 = 64 * kb, n0 = 64 * nb, itn = it + stride;
        if (itn < nitems) load(itn, nxt);
#pragma unroll
        for (int i = 0; i < 16; ++i) { float* d = scr + (4 * i + kr) * 65 + 4 * nq; d[0] = cur[i][0]; d[1] = cur[i][1]; d[2] = cur[i][2]; d[3] = cur[i][3]; }
        asm volatile("s_waitcnt lgkmcnt(0)" ::: "memory");
#pragma unroll
        for (int j = 0; j < 8; ++j) { const int n = 8 * j + nr; const float* s = scr + (8 * kc) * 65 + n;
            v4u o; o.x = pk2bf(s[0 * 65], s[1 * 65]); o.y = pk2bf(s[2 * 65], s[3 * 65]); o.z = pk2bf(s[4 * 65], s[5 * 65]); o.w = pk2bf(s[6 * 65], s[7 * 65]);
            *(v4u*)(Wt + (size_t)(n0 + n) * K + k0 + 8 * kc) = o; }
        asm volatile("s_waitcnt lgkmcnt(0)" ::: "memory");
#pragma unroll
        for (int i = 0; i < 16; ++i) cur[i] = nxt[i];
    }
}
template <class SrcCol> __device__ __forceinline__ void tr_fast(const float* W, int K, int N, int NP, bf16_t* Wt, float* scr_base, SrcCol src) {
    tr_range(W, K, N, NP, Wt, scr_base, src, (int)blockIdx.x * 8, (K / 64) * (NP / 64), (int)gridDim.x * 8);
}
struct SrcIdent { __device__ int operator()(int n) const { return n; } };
struct SrcPad { int N; __device__ int operator()(int n) const { return n < N ? n : -1; } };
struct SrcFfnIn { __device__ int operator()(int n) const { const int t = n >> 8, r = n & 255; return r < 128 ? t * 128 + r : FFN + t * 128 + (r - 128); } };
namespace ip {
constexpr int E_QKV = 0, E_ZA = E_QKV + 3 * GW, E_QN = E_ZA + GW, E_CMP = E_QN + NSAW, E_SEL = E_CMP + KV2, E_WIN = E_SEL + KV2, E_GM = E_WIN + KV2, E_SM = E_GM + 2 * D, E_END = E_SM + 256;
static_assert(E_END == NPROJ && (3 * GW) % 256 == 0 && GW % 256 == 0 && NSAW % 256 == 0 && KV2 % 256 == 0 && 2 * GH + 3 * NH <= 128, "projection tile map");
constexpr int SMW = 128;
struct SrcIn { __device__ int operator()(int n) const {
    if (n < E_QN) return n;
    if (n < E_CMP) return C_QN + (n - E_QN);
    if (n < E_SEL) return C_CMP + (n - E_CMP);
    if (n < E_WIN) return C_SEL + (n - E_SEL);
    if (n < E_GM) return C_WIN + (n - E_WIN);
    if (n < E_SM) return C_GM + (n - E_GM);
    const int c = n - E_SM;
    if (c < GH) return C_A + c; if (c < 2 * GH) return C_B + (c - GH); if (c < 2 * GH + 3 * NH) return C_GN + (c - 2 * GH);
    return -1; } };
__device__ __forceinline__ v4u pack8(const float* v) { v4u w; w.x = pk2bf(v[0], v[1]); w.y = pk2bf(v[2], v[3]); w.z = pk2bf(v[4], v[5]); w.w = pk2bf(v[6], v[7]); return w; }
struct Epi {
    static constexpr bool PERM = true, AFTER_DRAIN = false;
    unsigned char* ws; float* out; const float* A_log; const float* dt_bias;
    template <int SEG> __device__ __forceinline__ void seg(const pg8::f32x4 (&acc)[2][2][4][2], int col0, int rowb, int clb) const {
#pragma unroll
        for (int ai = 0; ai < 2; ++ai)
#pragma unroll
            for (int m = 0; m < 4; ++m) {
                const int row = rowb + ai * 128 + m * 16; const bool prm = row < MPR, real = row < M;
                const int b = prm ? row / SEQ : (row - MPR) / DEC_SEQ, t = prm ? row % SEQ : (row - MPR) % DEC_SEQ;
#pragma unroll
                for (int bj = 0; bj < 2; ++bj) {
                    const int cl = bj * 128 + clb, col = col0 + cl; float v[8];
#pragma unroll
                    for (int e = 0; e < 4; ++e) { v[e] = acc[ai][bj][m][0][e]; v[4 + e] = acc[ai][bj][m][1][e]; }
                    if (SEG == 0) {
                        NT_ST(((bf16_t*)(ws + WSL.QKVb)) + (size_t)row * (3 * GW) + col, pack8(v));
                        if (real && t >= (prm ? SEQ : DEC_SEQ) - 3) { float* d = out + (prm ? O_CONVP : O_CONVS) + ((size_t)(b * 3 + t - ((prm ? SEQ : DEC_SEQ) - 3))) * (3 * GW) + col;
                            *(v4f*)d = (v4f){v[0], v[1], v[2], v[3]}; *(v4f*)(d + 4) = (v4f){v[4], v[5], v[6], v[7]}; }
                    } else if (SEG == 1) {
#pragma unroll
                        for (int e = 0; e < 8; ++e) v[e] = v[e] / (1.0f + __expf(-v[e]));
                        NT_ST(((bf16_t*)(ws + WSL.ZAs)) + (size_t)row * GW + (col - E_ZA), pack8(v));
                    } else if (SEG == 2) {
#pragma unroll
                        for (int e = 0; e < 8; ++e) v[e] *= QSCALE * 1.4426950408889634f;
                        NT_ST(((bf16_t*)(ws + WSL.QN)) + (size_t)row * NSAW + (col - E_QN), pack8(v));
                    } else if (SEG <= 5) {
                        constexpr int sg3 = SEG - 3; const int c = col - (sg3 == 0 ? E_CMP : sg3 == 1 ? E_SEL : E_WIN);
                        if (real) {
                            if (sg3 < 2) { float* d = out + (sg3 == 0 ? (prm ? O_CMPP : O_CMPS) : (prm ? O_SELP : O_SELS)) + (size_t)(prm ? row : row - MPR) * KV2 + c;
                                *(v4f*)d = (v4f){v[0], v[1], v[2], v[3]}; *(v4f*)(d + 4) = (v4f){v[4], v[5], v[6], v[7]}; }
                            else if (!prm || t >= SEQ - WINBUF) { float* d = out + (prm ? O_WINP + ((size_t)b * WINBUF + t - (SEQ - WINBUF)) * KV2 : O_WINS + ((size_t)b * WINBUF + WINBUF - DEC_SEQ + t) * KV2) + c;
                                *(v4f*)d = (v4f){v[0], v[1], v[2], v[3]}; *(v4f*)(d + 4) = (v4f){v[4], v[5], v[6], v[7]}; }
                            if (prm && sg3 > 0) { const int x = c / KVW, g = (c % KVW) / HD, dd = c % HD;
                                bf16_t* base = (bf16_t*)(ws + (sg3 == 1 ? (x ? WSL.SELV : WSL.SELK) : (x ? WSL.WINV : WSL.WINK)));
                                *(v4u*)(base + ((size_t)(b * NKV + g) * SEQ + t) * HD + dd) = pack8(v); } }
                    } else if (SEG == 6) {
#pragma unroll
                        for (int e = 0; e < 8; ++e) v[e] = 1.0f / (1.0f + __expf(-v[e]));
                        NT_ST(((bf16_t*)(ws + WSL.GMs)) + (size_t)row * (2 * D) + (col - E_GM), pack8(v));
                    } else if (cl < SMW) {
#pragma unroll
                        for (int e = 0; e < 8; ++e) { const int c = cl + e;
                            v[e] = c < GH ? -__expf(A_log[c]) * softplus_f(v[e] + dt_bias[c]) : 1.0f / (1.0f + __expf(-v[e])); }
                        float* d = ((float*)(ws + WSL.SMf)) + (size_t)row * SMW + cl; *(v4f*)d = (v4f){v[0], v[1], v[2], v[3]}; *(v4f*)(d + 4) = (v4f){v[4], v[5], v[6], v[7]};
                    }
                }
            }
    }
    __device__ __forceinline__ void operator()(const pg8::f32x4 (&acc)[2][2][4][2], const pg8::Unit& u, int wr, int wc, int fr, int fq) const {
        const int col0 = u.pn * 256, rowb = u.pm * 256 + wr * 64 + fr, clb = wc * 32 + 8 * fq;
        if (col0 < E_ZA) seg<0>(acc, col0, rowb, clb); else if (col0 < E_QN) seg<1>(acc, col0, rowb, clb); else if (col0 < E_CMP) seg<2>(acc, col0, rowb, clb);
        else if (col0 < E_SEL) seg<3>(acc, col0, rowb, clb); else if (col0 < E_WIN) seg<4>(acc, col0, rowb, clb); else if (col0 < E_GM) seg<5>(acc, col0, rowb, clb);
        else if (col0 < E_SM) seg<6>(acc, col0, rowb, clb); else seg<7>(acc, col0, rowb, clb);
    }
};
template <int FORCE> struct EpiProbe {
    static constexpr bool PERM = true, AFTER_DRAIN = false;
    bf16_t* dummy;
    __device__ __forceinline__ void operator()(const pg8::f32x4 (&acc)[2][2][4][2], const pg8::Unit& u, int wr, int wc, int fr, int fq) const {
        const int col0 = u.pn * 256, rowb = u.pm * 256 + wr * 64 + fr, clb = wc * 32 + 8 * fq;
#pragma unroll
        for (int ai = 0; ai < 2; ++ai)
#pragma unroll
            for (int m = 0; m < 4; ++m) { const int row = rowb + ai * 128 + m * 16;
#pragma unroll
                for (int bj = 0; bj < 2; ++bj) { const int col = col0 + bj * 128 + clb; float v[8];
#pragma unroll
                    for (int e = 0; e < 4; ++e) { v[e] = acc[ai][bj][m][0][e]; v[4 + e] = acc[ai][bj][m][1][e]; }
                    if (FORCE == 1) {
#pragma unroll
                        for (int e = 0; e < 8; ++e) v[e] = v[e] / (1.0f + __expf(-v[e])); }
                    if (FORCE == 2) { float* d = (float*)dummy + (size_t)row * (NPROJ / 2) + (col >> 1) / 4 * 4;
                        *(v4f*)d = (v4f){v[0], v[1], v[2], v[3]}; }
                    *(v4u*)(dummy + (size_t)row * NPROJ + col) = pack8(v); } }
    }
};
}
DEVFN void st_prep_weights_fast(const Params& p, float* sm) {
    tr_fast(p.w_in, D, PROJ, NPROJ, p.Wt_in(), sm, ip::SrcIn{});
}
constexpr int TRI_O = (D / 64) * (D / 64), TRI_FI = (D / 64) * (2 * FFN / 64), TRI_FO = (FFN / 64) * (D / 64), TRI_PG = (D / 64) * (D / 64), TRI_PL = (PLE / 64) * (D / 64);
constexpr int TRU = 64;
constexpr int TRN_O = (TRI_O + TRU - 1) / TRU, TRN_FI = (TRI_FI + TRU - 1) / TRU, TRN_FO = (TRI_FO + TRU - 1) / TRU, TRN_PG = (TRI_PG + TRU - 1) / TRU, TRN_PL = (TRI_PL + TRU - 1) / TRU;
constexpr int TRN_ALL = TRN_O + TRN_FI + TRN_FO + TRN_PG + TRN_PL;
DEVFN void tr_filler_unit(const Params& p, float* sm, int u) {
    __syncthreads();
    int v = u;
    if (v < TRN_O) { const int a = v * TRU, b = a + TRU < TRI_O ? a + TRU : TRI_O; tr_range(p.w_o, D, D, D, p.Wt_o(), sm, SrcIdent{}, a, b, 8); return; } v -= TRN_O;
    if (v < TRN_FI) { const int a = v * TRU, b = a + TRU < TRI_FI ? a + TRU : TRI_FI; tr_range(p.w_ffn_in, D, 2 * FFN, 2 * FFN, p.Wt_ffi(), sm, SrcFfnIn{}, a, b, 8); return; } v -= TRN_FI;
    if (v < TRN_FO) { const int a = v * TRU, b = a + TRU < TRI_FO ? a + TRU : TRI_FO; tr_range(p.w_ffn_out, FFN, D, D, p.Wt_ffo(), sm, SrcIdent{}, a, b, 8); return; } v -= TRN_FO;
    if (v < TRN_PG) { const int a = v * TRU, b = a + TRU < TRI_PG ? a + TRU : TRI_PG; tr_range(p.w_ple_gate, D, D, D, p.Wt_pg(), sm, SrcIdent{}, a, b, 8); return; } v -= TRN_PG;
    { const int a = v * TRU, b = a + TRU < TRI_PL ? a + TRU : TRI_PL; tr_range(p.w_ple, PLE, D, D, p.Wt_ple(), sm, SrcIdent{}, a, b, 8); }
}
struct EpiSwiGLU {
    static constexpr bool PERM = true, AFTER_DRAIN = false;
    bf16_t* O; int ldc;
    __device__ __forceinline__ void operator()(const pg8::f32x4 (&acc)[2][2][4][2], const pg8::Unit& u, int wr, int wc, int fr, int fq) const {
        const int row0 = u.pm * 256 + wr * 64 + fr, col0 = u.pn * 128 + wc * 32 + 8 * fq;
#pragma unroll
        for (int ai = 0; ai < 2; ++ai)
#pragma unroll
            for (int m = 0; m < 4; ++m) { float v[8];
#pragma unroll
                for (int n = 0; n < 2; ++n)
#pragma unroll
                    for (int e = 0; e < 4; ++e) { const float g = acc[ai][0][m][n][e], up = acc[ai][1][m][n][e]; v[4 * n + e] = g / (1.0f + __expf(-g)) * up; }
                v4u w; w.x = pk2bf(v[0], v[1]); w.y = pk2bf(v[2], v[3]); w.z = pk2bf(v[4], v[5]); w.w = pk2bf(v[6], v[7]);
                NT_ST(O + (size_t)(row0 + ai * 128 + m * 16) * ldc + col0, w); }
    }
};
struct EpiFinal {
    static constexpr bool PERM = false, AFTER_DRAIN = false;
    const bf16_t* X2; const bf16_t* PL; float* out;
    __device__ __forceinline__ void operator()(const pg8::f32x4 (&acc)[2][2][4][2], const pg8::Unit& u, int wr, int wc, int fr, int fq) const {
        const int row0 = u.pm * 256 + wr * 64 + fr, col0 = u.pn * 256 + wc * 32 + 4 * fq;
#pragma unroll
        for (int ai = 0; ai < 2; ++ai)
#pragma unroll
            for (int m = 0; m < 4; ++m) { const int row = row0 + ai * 128 + m * 16; if (row >= M) continue;
                float* orow = row < MPR ? out + O_YP + (size_t)row * D : out + O_YS + (size_t)(row - MPR) * D;
                unsigned long long xq[2][2], pq[2][2];
#pragma unroll
                for (int bj = 0; bj < 2; ++bj)
#pragma unroll
                    for (int n = 0; n < 2; ++n) { const int col = col0 + bj * 128 + n * 16;
                        xq[bj][n] = *(const unsigned long long*)(X2 + (size_t)row * D + col); pq[bj][n] = *(const unsigned long long*)(PL + (size_t)row * D + col); }
#pragma unroll
                for (int bj = 0; bj < 2; ++bj)
#pragma unroll
                    for (int n = 0; n < 2; ++n) { const int col = col0 + bj * 128 + n * 16;
                        const v4f x2 = bf4_unpack(xq[bj][n]), pl = bf4_unpack(pq[bj][n]); const pg8::f32x4 a = acc[ai][bj][m][n]; v4f y;
#pragma unroll
                        for (int e = 0; e < 4; ++e) y[e] = x2[e] + pl[e] / (1.0f + __expf(-a[e]));
                        *(v4f*)(orow + col) = y; } }
    }
};
DEVFN void st_merge_fast(const Params& p) {
    const int t = tid_now(), c0 = 4 * t;
    const v4f gw = *(const v4f*)(p.gdn_norm_w + (c0 & (HD - 1)));
    constexpr int MR = 4;
    for (int m0 = blockIdx.x; m0 < MPR; m0 += MR * gridDim.x) {
        unsigned long long oq[MR], nq[MR], zq[MR], gaq[MR], gnq[MR];
#pragma unroll
        for (int k = 0; k < MR; ++k) { const int m = m0 + k * (int)gridDim.x, ml = m < MPR ? m : 0;
            oq[k] = *(const unsigned long long*)(p.OAh() + (size_t)ml * GW + c0); nq[k] = *(const unsigned long long*)(p.Onh() + (size_t)ml * NSAW + c0);
            zq[k] = *(const unsigned long long*)(p.ZAs() + (size_t)ml * GW + c0); gaq[k] = *(const unsigned long long*)(p.GMs() + (size_t)ml * 2 * D + c0);
            gnq[k] = *(const unsigned long long*)(p.GMs() + (size_t)ml * 2 * D + D + c0); }
#pragma unroll
        for (int k = 0; k < MR; ++k) { const int m = m0 + k * (int)gridDim.x;
            const v4f o = bf4_unpack(oq[k]), on = bf4_unpack(nq[k]), za = bf4_unpack(zq[k]), ga = bf4_unpack(gaq[k]), gn = bf4_unpack(gnq[k]);
            float ss = o[0] * o[0] + o[1] * o[1] + o[2] * o[2] + o[3] * o[3];
#pragma unroll
            for (int sft = 1; sft < 32; sft <<= 1) ss += __shfl_xor(ss, sft);
            const float r = 1.0f / sqrtf(ss * (1.0f / HD) + RMS_EPS);
            float v[4];
#pragma unroll
            for (int e = 0; e < 4; ++e) v[e] = o[e] * r * gw[e] * za[e] * ga[e] + on[e] * gn[e];
            if (m < MPR) *(unsigned long long*)(p.MIX() + (size_t)m * D + c0) = (unsigned long long)pk2bf(v[0], v[1]) | ((unsigned long long)pk2bf(v[2], v[3]) << 32); }
    }
    for (int m = MPR + blockIdx.x; m < MPAD; m += gridDim.x) {
        bf16_t* dst = p.MIX() + (size_t)m * D + c0;
        if (m >= M) { *(unsigned long long*)dst = 0ull; continue; }
        const v4f o = *(const v4f*)(p.OA() + (size_t)m * GW + c0);
        float ss = o[0] * o[0] + o[1] * o[1] + o[2] * o[2] + o[3] * o[3];
#pragma unroll
        for (int sft = 1; sft < 32; sft <<= 1) ss += __shfl_xor(ss, sft);
        const float r = 1.0f / sqrtf(ss * (1.0f / HD) + RMS_EPS);
        const v4f on = *(const v4f*)(p.On() + (size_t)m * NSAW + c0);
        const v4f za = load_bf4(p.ZAs() + (size_t)m * GW + c0), ga = load_bf4(p.GMs() + (size_t)m * 2 * D + c0), gn = load_bf4(p.GMs() + (size_t)m * 2 * D + D + c0);
        float v[4];
#pragma unroll
        for (int e = 0; e < 4; ++e) v[e] = o[e] * r * gw[e] * za[e] * ga[e] + on[e] * gn[e];
        *(unsigned long long*)dst = (unsigned long long)pk2bf(v[0], v[1]) | ((unsigned long long)pk2bf(v[2], v[3]) << 32);
    }
}
#endif
#ifndef CPU_SHIM
namespace ns {
constexpr float LOG2E = 1.4426950408889634f;
struct Src {
    const Params p;
    __device__ __forceinline__ float q2(int m, int col) const { return bf2f(p.QN()[(size_t)m * NSAW + col]); }
    __device__ __forceinline__ float gate(int m, int idx) const { return p.SMf()[(size_t)m * 128 + 2 * GH + idx]; }
    __device__ __forceinline__ const float* selnew(int bs, int tt, int x, int g) const { return p.out + O_SELS + (size_t)(bs * DEC_SEQ + tt) * KV2 + x * KVW + g * HD; }
    __device__ __forceinline__ const float* winnew(int bs, int tt, int x, int g) const { return p.out + O_WINS + ((size_t)bs * WINBUF + WINBUF - DEC_SEQ + tt) * KV2 + x * KVW + g * HD; }
};
constexpr int SW = 1024;
template <class RowPtr, class Pos> __device__ __forceinline__ void scores(float* ssc, const float* sq, const float* sslope, int nkeys, int tpos, RowPtr rowptr, Pos pos) {
    const int tid = tid_now(), grp = tid >> 4, l16 = tid & 15;
    float q[4][8];
#pragma unroll
    for (int h = 0; h < 4; ++h)
#pragma unroll
        for (int e = 0; e < 8; ++e) q[h][e] = sq[h * HD + l16 * 8 + e];
    constexpr int UN = 8;
    for (int k0 = grp; k0 < nkeys; k0 += 32 * UN) {
        v4f x0[UN], x1[UN]; int kp[UN]; bool valid[UN];
#pragma unroll
        for (int u = 0; u < UN; ++u) { const int k = k0 + 32 * u; const bool in = k < nkeys; kp[u] = in ? pos(k) : 0x7fffffff; valid[u] = in && kp[u] <= tpos && kp[u] >= 0;
            if (valid[u]) { const float* r = rowptr(k) + l16 * 8; x0[u] = *(const v4f*)r; x1[u] = *(const v4f*)(r + 4); } else { x0[u] = (v4f){0.f, 0.f, 0.f, 0.f}; x1[u] = x0[u]; } }
#pragma unroll
        for (int u = 0; u < UN; ++u) { const int k = k0 + 32 * u; float a[4];
#pragma unroll
            for (int h = 0; h < 4; ++h) { a[h] = q[h][0] * x0[u][0] + q[h][1] * x0[u][1] + q[h][2] * x0[u][2] + q[h][3] * x0[u][3] + q[h][4] * x1[u][0] + q[h][5] * x1[u][1] + q[h][6] * x1[u][2] + q[h][7] * x1[u][3];
                a[h] += __shfl_xor(a[h], 1); a[h] += __shfl_xor(a[h], 2); a[h] += __shfl_xor(a[h], 4); a[h] += __shfl_xor(a[h], 8); }
            if (l16 < 4 && k < nkeys) { const float v = l16 == 0 ? a[0] : l16 == 1 ? a[1] : l16 == 2 ? a[2] : a[3];
                ssc[l16 * SW + k] = valid[u] ? v + sslope[l16] * (float)(kp[u] - tpos) : -1.0e30f; } }
    }
}
__device__ __forceinline__ void softmax4(float* ssc, int n) {
    const int wave = tid_now() >> 6, lane = tid_now() & 63;
    if (wave < 4) { float* row = ssc + wave * SW; float mx = -3.0e38f;
        for (int i = lane; i < n; i += 64) mx = fmaxf(mx, row[i]);
#pragma unroll
        for (int s = 1; s < 64; s <<= 1) mx = fmaxf(mx, __shfl_xor(mx, s));
        float sum = 0.f;
        for (int i = lane; i < n; i += 64) { const float s = row[i]; const float e = s > -1.0e29f ? exp2f(s - mx) : 0.f; row[i] = e; sum += e; }
#pragma unroll
        for (int s = 1; s < 64; s <<= 1) sum += __shfl_xor(sum, s);
        const float inv = sum > 0.f ? 1.0f / sum : 0.f;
        for (int i = lane; i < n; i += 64) row[i] *= inv; }
}
template <class RowPtr> __device__ __forceinline__ void pv(float* sacc  , const float* ssc, int nkeys, RowPtr vrow) {
    const int wave = tid_now() >> 6, lane = tid_now() & 63;
    float a[4][2] = {{0.f, 0.f}, {0.f, 0.f}, {0.f, 0.f}, {0.f, 0.f}};
    constexpr int UN = 16;
    for (int k0 = wave; k0 < nkeys; k0 += 8 * UN) {
        float x0[UN], x1[UN], pp[UN][4];
#pragma unroll
        for (int u = 0; u < UN; ++u) { const int k = k0 + 8 * u; const bool in = k < nkeys;
            pp[u][0] = in ? ssc[k] : 0.f; pp[u][1] = in ? ssc[SW + k] : 0.f; pp[u][2] = in ? ssc[2 * SW + k] : 0.f; pp[u][3] = in ? ssc[3 * SW + k] : 0.f;
            if (pp[u][0] != 0.f || pp[u][1] != 0.f || pp[u][2] != 0.f || pp[u][3] != 0.f) { const float* r = vrow(k) + 2 * lane; x0[u] = r[0]; x1[u] = r[1]; } else { x0[u] = 0.f; x1[u] = 0.f; } }
#pragma unroll
        for (int u = 0; u < UN; ++u) {
#pragma unroll
            for (int h = 0; h < 4; ++h) { a[h][0] += pp[u][h] * x0[u]; a[h][1] += pp[u][h] * x1[u]; } }
    }
#pragma unroll
    for (int h = 0; h < 4; ++h) { sacc[(wave * 4 + h) * HD + 2 * lane] = a[h][0]; sacc[(wave * 4 + h) * HD + 2 * lane + 1] = a[h][1]; }
}
}
DEVFN void st_nsa_sample_unit(const Params& p, float* sm, int u) {
    using namespace ns;
    float* sq = sm; float* sgate = sq + 4 * HD; float* sslope = sgate + 16; float* so = sslope + 4; float* sscore = so + 4 * HD; int* sidx = (int*)(sscore + 272);
    float* ssc = (float*)(sidx + 16); float* sacc = ssc + 4 * SW;
    long long* sbase = (long long*)(sacc + 8 * 4 * HD);
    const Src S{p}; const int tid = tid_now();
    {
        const int g = u % NKV, mm = u / NKV, bs = mm / DEC_SEQ, tt = mm % DEC_SEQ, m = MPR + mm, tpos = PAST + tt;
        __syncthreads();
        if (tid < 4 * HD) sq[tid] = S.q2(m, g * 4 * HD + tid);
        if (tid < 12) sgate[tid] = S.gate(m, g * 12 + tid);
        if (tid < 4) sslope[tid] = exp2f(-8.0f * (float)(g * 4 + tid + 1) / (float)NH) * LOG2E;
        __syncthreads();
        const float* kvc = p.KVCs() + (size_t)bs * NCS * KV2;
        scores(ssc, sq, sslope, NCS, tpos, [=](int n) { return kvc + (size_t)n * KV2 + g * HD; }, [=](int n) { return 32 * n + 31; });
        __syncthreads();
        softmax4(ssc, NCS);
        __syncthreads();
        pv(sacc, ssc, NCS, [=](int n) { return kvc + (size_t)n * KV2 + KVW + g * HD; });
        for (int j = tid; j < NSS; j += 512) { float imp = 0.f;
#pragma unroll
            for (int r = 0; r < 4; ++r) { if (2 * j < NCS) imp += ssc[r * SW + 2 * j]; if (2 * j + 1 < NCS) imp += ssc[r * SW + 2 * j + 1]; }
            const int cur = tpos / 64; const bool forced = (j == 0) || (j == cur) || (j == cur - 1), avail = j * 64 <= tpos;
            sscore[j] = forced ? imp + FORCE_BONUS : (avail ? imp : -1.0f); }
        __syncthreads();
        if (tid < 4 * HD) { const int h = tid / HD, d = tid % HD; float a = 0.f;
#pragma unroll
            for (int w = 0; w < 8; ++w) a += sacc[(w * 4 + h) * HD + d];
            so[tid] = sgate[h * 3 + 0] * a; }
        for (int j = tid; j < NSS; j += 512) { const float s = sscore[j]; int cnt = 0;
            for (int k = 0; k < NSS; ++k) { const float sk = sscore[k]; cnt += (sk > s || (sk == s && k < j)) ? 1 : 0; }
            if (cnt < KSEL_S) sidx[cnt] = j; }
        __syncthreads();
        if (tid < KSEL_S) { const int kpos0 = sidx[tid] * 64;
            sbase[tid] = kpos0 < PAST ? (long long)(((size_t)p.page_table[bs * N_PAGES + kpos0 / PAGE] * PAGE + kpos0 % PAGE) * KV2) : -1ll; }
        __syncthreads();
        auto selptr = [=](int kk, int x) -> const float* { const long long bo = sbase[kk >> 6]; const int r = kk & 63;
            if (bo >= 0) return p.cache_sel + (size_t)bo + (size_t)r * KV2 + x * KVW + g * HD;
            return S.selnew(bs, r < DEC_SEQ ? r : DEC_SEQ - 1, x, g); };
        scores(ssc, sq, sslope, KSEL_S * 64, tpos, [=](int kk) { return selptr(kk, 0); }, [=](int kk) { return sidx[kk >> 6] * 64 + (kk & 63); });
        __syncthreads();
        softmax4(ssc, KSEL_S * 64);
        __syncthreads();
        pv(sacc, ssc, KSEL_S * 64, [=](int kk) { return selptr(kk, 1); });
        __syncthreads();
        if (tid < 4 * HD) { const int h = tid / HD, d = tid % HD; float a = 0.f;
#pragma unroll
            for (int w = 0; w < 8; ++w) a += sacc[(w * 4 + h) * HD + d];
            so[tid] += sgate[h * 3 + 1] * a; }
        auto winptr = [=](int kk, int x) -> const float* { const int wpos = tpos - (WINDOW - 1) + kk;
            if (wpos < PAST) return p.state_win + ((size_t)bs * WINBUF + (wpos - (PAST - WINBUF))) * KV2 + x * KVW + g * HD;
            return S.winnew(bs, wpos - PAST, x, g); };
        scores(ssc, sq, sslope, WINDOW, tpos, [=](int kk) { return winptr(kk, 0); }, [=](int kk) { return tpos - (WINDOW - 1) + kk; });
        __syncthreads();
        softmax4(ssc, WINDOW);
        __syncthreads();
        pv(sacc, ssc, WINDOW, [=](int kk) { return winptr(kk, 1); });
        __syncthreads();
        if (tid < 4 * HD) { const int h = tid / HD, d = tid % HD; float a = 0.f;
#pragma unroll
            for (int w = 0; w < 8; ++w) a += sacc[(w * 4 + h) * HD + d];
            p.On()[(size_t)m * NSAW + g * 4 * HD + tid] = so[tid] + sgate[h * 3 + 2] * a; }
    }
}
#endif
#ifndef CPU_SHIM
__device__ __forceinline__ float wave_sum64(float v) {
#pragma unroll
    for (int o = 1; o < 64; o <<= 1) v += __shfl_xor(v, o);
    return v;
}
constexpr int RV = D / 256;
__device__ __forceinline__ void store_bf4(bf16_t* dst, v4f v) { *(unsigned long long*)dst = (unsigned long long)pk2bf(v[0], v[1]) | ((unsigned long long)pk2bf(v[2], v[3]) << 32); }
DEVFN void st_prep_rows_fast(const Params& p) {
    const int lane = tid_now() & 63, wave = tid_now() >> 6, stride = (int)gridDim.x * 8;
    for (int m0 = blockIdx.x * 8 + wave; m0 < MPAD; m0 += 2 * stride) {
        v4f xv[2][RV], plv[2];
#pragma unroll
        for (int k = 0; k < 2; ++k) { const int m = m0 + k * stride, ml = m < M ? m : 0;
            const float* x = x_row(p, ml) + 4 * lane;
#pragma unroll
            for (int j = 0; j < RV; ++j) xv[k][j] = *(const v4f*)(x + 256 * j);
            plv[k] = *(const v4f*)((ml < MPR ? p.p_prompt + (size_t)ml * PLE : p.p_sample + (size_t)(ml - MPR) * PLE) + 4 * lane); }
#pragma unroll
        for (int k = 0; k < 2; ++k) { const int m = m0 + k * stride; if (m >= MPAD) continue;
            bf16_t* h = p.H1() + (size_t)m * D + 4 * lane; bf16_t* pb = p.Pbf() + (size_t)m * PLE + 4 * lane;
            if (m >= M) {
#pragma unroll
                for (int j = 0; j < RV; ++j) *(unsigned long long*)(h + 256 * j) = 0ull;
                *(unsigned long long*)pb = 0ull; continue; }
            float ss = 0.f;
#pragma unroll
            for (int j = 0; j < RV; ++j) ss += xv[k][j][0] * xv[k][j][0] + xv[k][j][1] * xv[k][j][1] + xv[k][j][2] * xv[k][j][2] + xv[k][j][3] * xv[k][j][3];
            const float r = 1.0f / sqrtf(wave_sum64(ss) * (1.0f / D) + RMS_EPS);
#pragma unroll
            for (int j = 0; j < RV; ++j) { const v4f g = *(const v4f*)(p.g_pre1 + 4 * lane + 256 * j); store_bf4(h + 256 * j, xv[k][j] * r * g); }
            store_bf4(pb, plv[k]); }
    }
}
DEVFN void st_norm1_fast(const Params& p) {
    const int lane = tid_now() & 63, wave = tid_now() >> 6, stride = (int)gridDim.x * 8;
    for (int m0 = blockIdx.x * 8 + wave; m0 < MPAD; m0 += 2 * stride) {
        v4f tv[2][RV], xv[2][RV];
#pragma unroll
        for (int k = 0; k < 2; ++k) { const int m = m0 + k * stride, ml = m < M ? m : 0;
            const bf16_t* t1 = p.T1b() + (size_t)ml * D + 4 * lane; const float* x = x_row(p, ml) + 4 * lane;
#pragma unroll
            for (int j = 0; j < RV; ++j) { tv[k][j] = load_bf4(t1 + 256 * j); xv[k][j] = *(const v4f*)(x + 256 * j); } }
#pragma unroll
        for (int k = 0; k < 2; ++k) { const int m = m0 + k * stride; if (m >= MPAD) continue;
            bf16_t* h2 = p.H2() + (size_t)m * D + 4 * lane;
            if (m >= M) {
#pragma unroll
                for (int j = 0; j < RV; ++j) *(unsigned long long*)(h2 + 256 * j) = 0ull;
                continue; }
            bf16_t* x1 = p.X1h() + (size_t)m * D + 4 * lane; float ss = 0.f;
#pragma unroll
            for (int j = 0; j < RV; ++j) ss += tv[k][j][0] * tv[k][j][0] + tv[k][j][1] * tv[k][j][1] + tv[k][j][2] * tv[k][j][2] + tv[k][j][3] * tv[k][j][3];
            const float r1 = 1.0f / sqrtf(wave_sum64(ss) * (1.0f / D) + RMS_EPS); ss = 0.f;
#pragma unroll
            for (int j = 0; j < RV; ++j) { const v4f g = *(const v4f*)(p.g_post1 + 4 * lane + 256 * j); const v4f y = xv[k][j] + tv[k][j] * r1 * g; tv[k][j] = y; store_bf4(x1 + 256 * j, y);
                ss += y[0] * y[0] + y[1] * y[1] + y[2] * y[2] + y[3] * y[3]; }
            const float r2 = 1.0f / sqrtf(wave_sum64(ss) * (1.0f / D) + RMS_EPS);
#pragma unroll
            for (int j = 0; j < RV; ++j) { const v4f g = *(const v4f*)(p.g_pre2 + 4 * lane + 256 * j); store_bf4(h2 + 256 * j, tv[k][j] * r2 * g); } }
    }
}
DEVFN void st_norm2_fast(const Params& p) {
    const int lane = tid_now() & 63, wave = tid_now() >> 6, stride = (int)gridDim.x * 8;
    for (int m0 = blockIdx.x * 8 + wave; m0 < MPAD; m0 += 2 * stride) {
        v4f tv[2][RV], xv[2][RV];
#pragma unroll
        for (int k = 0; k < 2; ++k) { const int m = m0 + k * stride, ml = m < M ? m : 0;
            const bf16_t* t2 = p.T2b() + (size_t)ml * D + 4 * lane; const bf16_t* x1 = p.X1h() + (size_t)ml * D + 4 * lane;
#pragma unroll
            for (int j = 0; j < RV; ++j) { tv[k][j] = load_bf4(t2 + 256 * j); xv[k][j] = load_bf4(x1 + 256 * j); } }
#pragma unroll
        for (int k = 0; k < 2; ++k) { const int m = m0 + k * stride; if (m >= MPAD) continue;
            bf16_t* xb = p.X2b() + (size_t)m * D + 4 * lane;
            if (m >= M) {
#pragma unroll
                for (int j = 0; j < RV; ++j) *(unsigned long long*)(xb + 256 * j) = 0ull;
                continue; }
            float ss = 0.f;
#pragma unroll
            for (int j = 0; j < RV; ++j) ss += tv[k][j][0] * tv[k][j][0] + tv[k][j][1] * tv[k][j][1] + tv[k][j][2] * tv[k][j][2] + tv[k][j][3] * tv[k][j][3];
            const float r = 1.0f / sqrtf(wave_sum64(ss) * (1.0f / D) + RMS_EPS);
#pragma unroll
            for (int j = 0; j < RV; ++j) { const v4f g = *(const v4f*)(p.g_post2 + 4 * lane + 256 * j); store_bf4(xb + 256 * j, xv[k][j] + tv[k][j] * r * g); } }
    }
}
#endif
#ifndef CPU_SHIM
namespace gd {
using na::bf16x8; using na::f32x16; using na::s16x4;
constexpr int TILE = 64 * HD * 2;
constexpr int G1_KT = 0, G1_QT = G1_KT + TILE, G1_KB = G1_QT + TILE, G1_VB = G1_KB + TILE, G1_LM = G1_VB + TILE, G1_TF = G1_LM + 64 * 68 * 4, G1_TB = G1_TF + 64 * 68 * 4,
              G1_RF = G1_TB + 64 * 144, G1_SM = G1_RF + 16 * 64 * 4, G1_CW = G1_SM + 4 * 64 * 4, G1_END = G1_CW + 3 * 4 * 128 * 4;
__device__ __forceinline__ bf16_t bf1(float f) { return (bf16_t)(pk2bf(f, 0.f) & 0xffffu); }
typedef _Float16 h16x8 __attribute__((ext_vector_type(8)));
__device__ __forceinline__ bf16_t h1(float f) { const _Float16 h = (_Float16)f; return __builtin_bit_cast(unsigned short, h); }
__device__ __forceinline__ unsigned pk2h(float lo, float hi) { return (unsigned)h1(lo) | ((unsigned)h1(hi) << 16); }
template <int D0> __device__ __forceinline__ void pvh_one(f32x16& od, int vb, bf16x8 pa0, bf16x8 pa1, bf16x8 pa2, bf16x8 pa3) {
    const s16x4 l0 = na::tr_read<na::v_rd_off(D0, 0, 0)>(vb), h0 = na::tr_read<na::v_rd_off(D0, 0, 1)>(vb), l1 = na::tr_read<na::v_rd_off(D0, 1, 0)>(vb), h1_ = na::tr_read<na::v_rd_off(D0, 1, 1)>(vb);
    const s16x4 l2 = na::tr_read<na::v_rd_off(D0, 2, 0)>(vb), h2 = na::tr_read<na::v_rd_off(D0, 2, 1)>(vb), l3 = na::tr_read<na::v_rd_off(D0, 3, 0)>(vb), h3 = na::tr_read<na::v_rd_off(D0, 3, 1)>(vb);
    asm volatile("s_waitcnt lgkmcnt(0)" ::: "memory"); __builtin_amdgcn_sched_barrier(0);
#define GD_PK(L, H) __builtin_bit_cast(h16x8, (bf16x8){L[0], L[1], L[2], L[3], H[0], H[1], H[2], H[3]})
    od = __builtin_amdgcn_mfma_f32_32x32x16_f16(__builtin_bit_cast(h16x8, pa0), GD_PK(l0, h0), od, 0, 0, 0);
    od = __builtin_amdgcn_mfma_f32_32x32x16_f16(__builtin_bit_cast(h16x8, pa1), GD_PK(l1, h1_), od, 0, 0, 0);
    od = __builtin_amdgcn_mfma_f32_32x32x16_f16(__builtin_bit_cast(h16x8, pa2), GD_PK(l2, h2), od, 0, 0, 0);
    od = __builtin_amdgcn_mfma_f32_32x32x16_f16(__builtin_bit_cast(h16x8, pa3), GD_PK(l3, h3), od, 0, 0, 0);
#undef GD_PK
}
__device__ __forceinline__ void pvh_blk(f32x16& od, int db, int vb, bf16x8 a0, bf16x8 a1, bf16x8 a2, bf16x8 a3) {
    if (db == 0) pvh_one<0>(od, vb, a0, a1, a2, a3); else if (db == 1) pvh_one<1>(od, vb, a0, a1, a2, a3);
    else if (db == 2) pvh_one<2>(od, vb, a0, a1, a2, a3); else pvh_one<3>(od, vb, a0, a1, a2, a3);
}
template <int NDB> struct PvSel;
__device__ __forceinline__ void pv_blk(f32x16& od, int db, int vb, bf16x8 a0, bf16x8 a1, bf16x8 a2, bf16x8 a3) {
    if (db == 0) na::pv_one<0>(od, vb, a0, a1, a2, a3); else if (db == 1) na::pv_one<1>(od, vb, a0, a1, a2, a3);
    else if (db == 2) na::pv_one<2>(od, vb, a0, a1, a2, a3); else na::pv_one<3>(od, vb, a0, a1, a2, a3);
}
}
DEVFN void st_gdn_g1_mfma(const Params& p, char* lds) {
    using namespace gd;
    float* Lm = (float*)(lds + G1_LM); float* Tf = (float*)(lds + G1_TF); bf16_t* Tb = (bf16_t*)(lds + G1_TB); float* Rf = (float*)(lds + G1_RF);
    float* gcs = (float*)(lds + G1_SM); float* bet = gcs + 64;
    float* cw = (float*)(lds + G1_CW);
    constexpr int UPW = 8;
    static_assert(NCHK % UPW == 0, "chunks per sequence");
    for (int blk = blockIdx.x; blk < BATCH * GH * NCHK / UPW; blk += gridDim.x) {
      { const int tid = tid_now(), h = (blk * UPW / NCHK) % GH;
        __syncthreads();
        if (tid < 384) { const int idx = tid * 4, part = idx / 512, j = (idx / 128) % 4, d = idx % 128; *(v4f*)(cw + idx) = *(const v4f*)(p.conv_w + (size_t)j * 3 * GW + part * GW + h * HD + d); }
        __syncthreads(); }
      for (int k8 = 0; k8 < UPW; ++k8) {
        const int u = blk * UPW + k8;
        const int tid = tid_now(), wave = tid >> 6, lane = tid & 63, r32 = lane & 31, hi = lane >> 5;
        const int c = u % NCHK, h = (u / NCHK) % GH, b = u / (NCHK * GH); const int m0 = b * SEQ + c * GC; const size_t cu = (size_t)u;
        const int r = tid >> 3, sg = tid & 7, t = c * GC + r;
        for (int rep1 = 0; rep1 < (DUP_PHASE == 221 ? 2 : 1); ++rep1) {
        float gcl, btl;
        { const float* z = p.SMf() + (size_t)(m0 + lane) * ip::SMW; gcl = z[h]; btl = z[GH + h];
#pragma unroll
          for (int s2 = 1; s2 < 64; s2 <<= 1) { const float o = __shfl_up(gcl, s2); if (lane >= s2) gcl += o; }
          if (wave == 0) { gcs[lane] = gcl; bet[lane] = btl; } }
        float xq[16], xk[16], xv[16];
        {
            float ssq = 0.f, ssk = 0.f;
#pragma unroll
            for (int part = 0; part < 3; ++part) {
                const int ch0 = part * GW + h * HD + sg * 16;
                float a[16];
#pragma unroll
                for (int e = 0; e < 16; ++e) a[e] = 0.f;
#pragma unroll
                for (int j = 0; j < 4; ++j) { const int tt = t + j - 3;
                    if (tt >= 0) { const bf16_t* z = p.QKVb() + (size_t)(b * SEQ + tt) * (3 * GW) + ch0; const float* w = cw + (part * 4 + j) * 128 + sg * 16;
#pragma unroll
                        for (int e8 = 0; e8 < 2; ++e8) { const v4u zv = *(const v4u*)(z + 8 * e8); const v4f w0 = *(const v4f*)(w + 8 * e8), w1 = *(const v4f*)(w + 8 * e8 + 4);
                            a[8 * e8 + 0] += __uint_as_float(zv.x << 16) * w0[0]; a[8 * e8 + 1] += __uint_as_float(zv.x & 0xffff0000u) * w0[1];
                            a[8 * e8 + 2] += __uint_as_float(zv.y << 16) * w0[2]; a[8 * e8 + 3] += __uint_as_float(zv.y & 0xffff0000u) * w0[3];
                            a[8 * e8 + 4] += __uint_as_float(zv.z << 16) * w1[0]; a[8 * e8 + 5] += __uint_as_float(zv.z & 0xffff0000u) * w1[1];
                            a[8 * e8 + 6] += __uint_as_float(zv.w << 16) * w1[2]; a[8 * e8 + 7] += __uint_as_float(zv.w & 0xffff0000u) * w1[3]; } } }
#pragma unroll
                for (int e = 0; e < 16; ++e) { const float v = a[e] / (1.0f + __expf(-a[e])); if (part == 0) { xq[e] = v; ssq += v * v; } else if (part == 1) { xk[e] = v; ssk += v * v; } else xv[e] = v; }
            }
            ssq += __shfl_xor(ssq, 1); ssq += __shfl_xor(ssq, 2); ssq += __shfl_xor(ssq, 4);
            ssk += __shfl_xor(ssk, 1); ssk += __shfl_xor(ssk, 2); ssk += __shfl_xor(ssk, 4);
            const float rq = QSCALE / sqrtf(ssq + RMS_EPS), rk = 1.0f / sqrtf(ssk + RMS_EPS);
#pragma unroll
            for (int e = 0; e < 16; ++e) { xq[e] *= rq; xk[e] *= rk; }
#pragma unroll
            for (int hf = 0; hf < 2; ++hf) { v4u wq, wk;
                wq.x = pk2bf(xq[8 * hf + 0], xq[8 * hf + 1]); wq.y = pk2bf(xq[8 * hf + 2], xq[8 * hf + 3]); wq.z = pk2bf(xq[8 * hf + 4], xq[8 * hf + 5]); wq.w = pk2bf(xq[8 * hf + 6], xq[8 * hf + 7]);
                wk.x = pk2bf(xk[8 * hf + 0], xk[8 * hf + 1]); wk.y = pk2bf(xk[8 * hf + 2], xk[8 * hf + 3]); wk.z = pk2bf(xk[8 * hf + 4], xk[8 * hf + 5]); wk.w = pk2bf(xk[8 * hf + 6], xk[8 * hf + 7]);
                const int off = NA_KSWZ(r, (sg * 16 + hf * 8) * 2);
                *(v4u*)(lds + G1_QT + off) = wq; *(v4u*)(lds + G1_KT + off) = wk; }
        }
        {
            const float gr = __shfl(gcl, r), br = __shfl(btl, r), glast = __shfl(gcl, 63), fk = br * __expf(gr), eq = __expf(gr), ekd = __expf(glast - gr);
#pragma unroll
            for (int hf = 0; hf < 2; ++hf) { v4u wkb, wvb, wqg;
                wkb.x = pk2bf(xk[8 * hf + 0] * fk, xk[8 * hf + 1] * fk); wkb.y = pk2bf(xk[8 * hf + 2] * fk, xk[8 * hf + 3] * fk); wkb.z = pk2bf(xk[8 * hf + 4] * fk, xk[8 * hf + 5] * fk); wkb.w = pk2bf(xk[8 * hf + 6] * fk, xk[8 * hf + 7] * fk);
                wvb.x = pk2bf(xv[8 * hf + 0] * br, xv[8 * hf + 1] * br); wvb.y = pk2bf(xv[8 * hf + 2] * br, xv[8 * hf + 3] * br); wvb.z = pk2bf(xv[8 * hf + 4] * br, xv[8 * hf + 5] * br); wvb.w = pk2bf(xv[8 * hf + 6] * br, xv[8 * hf + 7] * br);
                wqg.x = pk2h(xq[8 * hf + 0] * eq, xq[8 * hf + 1] * eq); wqg.y = pk2h(xq[8 * hf + 2] * eq, xq[8 * hf + 3] * eq); wqg.z = pk2h(xq[8 * hf + 4] * eq, xq[8 * hf + 5] * eq); wqg.w = pk2h(xq[8 * hf + 6] * eq, xq[8 * hf + 7] * eq);
                const int voff = na::v_st(r, sg * 16 + hf * 8);
                *(v4u*)(lds + G1_KB + voff) = wkb; *(v4u*)(lds + G1_VB + voff) = wvb;
                *(v4u*)(p.GQG() + cu * GC * HD + ((size_t)(((r >> 5) * 8 + sg) * 64 + (r & 31) + 32 * hf)) * 8) = wqg; }
#pragma unroll
            for (int e = 0; e < 16; ++e) { const int dd = sg * 16 + e; p.GKD()[cu * GC * HD + ((size_t)(((dd >> 5) * 4 + (r >> 4)) * 64 + (dd & 31) + 32 * ((r >> 3) & 1))) * 8 + (r & 7)] = h1(xk[e] * ekd); }
            if (tid == 0) p.GEL()[cu] = __expf(glast);
        }
        }
        __syncthreads();
        for (int rep4 = 0; rep4 < (DUP_PHASE == 224 ? 2 : 1); ++rep4) {
            const int prod = wave >> 2, half = (wave >> 1) & 1, kh = wave & 1, i = 32 * half + r32;
            f32x16 p0;
#pragma unroll
            for (int q = 0; q < 16; ++q) p0[q] = 0.f;
#pragma unroll
            for (int d0 = 0; d0 < 8; ++d0) { const int cb = (d0 * 16 + hi * 8) * 2;
                const bf16x8 qf = *reinterpret_cast<const bf16x8*>(lds + (prod ? G1_QT : G1_KT) + NA_KSWZ(i, cb));
                const bf16x8 b0 = *reinterpret_cast<const bf16x8*>(lds + G1_KT + NA_KSWZ(32 * kh + r32, cb));
                p0 = __builtin_amdgcn_mfma_f32_32x32x16_bf16(b0, qf, p0, 0, 0, 0); }
            const float gi = gcs[i], bi = bet[i];
            if (prod == 0) {
#pragma unroll
                for (int q = 0; q < 16; ++q) { const int j0 = 32 * kh + na::crow(q, hi);
                    Lm[i * 68 + j0] = j0 < i ? p0[q] * __expf(gi - gcs[j0]) * bi : 0.f; }
            } else {
#pragma unroll
                for (int q4 = 0; q4 < 4; ++q4) {
                    float v0[4];
#pragma unroll
                    for (int e = 0; e < 4; ++e) { const int j0 = 32 * kh + 8 * q4 + 4 * hi + e; v0[e] = j0 <= i ? p0[4 * q4 + e] * __expf(gi - gcs[j0]) : 0.f; }
                    const int j0c = 32 * kh + 8 * q4 + 4 * hi; bf16_t* dst = p.GQK() + cu * GC * GC + ((size_t)(((i >> 5) * 4 + (j0c >> 4)) * 64 + (i & 31) + 32 * ((j0c >> 3) & 1))) * 8 + (j0c & 7);
                    *(unsigned long long*)dst = (unsigned long long)pk2h(v0[0], v0[1]) | ((unsigned long long)pk2h(v0[2], v0[3]) << 32); }
            }
        }
        __syncthreads();
        for (int rep5 = 0; rep5 < (DUP_PHASE == 225 ? 2 : 1); ++rep5) {
        if (wave == 0) {
            { const int a = lane >> 4, cc = lane & 15; f32x16 x;
#pragma unroll
              for (int i = 0; i < 16; ++i) { float s = (i == cc) ? 1.0f : 0.f;
#pragma unroll
                  for (int j = 0; j < i; ++j) s -= Lm[(16 * a + i) * 68 + 16 * a + j] * x[j];
                  x[i] = s; }
#pragma unroll
              for (int i = 0; i < 16; ++i) Tf[(16 * a + i) * 68 + 16 * a + cc] = x[i]; }
            asm volatile("s_waitcnt lgkmcnt(0)" ::: "memory");
            typedef _Float16 h16x4 __attribute__((ext_vector_type(4)));
            const int rw = lane & 15, kq = lane >> 4;
#define G1_LDA(base, rb, cb) ({ const v4f x_ = *(const v4f*)((base) + (16 * (rb) + rw) * 68 + 16 * (cb) + 4 * kq); (h16x4){(_Float16)x_[0], (_Float16)x_[1], (_Float16)x_[2], (_Float16)x_[3]}; })
#define G1_LDB(blk) ((h16x4){(_Float16)Tf[(16 * (blk) + 4 * kq + 0) * 68 + 16 * (blk) + rw], (_Float16)Tf[(16 * (blk) + 4 * kq + 1) * 68 + 16 * (blk) + rw], \
                             (_Float16)Tf[(16 * (blk) + 4 * kq + 2) * 68 + 16 * (blk) + rw], (_Float16)Tf[(16 * (blk) + 4 * kq + 3) * 68 + 16 * (blk) + rw]})
#define G1_MM(A_, B_, C_) __builtin_amdgcn_mfma_f32_16x16x16f16(A_, B_, C_, 0, 0, 0)
#define G1_NEGH(c_) ((h16x4){(_Float16)(-(c_)[0]), (_Float16)(-(c_)[1]), (_Float16)(-(c_)[2]), (_Float16)(-(c_)[3])})
#define G1_POSH(c_) ((h16x4){(_Float16)((c_)[0]), (_Float16)((c_)[1]), (_Float16)((c_)[2]), (_Float16)((c_)[3])})
#define G1_PUT(t_, rb, cb) do { _Pragma("unroll") for (int e_ = 0; e_ < 4; ++e_) Tb[(16 * (rb) + 4 * kq + e_) * 72 + 16 * (cb) + rw] = bf1((float)(t_)[e_]); } while (0)
            const v4f z4 = (v4f){0.f, 0.f, 0.f, 0.f};
            const h16x4 d0 = G1_LDB(0), d1 = G1_LDB(1), d2 = G1_LDB(2);
            const h16x4 D1 = G1_LDA(Tf, 1, 1), D2 = G1_LDA(Tf, 2, 2), D3 = G1_LDA(Tf, 3, 3);
            const h16x4 L10 = G1_LDA(Lm, 1, 0), L20 = G1_LDA(Lm, 2, 0), L21 = G1_LDA(Lm, 2, 1), L30 = G1_LDA(Lm, 3, 0), L31 = G1_LDA(Lm, 3, 1), L32 = G1_LDA(Lm, 3, 2);
            v4f r; h16x4 t10, t20, t21, t30, t31, t32;
            r = G1_MM(L10, d0, z4); r = G1_MM(D1, G1_POSH(r), z4); t10 = G1_NEGH(r);
            r = G1_MM(L20, d0, z4); r = G1_MM(L21, t10, r); r = G1_MM(D2, G1_POSH(r), z4); t20 = G1_NEGH(r);
            r = G1_MM(L21, d1, z4); r = G1_MM(D2, G1_POSH(r), z4); t21 = G1_NEGH(r);
            r = G1_MM(L30, d0, z4); r = G1_MM(L31, t10, r); r = G1_MM(L32, t20, r); r = G1_MM(D3, G1_POSH(r), z4); t30 = G1_NEGH(r);
            r = G1_MM(L31, d1, z4); r = G1_MM(L32, t21, r); r = G1_MM(D3, G1_POSH(r), z4); t31 = G1_NEGH(r);
            r = G1_MM(L32, d2, z4); r = G1_MM(D3, G1_POSH(r), z4); t32 = G1_NEGH(r);
            G1_PUT(t10, 1, 0); G1_PUT(t20, 2, 0); G1_PUT(t21, 2, 1); G1_PUT(t30, 3, 0); G1_PUT(t31, 3, 1); G1_PUT(t32, 3, 2);
#undef G1_LDA
#undef G1_LDB
#undef G1_MM
#undef G1_NEGH
#undef G1_POSH
#undef G1_PUT
        }
        __syncthreads();
        for (int idx = tid; idx < 64 * 64; idx += 512) { const int j = idx & 63, i = idx >> 6;
            if ((j >> 4) >= (i >> 4)) Tb[i * 72 + j] = bf1((j >> 4) == (i >> 4) ? Tf[i * 68 + j] : 0.f); }
        __syncthreads();
        }
        for (int rep6 = 0; rep6 < (DUP_PHASE == 226 ? 2 : 1); ++rep6) {
            const int db = wave & 3, rhf = wave >> 2, row = 32 * rhf + r32;
            bf16x8 pa[4];
#pragma unroll
            for (int ks = 0; ks < 4; ++ks) pa[ks] = *reinterpret_cast<const bf16x8*>((const char*)Tb + row * 144 + (16 * ks + 8 * hi) * 2);
            f32x16 ow, ou;
#pragma unroll
            for (int q = 0; q < 16; ++q) { ow[q] = 0.f; ou[q] = 0.f; }
            const int vbase = (int)(uintptr_t)lds + na::v_rd_base(lane);
            pv_blk(ow, db, vbase + G1_KB, pa[0], pa[1], pa[2], pa[3]);
            pv_blk(ou, db, vbase + G1_VB, pa[0], pa[1], pa[2], pa[3]);
#pragma unroll
            for (int q = 0; q < 16; ++q) { const int rr = 32 * rhf + na::crow(q, hi), cc = 32 * db + r32; const size_t o = (cu * GC + rr) * HD + cc;
                p.GNW()[cu * GC * HD + ((size_t)(((rr >> 5) * 8 + (cc >> 4)) * 64 + (rr & 31) + 32 * ((cc >> 3) & 1))) * 8 + (cc & 7)] = h1(-ow[q]); p.GU()[o] = ou[q]; }
        }
        __syncthreads();
      }
    }
}
#endif
#ifndef CPU_SHIM
namespace gd {
__device__ __forceinline__ int v_st_e(int k, int c) { const int kk = (k & ~0xC) | ((k & 4) << 1) | ((k & 8) >> 1); return ((kk >> 3) * 4 + (c >> 5)) * 512 + ((kk & 7) * 32 + (c & 31)) * 2; }
constexpr int G2_S = 0, G2_VN = 4 * TILE, G2_END = 5 * TILE;
}
DEVFN void gdn_g2_unit(const Params& p, char* lds, int b, int h, int dvh) {
    using namespace gd;
    const int tid = tid_now(), wave = tid >> 6, lane = tid & 63, r32 = lane & 31, hi = lane >> 5, db = 2 * dvh + (wave & 1), rhf = (wave >> 1) & 1, col = 32 * db + r32;
    const bool act = wave < 4;
    const int vbase = (int)(uintptr_t)lds + na::v_rd_base(lane);
    f32x16 S0, S1;
#pragma unroll
    for (int q = 0; q < 16; ++q) { S0[q] = 0.f; S1[q] = 0.f; }
    __syncthreads();
    for (int i = tid; i < 2 * TILE / 16; i += 512) *(v4u*)(lds + G2_S + i * 16) = (v4u){0u, 0u, 0u, 0u};
    int cur = 0;
    const size_t cu0 = (size_t)(b * GH + h) * NCHK;
    bf16x8 nw[8]; f32x16 vn;
#define G2_LOAD_A(dst, base, pitch, n) do { _Pragma("unroll") for (int ks = 0; ks < (n); ++ks) dst[ks] = *reinterpret_cast<const bf16x8*>((base) + (size_t)(ks * 64 + lane) * 8); } while (0)
    if (act) { const bf16_t* src = p.GNW() + cu0 * GC * HD + (size_t)rhf * 8 * 512; G2_LOAD_A(nw, src, HD, 8);
#pragma unroll
      for (int q = 0; q < 16; ++q) vn[q] = p.GU()[(cu0 * GC + 32 * rhf + na::crow(q, hi)) * HD + col]; }
    __syncthreads();
    for (int c = 0; c < NCHK; ++c) {
        const size_t cu = cu0 + c;
        bf16x8 qg[8], qk[4], kd0[4], kd1[4]; float egl = 0.f;
        if (act) {
            { const bf16_t* s1 = p.GQG() + cu * GC * HD + (size_t)rhf * 8 * 512; G2_LOAD_A(qg, s1, HD, 8);
              const bf16_t* s2 = p.GQK() + cu * GC * GC + (size_t)rhf * 4 * 512; G2_LOAD_A(qk, s2, GC, 4);
              const bf16_t* s3 = p.GKD() + cu * GC * HD + (size_t)rhf * 4 * 512; G2_LOAD_A(kd0, s3, GC, 4);
              const bf16_t* s4 = p.GKD() + cu * GC * HD + (size_t)(2 + rhf) * 4 * 512; G2_LOAD_A(kd1, s4, GC, 4); }
            egl = p.GEL()[cu];
            gd::pvh_blk(vn, db, vbase + G2_S + (cur * 2 + 0) * TILE, nw[0], nw[1], nw[2], nw[3]);
            gd::pvh_blk(vn, db, vbase + G2_S + (cur * 2 + 1) * TILE, nw[4], nw[5], nw[6], nw[7]);
#pragma unroll
            for (int q = 0; q < 16; ++q) *(bf16_t*)(lds + G2_VN + v_st_e(32 * rhf + na::crow(q, hi), col)) = h1(vn[q]);
        }
        __syncthreads();
        if (act) {
            if (c + 1 < NCHK) { const bf16_t* src = p.GNW() + (cu + 1) * GC * HD + (size_t)rhf * 8 * 512; G2_LOAD_A(nw, src, HD, 8);
#pragma unroll
                for (int q = 0; q < 16; ++q) vn[q] = p.GU()[((cu + 1) * GC + 32 * rhf + na::crow(q, hi)) * HD + col]; }
            f32x16 o;
#pragma unroll
            for (int q = 0; q < 16; ++q) o[q] = 0.f;
            gd::pvh_blk(o, db, vbase + G2_S + (cur * 2 + 0) * TILE, qg[0], qg[1], qg[2], qg[3]);
            gd::pvh_blk(o, db, vbase + G2_S + (cur * 2 + 1) * TILE, qg[4], qg[5], qg[6], qg[7]);
            gd::pvh_blk(o, db, vbase + G2_VN, qk[0], qk[1], qk[2], qk[3]);
#pragma unroll
            for (int q = 0; q < 16; ++q) p.OAh()[(size_t)(b * SEQ + c * GC + 32 * rhf + na::crow(q, hi)) * GW + h * HD + col] = f2bf(o[q]);
#pragma unroll
            for (int q = 0; q < 16; ++q) { S0[q] *= egl; S1[q] *= egl; }
            gd::pvh_blk(S0, db, vbase + G2_VN, kd0[0], kd0[1], kd0[2], kd0[3]);
            gd::pvh_blk(S1, db, vbase + G2_VN, kd1[0], kd1[1], kd1[2], kd1[3]);
#pragma unroll
            for (int q = 0; q < 16; ++q) { const int off = v_st_e(32 * rhf + na::crow(q, hi), col);
                *(bf16_t*)(lds + G2_S + ((cur ^ 1) * 2 + 0) * TILE + off) = h1(S0[q]); *(bf16_t*)(lds + G2_S + ((cur ^ 1) * 2 + 1) * TILE + off) = h1(S1[q]); }
        }
        __syncthreads();
        cur ^= 1;
    }
#undef G2_LOAD_A
    if (act) {
#pragma unroll
        for (int q = 0; q < 16; ++q) { const int k = 32 * rhf + na::crow(q, hi);
            p.out[O_GDNP + ((size_t)(b * GH + h) * HD + k) * HD + col] = S0[q]; p.out[O_GDNP + ((size_t)(b * GH + h) * HD + 64 + k) * HD + col] = S1[q]; } }
}
constexpr int QW_P3 = XCD_BAR_WORDS + 64;
DEVFN void st_mixers(const Params& p, char* lds, volatile LAS unsigned* misc, int qw, int only = 0) {
    constexpr int NG2 = BATCH * GH * 2, NSM = MSA * NKV, NPA = BATCH * NKV * (SEQ / 64), NTOT = NG2 + NSM + NPA + TRN_ALL;
    for (;;) {
        if (tid_now() == 0) misc[4] = __hip_atomic_fetch_add(p.ctl() + qw, 1u, __ATOMIC_RELAXED, __HIP_MEMORY_SCOPE_AGENT);
        __syncthreads();
        const int u = (int)misc[4];
        __syncthreads();
        if (u >= NTOT) break;
        constexpr int NPL = (NPA * 2) / 5;
        if (u < NG2) { if (only == 0 || only == 2) gdn_g2_unit(p, lds, (u >> 1) / GH, (u >> 1) % GH, u & 1); }
        else if (only == 2) continue;
        else if (u >= NG2 + NPL && u < NG2 + NPL + NSM) { if (only != 4) st_nsa_sample_unit(p, (float*)lds, u - NG2 - NPL); }
        else if (u < NG2 + NSM + NPA) { if (only == 3) continue; const int v = u < NG2 + NPL ? u - NG2 : u - NG2 - NSM, i = (SEQ / 64 - 1) - v / (BATCH * NKV), bg = v % (BATCH * NKV); na::nsa_unit(p, lds, bg / NKV, i, bg % NKV); }
        else if (only == 0) tr_filler_unit(p, (float*)lds, u - NG2 - NSM - NPA);
    }
}
#endif
#ifndef CPU_SHIM
__device__ __forceinline__ float wave_sum64(float v);
DEVFN void st_post_fast(const Params& p) {
    { const int lane = tid_now() & 63, wave = tid_now() >> 6;
      for (int i = blockIdx.x * 8 + wave; i < MSA * 3 * GH; i += gridDim.x * 8) {
        const int h = i % GH, part = (i / GH) % 3, mm = i / (3 * GH), m = MPR + mm, bs = mm / DEC_SEQ, tq = mm % DEC_SEQ, c = part * GW + h * HD + 2 * lane;
        float a0 = 0.f, a1 = 0.f;
#pragma unroll
        for (int j = 0; j < 4; ++j) { const int tt = tq + j - 3; float x0, x1;
            if (tt >= 0) { const unsigned uu = *(const unsigned*)(p.QKVb() + (size_t)(MPR + bs * DEC_SEQ + tt) * (3 * GW) + c); x0 = __uint_as_float(uu << 16); x1 = __uint_as_float(uu & 0xffff0000u); }
            else { const float* sc = p.state_conv + (size_t)(bs * 3 + tt + 3) * (3 * GW) + c; x0 = sc[0]; x1 = sc[1]; }
            a0 += x0 * p.conv_w[(size_t)j * 3 * GW + c]; a1 += x1 * p.conv_w[(size_t)j * 3 * GW + c + 1]; }
        float v0 = a0 / (1.0f + __expf(-a0)), v1 = a1 / (1.0f + __expf(-a1));
        if (part < 2) { const float ss = wave_sum64(v0 * v0 + v1 * v1), r = (part == 0 ? QSCALE : 1.0f) / sqrtf(ss + RMS_EPS); v0 *= r; v1 *= r; }
        float* dst = p.QKVc() + (size_t)m * 3 * GW + c; dst[0] = v0; dst[1] = v1; } }
    GSL(i, (long)MSA * GH) { const int h = (int)(i % GH), m = MPR + (int)(i / GH);
        p.GB()[(size_t)m * 2 * GH + h] = p.SMf()[(size_t)m * ip::SMW + h]; p.GB()[(size_t)m * 2 * GH + GH + h] = p.SMf()[(size_t)m * ip::SMW + GH + h]; }
    GSL(i, (long)DEC_BATCH * (WINBUF - DEC_SEQ) * KV2) { const int c = (int)(i % KV2), j = (int)((i / KV2) % (WINBUF - DEC_SEQ)), bs = (int)(i / ((long)KV2 * (WINBUF - DEC_SEQ)));
        p.out[O_WINS + ((size_t)bs * WINBUF + j) * KV2 + c] = p.state_win[((size_t)bs * WINBUF + j + DEC_SEQ) * KV2 + c]; }
    GSL(i, (long)BATCH * NKV * NCP * HD) { const int d = (int)(i % HD), n = (int)((i / HD) % NCP), g = (int)((i / ((long)HD * NCP)) % NKV), b = (int)(i / ((long)HD * NCP * NKV));
        float ak = 0.f, av = 0.f; const float* z = p.out + O_CMPP + (size_t)(b * SEQ + 32 * n) * KV2 + g * HD + d;
#pragma unroll 8
        for (int cc = 0; cc < 32; ++cc) { ak += z[(size_t)cc * KV2] * p.w_cmp[cc * KV2 + g * HD + d]; av += z[(size_t)cc * KV2 + KVW] * p.w_cmp[cc * KV2 + KVW + g * HD + d]; }
        p.CMPK()[i] = f2bf(ak); p.CMPV()[i] = f2bf(av); }
}
#endif
#ifndef CPU_SHIM
template <int N, int K, class EpiS> __device__ __forceinline__ void gemm_small32_unit(char* lds, const bf16_t* A, const bf16_t* Bt, EpiS epi, int unit) {
    using na::bf16x8; using na::f32x16;
    float* red = (float*)lds;
    {
        const int tid = tid_now(), wave = tid >> 6, lane = tid & 63, r32 = lane & 31, hi = lane >> 5, n0 = 32 * unit;
        f32x16 acc;
#pragma unroll
        for (int q = 0; q < 16; ++q) acc[q] = 0.f;
        const bf16_t* ap = A + (size_t)r32 * K + 8 * hi; const bf16_t* bp = Bt + (size_t)(n0 + r32) * K + 8 * hi;
#pragma unroll 4
        for (int s8 = 0; s8 < K / 128; ++s8) { const int ks = wave + 8 * s8;
            const bf16x8 a = *reinterpret_cast<const bf16x8*>(ap + 16 * ks), bb = *reinterpret_cast<const bf16x8*>(bp + 16 * ks);
            acc = __builtin_amdgcn_mfma_f32_32x32x16_bf16(a, bb, acc, 0, 0, 0); }
        __syncthreads();
#pragma unroll
        for (int q = 0; q < 16; ++q) red[(wave * 16 + q) * 64 + lane] = acc[q];
        __syncthreads();
#pragma unroll
        for (int rep = 0; rep < 2; ++rep) { const int e = tid + 512 * rep, q = e >> 6, ln = e & 63; float s = 0.f;
#pragma unroll
            for (int w = 0; w < 8; ++w) s += red[(w * 16 + q) * 64 + ln];
            epi(na::crow(q, ln >> 5), n0 + (ln & 31), s); }
    }
}
template <int N, int K, class EpiS> __device__ __forceinline__ void gemm_small32(char* lds, const bf16_t* A, const bf16_t* Bt, EpiS epi) {
    for (int unit = blockIdx.x; unit < N / 32; unit += gridDim.x) gemm_small32_unit<N, K>(lds, A, Bt, epi, unit);
}
struct EpiSF32 { float* C; int ldc; __device__ __forceinline__ void operator()(int row, int col, float v) const { C[(size_t)row * ldc + col] = v; } };
struct EpiSFinal { const bf16_t* X2; const bf16_t* PL; float* y; __device__ __forceinline__ void operator()(int row, int col, float v) const {
    const size_t o = (size_t)row * D + col; y[o] = bf2f(X2[o]) + bf2f(PL[o]) / (1.0f + __expf(-v)); } };
struct EpiSBf16 { bf16_t* C; int ldc; __device__ __forceinline__ void operator()(int row, int col, float v) const { C[(size_t)row * ldc + col] = f2bf(v); } };
#endif
#ifndef CPU_SHIM
namespace rx {
constexpr int NT = D / 256, NSETS = 4, RX_CNT0 = 4096;
static_assert(RX_CNT0 + NSETS * 64 * 64 <= (int)(CTL_BYTES / 4) && XCD_BAR_WORDS + 256 <= RX_CNT0, "control block map");
struct RowEx { float* slots; unsigned* cnt; unsigned* tmo; };
__device__ __forceinline__ void wait_count(unsigned* c, unsigned want, unsigned* tmo) {
    unsigned sp = 0;
    while ((unsigned)__builtin_amdgcn_readfirstlane(__hip_atomic_load(c, __ATOMIC_RELAXED, __HIP_MEMORY_SCOPE_AGENT)) < want) {
        __builtin_amdgcn_s_sleep(2);
        if ((++sp & 255u) == 0u) { if (__hip_atomic_load(tmo, __ATOMIC_RELAXED, __HIP_MEMORY_SCOPE_AGENT)) break; if (sp > (1u << 22)) { __hip_atomic_store(tmo, 1u, __ATOMIC_RELAXED, __HIP_MEMORY_SCOPE_AGENT); break; } } }
    __builtin_amdgcn_fence(__ATOMIC_ACQUIRE, "agent");
    asm volatile("s_waitcnt vmcnt(0)" ::: "memory");
}
__device__ __forceinline__ void tile(const RowEx& X, const pg8::f32x4 (&v)[2][2][4][2], int pm, int pn, int wr, int wc, int fr, int fq, float* P, float* S, int tid) {
#pragma unroll
    for (int ai = 0; ai < 2; ++ai)
#pragma unroll
        for (int m = 0; m < 4; ++m) { float s = 0.f;
#pragma unroll
            for (int bj = 0; bj < 2; ++bj)
#pragma unroll
                for (int n = 0; n < 2; ++n) { const pg8::f32x4 x = v[ai][bj][m][n]; s += (x[0] * x[0] + x[1] * x[1]) + (x[2] * x[2] + x[3] * x[3]); }
            s += __shfl_xor(s, 16); s += __shfl_xor(s, 32);
            if (fq == 0) P[(ai * 128 + wr * 64 + m * 16 + fr) * 4 + wc] = s; }
    asm volatile("s_waitcnt lgkmcnt(0)" ::: "memory"); __builtin_amdgcn_s_barrier(); asm volatile("" ::: "memory");
    if (tid < 256) { const float s = (P[tid * 4] + P[tid * 4 + 1]) + (P[tid * 4 + 2] + P[tid * 4 + 3]);
        __hip_atomic_store((unsigned*)X.slots + ((size_t)(pm * 64 + pn) * 256 + tid), __float_as_uint(s), __ATOMIC_RELAXED, __HIP_MEMORY_SCOPE_AGENT); }
    asm volatile("s_waitcnt vmcnt(0)" ::: "memory");
    if (tid < 256 && (tid & 63) == 0) __hip_atomic_fetch_add(X.cnt + 64 * pm, 1u, __ATOMIC_RELAXED, __HIP_MEMORY_SCOPE_AGENT);
    if (tid < 64) wait_count(X.cnt + 64 * pm, 4u * NT, X.tmo);
    asm volatile("s_waitcnt vmcnt(0) lgkmcnt(0)" ::: "memory"); __builtin_amdgcn_s_barrier(); asm volatile("" ::: "memory");
    if (tid < 256) { float tot = 0.f;
#pragma unroll
        for (int t = 0; t < NT; ++t) tot += __uint_as_float(__hip_atomic_load((unsigned*)X.slots + ((size_t)(pm * 64 + t) * 256 + tid), __ATOMIC_RELAXED, __HIP_MEMORY_SCOPE_AGENT));
        S[tid] = 1.0f / sqrtf(tot * (1.0f / D) + RMS_EPS); }
    asm volatile("s_waitcnt lgkmcnt(0)" ::: "memory"); __builtin_amdgcn_s_barrier(); asm volatile("" ::: "memory");
}
}
struct EpiWoNorm {
    static constexpr bool PERM = false, AFTER_DRAIN = true;
    const float* x; float* X1; bf16_t* H2; const float* g1; const float* g2; rx::RowEx e1, e2;
    __device__ __forceinline__ void fused(pg8::f32x4 (&acc)[2][2][4][2], const pg8::Unit& u, int wr, int wc, int fr, int fq, PG8_LAS unsigned char* ldsp, int wid, int lane) const {
        float* P = (float*)ldsp; float* S = P + 1024; const int tid = wid * 64 + lane, col0 = u.pn * 256 + wc * 32 + 4 * fq;
        rx::tile(e1, acc, u.pm, u.pn, wr, wc, fr, fq, P, S, tid);
#pragma unroll
        for (int ai = 0; ai < 2; ++ai)
#pragma unroll
            for (int m = 0; m < 4; ++m) { const int r = ai * 128 + wr * 64 + m * 16 + fr; const float rs = S[r]; const size_t off = (size_t)(u.pm * 256 + r) * D + col0;
#pragma unroll
                for (int bj = 0; bj < 2; ++bj)
#pragma unroll
                    for (int n = 0; n < 2; ++n) { const int c = bj * 128 + n * 16; const v4f xv = *(const v4f*)(x + off + c), g = *(const v4f*)(g1 + col0 + c);
                        pg8::f32x4 y; y[0] = xv[0] + acc[ai][bj][m][n][0] * rs * g[0]; y[1] = xv[1] + acc[ai][bj][m][n][1] * rs * g[1]; y[2] = xv[2] + acc[ai][bj][m][n][2] * rs * g[2]; y[3] = xv[3] + acc[ai][bj][m][n][3] * rs * g[3];
                        acc[ai][bj][m][n] = y; *(v4f*)(X1 + off + c) = (v4f){y[0], y[1], y[2], y[3]}; }
                asm volatile("" : "+v"(acc[ai][0][m][0]), "+v"(acc[ai][0][m][1]), "+v"(acc[ai][1][m][0]), "+v"(acc[ai][1][m][1]));
                asm volatile("" ::: "memory"); }
        rx::tile(e2, acc, u.pm, u.pn, wr, wc, fr, fq, P, S, tid);
#pragma unroll
        for (int ai = 0; ai < 2; ++ai)
#pragma unroll
            for (int m = 0; m < 4; ++m) { const int r = ai * 128 + wr * 64 + m * 16 + fr; const float rs = S[r]; const size_t off = (size_t)(u.pm * 256 + r) * D + col0;
#pragma unroll
                for (int bj = 0; bj < 2; ++bj)
#pragma unroll
                    for (int n = 0; n < 2; ++n) { const int c = bj * 128 + n * 16; const v4f g = *(const v4f*)(g2 + col0 + c); const pg8::f32x4 y = acc[ai][bj][m][n];
                        *(unsigned long long*)(H2 + off + c) = (unsigned long long)pk2bf(y[0] * rs * g[0], y[1] * rs * g[1]) | ((unsigned long long)pk2bf(y[2] * rs * g[2], y[3] * rs * g[3]) << 32); }
                asm volatile("" ::: "memory"); }
    }
};
struct EpiFfoNorm {
    static constexpr bool PERM = false, AFTER_DRAIN = true;
    const float* X1; float* X2; bf16_t* X2b; const float* g; rx::RowEx e1;
    __device__ __forceinline__ void fused(pg8::f32x4 (&acc)[2][2][4][2], const pg8::Unit& u, int wr, int wc, int fr, int fq, PG8_LAS unsigned char* ldsp, int wid, int lane) const {
        float* P = (float*)ldsp; float* S = P + 1024; const int tid = wid * 64 + lane, col0 = u.pn * 256 + wc * 32 + 4 * fq;
        rx::tile(e1, acc, u.pm, u.pn, wr, wc, fr, fq, P, S, tid);
#pragma unroll
        for (int ai = 0; ai < 2; ++ai)
#pragma unroll
            for (int m = 0; m < 4; ++m) { const int r = ai * 128 + wr * 64 + m * 16 + fr; const float rs = S[r]; const size_t off = (size_t)(u.pm * 256 + r) * D + col0;
#pragma unroll
                for (int bj = 0; bj < 2; ++bj)
#pragma unroll
                    for (int n = 0; n < 2; ++n) { const int c = bj * 128 + n * 16; const v4f xv = *(const v4f*)(X1 + off + c), gg = *(const v4f*)(g + col0 + c); const pg8::f32x4 a = acc[ai][bj][m][n];
                        const v4f y = (v4f){xv[0] + a[0] * rs * gg[0], xv[1] + a[1] * rs * gg[1], xv[2] + a[2] * rs * gg[2], xv[3] + a[3] * rs * gg[3]};
                        *(v4f*)(X2 + off + c) = y; *(unsigned long long*)(X2b + off + c) = (unsigned long long)pk2bf(y[0], y[1]) | ((unsigned long long)pk2bf(y[2], y[3]) << 32); }
                asm volatile("" ::: "memory"); }
    }
};
template <int K, int MODE> __device__ __forceinline__ void small32_norm(const Params& p, char* lds, const bf16_t* A, const bf16_t* Bt, rx::RowEx e1, rx::RowEx e2) {
    using na::bf16x8; using na::f32x16;
    constexpr int NB = D / 32;
    float* red = (float*)lds; float* Prow = red + 8 * 16 * 64; float* S = Prow + 32;
    for (int unit = blockIdx.x; unit < NB; unit += gridDim.x) {
        const int tid = tid_now(), wave = tid >> 6, lane = tid & 63, r32 = lane & 31, hi = lane >> 5, n0 = 32 * unit;
        f32x16 acc;
#pragma unroll
        for (int q = 0; q < 16; ++q) acc[q] = 0.f;
        const bf16_t* ap = A + (size_t)r32 * K + 8 * hi; const bf16_t* bp = Bt + (size_t)(n0 + r32) * K + 8 * hi;
#pragma unroll 4
        for (int s8 = 0; s8 < K / 128; ++s8) { const int ks = wave + 8 * s8;
            const bf16x8 a = *reinterpret_cast<const bf16x8*>(ap + 16 * ks), bb = *reinterpret_cast<const bf16x8*>(bp + 16 * ks);
            acc = __builtin_amdgcn_mfma_f32_32x32x16_bf16(a, bb, acc, 0, 0, 0); }
        __syncthreads();
#pragma unroll
        for (int q = 0; q < 16; ++q) red[(wave * 16 + q) * 64 + lane] = acc[q];
        __syncthreads();
        float val[2]; int row[2]; const int col = n0 + r32;
#pragma unroll
        for (int rep = 0; rep < 2; ++rep) { const int q = wave + 8 * rep; float s = 0.f;
#pragma unroll
            for (int w = 0; w < 8; ++w) s += red[(w * 16 + q) * 64 + lane];
            val[rep] = s; row[rep] = na::crow(q, hi); }
        const rx::RowEx* ex[2] = {&e1, &e2};
#pragma unroll
        for (int pass = 0; pass < (MODE == 0 ? 2 : 1); ++pass) {
            const rx::RowEx& X = *ex[pass];
#pragma unroll
            for (int rep = 0; rep < 2; ++rep) { float s = val[rep] * val[rep];
#pragma unroll
                for (int o = 1; o < 32; o <<= 1) s += __shfl_xor(s, o);
                if (r32 == 0) Prow[row[rep]] = s; }
            __syncthreads();
            if (tid < 32) __hip_atomic_store((unsigned*)X.slots + ((size_t)(32 * 64 + unit) * 256 + tid), __float_as_uint(Prow[tid]), __ATOMIC_RELAXED, __HIP_MEMORY_SCOPE_AGENT);
            asm volatile("s_waitcnt vmcnt(0)" ::: "memory");
            if (tid == 0) __hip_atomic_fetch_add(X.cnt + 64 * 32, 1u, __ATOMIC_RELAXED, __HIP_MEMORY_SCOPE_AGENT);
            if (tid < 64) rx::wait_count(X.cnt + 64 * 32, (unsigned)NB, X.tmo);
            __syncthreads();
            if (tid < 32) { float tot = 0.f; for (int t = 0; t < NB; ++t) tot += __uint_as_float(__hip_atomic_load((unsigned*)X.slots + ((size_t)(32 * 64 + t) * 256 + tid), __ATOMIC_RELAXED, __HIP_MEMORY_SCOPE_AGENT));
                S[tid] = 1.0f / sqrtf(tot * (1.0f / D) + RMS_EPS); }
            __syncthreads();
#pragma unroll
            for (int rep = 0; rep < 2; ++rep) { const size_t o = (size_t)(MPR + row[rep]) * D + col; const float rs = S[row[rep]];
                if (MODE == 0 && pass == 0) { val[rep] = p.x_sample[(size_t)row[rep] * D + col] + val[rep] * rs * p.g_post1[col]; p.X1()[o] = val[rep]; }
                else if (MODE == 0) p.H2()[o] = f2bf(val[rep] * rs * p.g_pre2[col]);
                else { const float y = p.X1()[o] + val[rep] * rs * p.g_post2[col]; p.X2()[o] = y; p.X2b()[o] = f2bf(y); } }
            __syncthreads();
        }
    }
}
#endif
#ifndef CPU_SHIM
DEVFN void st_h2_pad(const Params& p) {
    for (long i = (long)blockIdx.x * 512 + tid_now(); i < (long)(MPAD - M) * D / 8; i += (long)gridDim.x * 512) *(v4u*)(p.H2() + (size_t)M * D + i * 8) = (v4u){0u, 0u, 0u, 0u};
}
#endif
#ifndef CPU_SHIM
struct PoolOrder : pg8::StaticOrder {
    const float* cache; const int* page_table; const float* w_cmp; float* kvcs; mutable int step;
    static constexpr long NV = (long)DEC_BATCH * NCS * (KV2 / 4);
    __device__ __forceinline__ void pool_step(int k) const {
        const long o = (long)k * ((long)gridDim.x * 512) + (long)blockIdx.x * 512 + tid_now();
        if (o >= NV) return;
        const int c4 = (int)(o % (KV2 / 4)), n = (int)((o / (KV2 / 4)) % NCS), bs = (int)(o / ((long)(KV2 / 4) * NCS));
        const float* base = cache + ((size_t)page_table[bs * N_PAGES + (32 * n) / PAGE] * PAGE + (32 * n) % PAGE) * KV2 + 4 * c4;
        v4f acc = (v4f){0.f, 0.f, 0.f, 0.f};
#pragma unroll
        for (int hf = 0; hf < 2; ++hf) { v4f x[16], w[16];
#pragma unroll
            for (int cc = 0; cc < 16; ++cc) { x[cc] = *(const v4f*)(base + (size_t)(16 * hf + cc) * KV2); w[cc] = *(const v4f*)(w_cmp + (size_t)(16 * hf + cc) * KV2 + 4 * c4); }
#pragma unroll
            for (int cc = 0; cc < 16; ++cc) acc += x[cc] * w[cc]; }
        *(v4f*)(kvcs + o * 4) = acc;
    }
    __device__ __forceinline__ bool next(int i, pg8::Unit& u) const {
        if (!pg8::StaticOrder::next(i, u)) return false;
        constexpr int T_H0 = ip::E_CMP / 256, NHV = (ip::E_GM - ip::E_CMP) / 256;
        const int k = u.pn;
        if (k % 5 == 4 && k / 5 < NHV) u.pn = T_H0 + k / 5;
        else { const int li = k - (k / 5 < NHV ? k / 5 : NHV); u.pn = li < T_H0 ? li : li + NHV; }
        return true; }
    __device__ __forceinline__ void done(const pg8::Unit&) const { pool_step(step); ++step; }
    __device__ __forceinline__ void finish() const { const int nsteps = (int)((NV + (long)gridDim.x * 512 - 1) / ((long)gridDim.x * 512)); for (; step < nsteps; ++step) pool_step(step); }
};
#endif
constexpr int N_PHASES = 13;
#ifndef MK_N_LAUNCHES
#define MK_N_LAUNCHES 1
#endif
static void fill_inputs(Params& p, void* const* d_in, void* d_out) {
    p.x_prompt = (const float*)d_in[0]; p.x_sample = (const float*)d_in[1]; p.cache_cmp = (const float*)d_in[2]; p.cache_sel = (const float*)d_in[3];
    p.page_table = (const int*)d_in[4]; p.state_win = (const float*)d_in[5]; p.state_gdn = (const float*)d_in[6]; p.state_conv = (const float*)d_in[7];
    p.p_prompt = (const float*)d_in[8]; p.p_sample = (const float*)d_in[9]; p.g_pre1 = (const float*)d_in[10]; p.w_in = (const float*)d_in[11];
    p.conv_w = (const float*)d_in[12]; p.A_log = (const float*)d_in[13]; p.dt_bias = (const float*)d_in[14]; p.gdn_norm_w = (const float*)d_in[15];
    p.w_cmp = (const float*)d_in[16]; p.w_o = (const float*)d_in[17]; p.g_post1 = (const float*)d_in[18]; p.g_pre2 = (const float*)d_in[19];
    p.w_ffn_in = (const float*)d_in[20]; p.w_ffn_out = (const float*)d_in[21]; p.g_post2 = (const float*)d_in[22]; p.w_ple = (const float*)d_in[23];
    p.w_ple_gate = (const float*)d_in[24]; p.out = (float*)d_out;
}

#ifndef CPU_SHIM
constexpr int LDS_BYTES = 160 * 1024;
constexpr int MISC_OFF = LDS_BYTES - 256;
static_assert(gd::G2_END <= MISC_OFF && gd::G1_END <= MISC_OFF && na::OFF_END <= MISC_OFF && pg8::STAGE_BYTES <= MISC_OFF, "LDS map");
template <class Epi> __device__ __forceinline__ void run_gemm(PG8_LAS unsigned char* lds, const bf16_t* A, const bf16_t* Bt, int Mr, int N, int K, const Epi& E) {
    pg8::Gemm g{A, Bt, Mr, N, K}; pg8::StaticOrder S; S.init(Mr, N, (int)gridDim.x, (int)blockIdx.x);
    pg8::gemm_phase<Epi, pg8::StaticOrder, false>(lds, g, S, E, nullptr);
}
__global__ void __launch_bounds__(512, 2) fwd(Params p) {
    extern __shared__ __attribute__((aligned(16))) unsigned char lds_raw[];
    PG8_LAS unsigned char* lds = (PG8_LAS unsigned char*)lds_raw;
    float* sm = (float*)lds_raw;
    volatile LAS unsigned* misc = (volatile LAS unsigned*)(lds + MISC_OFF);
    if (threadIdx.x < 4) misc[threadIdx.x] = 0u;
    __syncthreads();
    XcdBarrier bar = xcd_barrier_post(p.ctl(), misc);
    const int lo = p.ph_lo, hi = p.ph_hi;
#define IN(k) (lo <= (k) && (k) < hi)
#ifndef TIME_PHASE
#define TIME_PHASE -1
#endif
    unsigned long long tp_a = (TIME_PHASE % 100 == 0) ? wall_clock64() : 0ull, tp_b = 0ull;
#define SEAM(k) do { if (TIME_PHASE == 100 + (k)) tp_b = wall_clock64(); \
                     if (TIME_PHASE == 200 + (k) && threadIdx.x == 0) __hip_atomic_store(p.ctl() + 32000 + blockIdx.x, (unsigned)(wall_clock64() - tp_a), __ATOMIC_RELAXED, __HIP_MEMORY_SCOPE_AGENT); \
                     if (IN(k) && IN((k) + 1)) xcd_barrier(bar); if (TIME_PHASE == (k)) tp_b = wall_clock64(); \
                     if (TIME_PHASE == 200 + (k) && blockIdx.x == 0) { unsigned sacc = 0; for (int w = 0; w < (int)gridDim.x; ++w) sacc += __hip_atomic_load(p.ctl() + 32000 + w, __ATOMIC_RELAXED, __HIP_MEMORY_SCOPE_AGENT); tp_b = tp_a + sacc / gridDim.x; } \
                     if (TIME_PHASE >= 0 && (TIME_PHASE % 100 == (k) + 1 || (TIME_PHASE % 100 == 9 && (k) == 7))) tp_a = wall_clock64(); } while (0)
#ifndef DUP_PHASE
#define DUP_PHASE -1
#endif
#define RUN(id, ...) do { __VA_ARGS__; if (DUP_PHASE == (id)) { __syncthreads(); __VA_ARGS__; } } while (0)
    if (DUP_PHASE == 200) { for (int k = 0; k < 10; ++k) xcd_barrier(bar); }
    if (IN(0)) { RUN(0, st_prep_weights_fast(p, sm); __syncthreads(); st_prep_rows_fast(p)); } SEAM(0);
    if (IN(1)) { if (STAGGER_US > 0) { const unsigned long long t0 = wall_clock64(), dt = (unsigned long long)((blockIdx.x / 8) % 8) * STAGGER_US * 100ull; while (wall_clock64() - t0 < dt) __builtin_amdgcn_s_sleep(8); }
                 { pg8::Gemm g{p.H1(), p.Wt_in(), MPAD, NPROJ, D}; PoolOrder S; S.init(MPAD, NPROJ, (int)gridDim.x, (int)blockIdx.x);
                   S.cache = p.cache_cmp; S.page_table = p.page_table; S.w_cmp = p.w_cmp; S.kvcs = p.KVCs(); S.step = 0;
                   pg8::gemm_phase<ip::Epi, PoolOrder, false>(lds, g, S, ip::Epi{p.ws, p.out, p.A_log, p.dt_bias}, nullptr); S.finish(); }
                 if (DUP_PHASE == 1) { __syncthreads(); run_gemm(lds, p.H1(), p.Wt_in(), MPAD, NPROJ, D, ip::Epi{p.ws, p.out, p.A_log, p.dt_bias}); } } SEAM(1);
    if (IN(2)) { RUN(20, st_post_fast(p)); RUN(22, st_gdn_g1_mfma(p, (char*)lds_raw)); } SEAM(2);
    if (IN(3)) { RUN(30, st_gdn_naive(p, BATCH)); __syncthreads(); st_mixers(p, (char*)lds_raw, misc, QW_P3); if (DUP_PHASE == 3) { __syncthreads(); st_mixers(p, (char*)lds_raw, misc, QW_P3 + 64); }
                 if (DUP_PHASE == 301) { __syncthreads(); st_mixers(p, (char*)lds_raw, misc, QW_P3 + 64, 1); }
                 if (DUP_PHASE == 303) { __syncthreads(); st_mixers(p, (char*)lds_raw, misc, QW_P3 + 64, 3); }
                 if (DUP_PHASE == 304) { __syncthreads(); st_mixers(p, (char*)lds_raw, misc, QW_P3 + 64, 4); }
                 if (DUP_PHASE == 302) { __syncthreads(); st_mixers(p, (char*)lds_raw, misc, QW_P3 + 64, 2); } } SEAM(3);
    if (IN(4)) { RUN(4, st_merge_fast(p)); } SEAM(4);
#define RXE(set) rx::RowEx{p.RXS() + (size_t)(set) * 64 * 64 * 256, p.ctl() + rx::RX_CNT0 + (set) * 64 * 64, p.ctl() + XB_TMO}
#ifndef FUSED_NORMS
#define FUSED_NORMS 0
#endif
    if (IN(5)) { RUN(5,
                 if (FUSED_NORMS) { run_gemm(lds, p.MIX(), p.Wt_o(), MPR, D, D, EpiWoNorm{p.x_prompt, p.X1(), p.H2(), p.g_post1, p.g_pre2, RXE(0), RXE(1)}); __syncthreads();
                                    small32_norm<D, 0>(p, (char*)lds_raw, p.MIX() + (size_t)MPR * D, p.Wt_o(), RXE(0), RXE(1)); st_h2_pad(p); }
                 else { run_gemm(lds, p.MIX(), p.Wt_o(), MPR, D, D, pg8::EpiBf16<0>{p.T1b(), D, nullptr, 0, 0}); __syncthreads();
                        gemm_small32<D, D>((char*)lds_raw, p.MIX() + (size_t)MPR * D, p.Wt_o(), EpiSBf16{p.T1b() + (size_t)MPR * D, D}); }); } SEAM(5);
    if (IN(6) && !FUSED_NORMS) { RUN(6, st_norm1_fast(p)); } SEAM(6);
    if (IN(7)) { RUN(7, run_gemm(lds, p.H2(), p.Wt_ffi(), MPAD, 2 * FFN, D, EpiSwiGLU{p.ACT(), FFN}));
                 { constexpr int NU7 = (MPAD / 256) * (2 * FFN / 256); const int G = (int)gridDim.x, full = NU7 % G;
                   const int c = (int)blockIdx.x, nfree = full ? G - full : G, c2 = full ? c - full : c;
                   if (c2 >= 0) { __syncthreads();
                       pg8::Gemm g{p.Pbf(), p.Wt_ple(), MPR, D, PLE}; pg8::StaticOrder S; S.init(MPR, D, nfree, c2);
                       pg8::gemm_phase<pg8::EpiBf16<0>, pg8::StaticOrder, false>(lds, g, S, pg8::EpiBf16<0>{p.PLb(), D, nullptr, 0, 0}, nullptr); __syncthreads();
                       for (int unit = c2; unit < D / 32; unit += nfree) gemm_small32_unit<D, PLE>((char*)lds_raw, p.Pbf() + (size_t)MPR * PLE, p.Wt_ple(), EpiSBf16{p.PLb() + (size_t)MPR * D, D}, unit); } } } SEAM(7);
    if (IN(9)) { RUN(9, if (FUSED_NORMS) { run_gemm(lds, p.ACT(), p.Wt_ffo(), MPR, D, FFN, EpiFfoNorm{p.X1(), p.X2(), p.X2b(), p.g_post2, RXE(2)}); __syncthreads();
                                           small32_norm<FFN, 1>(p, (char*)lds_raw, p.ACT() + (size_t)MPR * FFN, p.Wt_ffo(), RXE(2), RXE(2)); }
                 else { run_gemm(lds, p.ACT(), p.Wt_ffo(), MPR, D, FFN, pg8::EpiBf16<0>{p.T2b(), D, nullptr, 0, 0}); __syncthreads();
                        gemm_small32<D, FFN>((char*)lds_raw, p.ACT() + (size_t)MPR * FFN, p.Wt_ffo(), EpiSBf16{p.T2b() + (size_t)MPR * D, D}); }); } SEAM(9);
    if (IN(10) && !FUSED_NORMS) { RUN(10, st_norm2_fast(p)); } SEAM(10);
    if (IN(11)) { RUN(11, run_gemm(lds, p.X2b(), p.Wt_pg(), MPR, D, D, EpiFinal{p.X2b(), p.PLb(), p.out}); __syncthreads();
                  gemm_small32<D, D>((char*)lds_raw, p.X2b() + (size_t)MPR * D, p.Wt_pg(), EpiSFinal{p.X2b() + (size_t)MPR * D, p.PLb() + (size_t)MPR * D, p.out + O_YS})); }
    if (TIME_PHASE >= 0) { if (TIME_PHASE % 100 == 11) tp_b = wall_clock64();
                           if (blockIdx.x == 0) { const unsigned long long t_end = wall_clock64(), dt = 4ull * (tp_b - tp_a); while (wall_clock64() - t_end < dt) __builtin_amdgcn_s_sleep(8); } }
#undef RUN
#undef IN
#undef SEAM
}

extern "C" void kernel_launch(void* const* d_in, const int* in_sizes, int n_in, void* d_out, int out_size, void* d_ws, size_t ws_size, hipStream_t stream) {
    static int grid = 0;
    Params p; memset(&p, 0, sizeof(p));
    const size_t need = WSL.end; p.ws = (unsigned char*)d_ws;
    if (grid == 0) {
        if (n_in != 25 || (long)out_size != O_END || ws_size < need) { fprintf(stderr, "kernel_launch: shape mismatch (n_in %d out %d ws %zu need %zu)\n", n_in, out_size, ws_size, need); grid = -1; return; }
        int dev = 0, cus = 0, per_cu = 0;
        if (hipGetDevice(&dev) != hipSuccess || hipDeviceGetAttribute(&cus, hipDeviceAttributeMultiprocessorCount, dev) != hipSuccess) { grid = -1; return; }
        if (hipFuncSetAttribute((const void*)fwd, hipFuncAttributeMaxDynamicSharedMemorySize, LDS_BYTES) != hipSuccess) { fprintf(stderr, "kernel_launch: hipFuncSetAttribute failed\n"); grid = -1; return; }
        if (hipOccupancyMaxActiveBlocksPerMultiprocessor(&per_cu, (const void*)fwd, 512, LDS_BYTES) != hipSuccess || per_cu < 1) fprintf(stderr, "kernel_launch: occupancy query says %d\n", per_cu);
        (void)hipGetLastError();
        grid = cus;
    }
    if (grid < 0) return;
    fill_inputs(p, d_in, d_out);
    (void)hipMemsetAsync(p.ctl(), 0, CTL_BYTES, stream);
#if MK_N_LAUNCHES == 1
    p.ph_lo = 0; p.ph_hi = N_PHASES;
    hipLaunchKernelGGL(fwd, dim3(grid), dim3(512), LDS_BYTES, stream, p);
#else
    for (int k = 0; k < N_PHASES; ++k) { p.ph_lo = k; p.ph_hi = k + 1; hipLaunchKernelGGL(fwd, dim3(grid), dim3(512), LDS_BYTES, stream, p); }
#endif
    const hipError_t le = hipPeekAtLastError();
    if (le != hipSuccess) fprintf(stderr, "kernel_launch: launch failed: %s\n", hipGetErrorName(le));
}
#else
#include <omp.h>
static void cpu_gemm(const act_t* A, int lda, const float* W, int K, int N, float* C, int ldc, int rows) {
#pragma omp parallel for schedule(dynamic, 4)
    for (int m = 0; m < rows; ++m) { float* c = C + (size_t)m * ldc; for (int n = 0; n < N; ++n) c[n] = 0.f;
        for (int k = 0; k < K; ++k) { const float a = A[(size_t)m * lda + k]; const float* w = W + (size_t)k * N; for (int n = 0; n < N; ++n) c[n] += a * w[n]; } }
}
template <class F> static void par(F f) {
#pragma omp parallel
    { g_bid = omp_get_thread_num(); g_nblk = omp_get_num_threads(); static thread_local float smbuf[65536]; f(smbuf); }
}
static void run_all_cpu(Params& p) {
    par([&](float* sm) { st_prep(p, sm); });
    cpu_gemm(p.H1(), D, p.w_in, D, PROJ, p.Z(), NPROJ, M);
    par([&](float* sm) { st_post_inproj(p); st_gdn_g1(p, sm); });
    par([&](float* sm) { st_gdn_naive(p, BATCH); st_gdn_g2(p, sm); st_nsa_naive(p, sm, 0); });
    par([&](float*) { st_merge(p); });
    cpu_gemm(p.MIX(), D, p.w_o, D, D, p.T1(), D, M); cpu_gemm(p.Pbf(), PLE, p.w_ple, PLE, D, p.PL(), D, M);
    par([&](float* sm) { st_norm1(p, sm); });
    cpu_gemm(p.H2(), D, p.w_ffn_in, D, 2 * FFN, p.FF(), 2 * FFN, M);
    par([&](float*) { st_act(p); });
    cpu_gemm(p.ACT(), FFN, p.w_ffn_out, FFN, D, p.T2(), D, M);
    par([&](float* sm) { st_norm2(p, sm); });
    cpu_gemm(p.X2b(), D, p.w_ple_gate, D, D, p.G(), D, M);
    par([&](float*) { st_final(p); });
}
#endif
```

```cpp
#ifndef CPU_SHIM
#include <hip/hip_runtime.h>
#endif
#include <cstdio>
#include <cstdint>
#include <cstring>
#include <cmath>

#ifndef CFG_D_MODEL
#define CFG_D_MODEL 2048
#define CFG_BATCH 2
#define CFG_SEQ 4096
#define CFG_DEC_BATCH 8
#define CFG_PAST_LEN 16384
#endif
#ifndef DUP_PHASE
#define DUP_PHASE -1
#endif
#ifndef STAGGER_US
#define STAGGER_US 0
#endif
namespace cfg {
constexpr int D = CFG_D_MODEL, BATCH = CFG_BATCH, SEQ = CFG_SEQ, DEC_BATCH = CFG_DEC_BATCH, DEC_SEQ = 4, PAST = CFG_PAST_LEN, PAGE = 128;
constexpr int HD = 128, GH = D / HD, GW = GH * HD, NH = D / HD, NKV = NH / 4, NSAW = NH * HD, KVW = NKV * HD, KV2 = 2 * KVW;
constexpr int FFN = ((8 * D + 3 * 256 - 1) / (3 * 256)) * 256, PLE = 256, WINDOW = 512, WINBUF = (WINDOW < PAST ? WINDOW : PAST);
constexpr int C_QKV = 0, C_Z = 3 * GW, C_A = 4 * GW, C_B = C_A + GH, C_QN = C_B + GH, C_CMP = C_QN + NSAW, C_SEL = C_CMP + KV2, C_WIN = C_SEL + KV2,
              C_GN = C_WIN + KV2, C_GM = C_GN + 3 * NH, PROJ = C_GM + 2 * D;
constexpr int NPROJ = ((PROJ + 255) / 256) * 256;
constexpr int N_PAGES = PAST / PAGE, USED = DEC_BATCH * N_PAGES, N_POOL = USED + (USED / 4 > 1 ? USED / 4 : 1);
constexpr int MPR = BATCH * SEQ, MSA = DEC_BATCH * DEC_SEQ, M = MPR + MSA, MPAD = ((M + 255) / 256) * 256;
constexpr int NCP = SEQ / 32, NSP = (SEQ + 63) / 64;
constexpr int TKS = PAST + DEC_SEQ, NCS = TKS / 32, NSS = (TKS + 63) / 64;
constexpr int KSEL_P = NSP < 16 ? NSP : 16, KSEL_S = NSS < 16 ? NSS : 16;
static_assert(SEQ % 64 == 0 && SEQ >= WINDOW && PAST % 128 == 0 && PAST >= WINDOW && D % 256 == 0, "shape assumptions");
constexpr long O_YP = 0, O_YS = O_YP + (long)MPR * D, O_CMPP = O_YS + (long)MSA * D, O_SELP = O_CMPP + (long)MPR * KV2, O_WINP = O_SELP + (long)MPR * KV2,
               O_GDNP = O_WINP + (long)BATCH * WINBUF * KV2, O_CONVP = O_GDNP + (long)BATCH * GH * HD * HD, O_CMPS = O_CONVP + (long)BATCH * 3 * 3 * GW,
               O_SELS = O_CMPS + (long)MSA * KV2, O_WINS = O_SELS + (long)MSA * KV2, O_GDNS = O_WINS + (long)DEC_BATCH * WINBUF * KV2,
               O_CONVS = O_GDNS + (long)DEC_BATCH * GH * HD * HD, O_END = O_CONVS + (long)DEC_BATCH * 3 * 3 * GW;
constexpr int KN2_W = 24576;
constexpr float RMS_EPS = 1e-6f, NEG_INF = -1e30f, FORCE_BONUS = 5.0f, QSCALE = 0.08838834764831845f;
}
using namespace cfg;

typedef unsigned short bf16_t;
#ifdef CPU_SHIM
typedef float act_t;
#else
typedef bf16_t act_t;
#endif

#ifdef CPU_SHIM
static thread_local int g_bid = 0, g_nblk = 1;
#define BID g_bid
#define NBLK g_nblk
#define TID 0
#define NTHR 1
#define SYNC() do {} while (0)
#define CFENCE() do {} while (0)
#define UNIFORM(x) (x)
#define DEVFN static inline
#define DEVFN_M inline
#define LDSP
static inline float rsqrt_f(float x) { return 1.0f / sqrtf(x); }
static inline float exp2_f(float x) { return exp2f(x); }
#else
#define BID ((int)blockIdx.x)
#define NBLK ((int)gridDim.x)
__device__ __forceinline__ int tid_now() { int t = (int)threadIdx.x; asm volatile("" : "+v"(t)); return t; }
#define TID tid_now()
#define NTHR ((int)blockDim.x)
#define SYNC() __syncthreads()
#define CFENCE() asm volatile("" ::: "memory")
#define UNIFORM(x) __builtin_amdgcn_readfirstlane(x)
#define DEVFN __device__ __forceinline__
#define DEVFN_M __host__ __device__ __forceinline__
#define LDSP
__device__ __forceinline__ float rsqrt_f(float x) { return 1.0f / sqrtf(x); }
__device__ __forceinline__ float exp2_f(float x) { return exp2f(x); }
#endif
#define GSL(i, n) for (long i = (long)BID * NTHR + TID; i < (long)(n); i += (long)NBLK * NTHR)
#define BSL(i, n) for (int i = TID; i < (int)(n); i += NTHR)
#define USL(u, n) for (int u = BID; u < (int)(n); u += NBLK)

DEVFN float sigmoid_f(float x) { return 1.0f / (1.0f + expf(-x)); }
DEVFN float silu_f(float x) { return x / (1.0f + expf(-x)); }
DEVFN float softplus_f(float x) { return fmaxf(x, 0.0f) + log1pf(expf(-fabsf(x))); }
DEVFN bf16_t f2bf(float f) { unsigned u; memcpy(&u, &f, 4); u += 0x7FFFu + ((u >> 16) & 1u); return (bf16_t)(u >> 16); }
DEVFN float bf2f(bf16_t b) { unsigned u = ((unsigned)b) << 16; float f; memcpy(&f, &u, 4); return f; }
#ifdef CPU_SHIM
DEVFN act_t to_act(float f) { return f; }
DEVFN float from_act(act_t a) { return a; }
#else
DEVFN act_t to_act(float f) { return f2bf(f); }
DEVFN float from_act(act_t a) { return bf2f(a); }
#endif

constexpr size_t CTL_BYTES = 131072, NCHUNKS = (size_t)BATCH * GH * (SEQ / 64);
#ifdef CPU_SHIM
constexpr size_t CPU_ONLY = 1;
#else
constexpr size_t CPU_ONLY = 0;
#endif
constexpr size_t ws_al(size_t x) { return (x + 255) / 256 * 256; }
struct WsLayout { size_t T1b, T2b, PLb, RXS, QKVb, ZAs, GMs, SMf, ctl, Wt_in, Wt_o, Wt_ffi, Wt_ffo, Wt_pg, Wt_ple, H1, Pbf, MIX, H2, ACT, X2b, Z, QKVc, GB, OA, KVCp, KVCs, On, T1, X1, FF, T2, X2, G, PL, GNW, GQG, GKD, GQK, GU, GEL, QN, SELK, SELV, WINK, WINV, CMPK, CMPV, end; };
constexpr WsLayout make_ws_layout() { WsLayout L{}; size_t o = 0;
    L.ctl = o; o += ws_al(sizeof(unsigned) * (CTL_BYTES / 4));
    L.QKVb = o; o += ws_al(sizeof(bf16_t) * ((size_t)MPAD * 3 * GW)); L.ZAs = o; o += ws_al(sizeof(bf16_t) * ((size_t)MPAD * GW));
    L.GMs = o; o += ws_al(sizeof(bf16_t) * ((size_t)MPAD * 2 * D)); L.SMf = o; o += ws_al(sizeof(float) * ((size_t)MPAD * 128));
    L.Wt_in = o; o += ws_al(sizeof(act_t) * ((size_t)NPROJ * D));
    L.Wt_o = o; o += ws_al(sizeof(act_t) * ((size_t)D * D));
    L.Wt_ffi = o; o += ws_al(sizeof(act_t) * ((size_t)2 * FFN * D));
    L.Wt_ffo = o; o += ws_al(sizeof(act_t) * ((size_t)D * FFN));
    L.Wt_pg = o; o += ws_al(sizeof(act_t) * ((size_t)D * D));
    L.Wt_ple = o; o += ws_al(sizeof(act_t) * ((size_t)D * PLE));
    L.H1 = o; o += ws_al(sizeof(act_t) * ((size_t)MPAD * D));
    L.Pbf = o; o += ws_al(sizeof(act_t) * ((size_t)MPAD * PLE));
    L.MIX = o; o += ws_al(sizeof(act_t) * ((size_t)MPAD * D));
    L.H2 = o; o += ws_al(sizeof(act_t) * ((size_t)MPAD * D));
    L.ACT = o; o += ws_al(sizeof(act_t) * ((size_t)MPAD * FFN));
    L.X2b = o; o += ws_al(sizeof(act_t) * ((size_t)MPAD * D));
    L.Z = o; o += ws_al(sizeof(float) * ((size_t)MPAD * NPROJ) * CPU_ONLY);
    L.QKVc = o; o += ws_al(sizeof(float) * ((size_t)(CPU_ONLY ? M : MSA) * 3 * GW));
    L.GB = o; o += ws_al(sizeof(float) * ((size_t)M * 2 * GH));
    L.OA = o; o += ws_al(sizeof(float) * ((size_t)M * GW));
    L.KVCp = o; o += ws_al(sizeof(float) * ((size_t)BATCH * NCP * KV2) * CPU_ONLY);
    L.KVCs = o; o += ws_al(sizeof(float) * ((size_t)DEC_BATCH * NCS * KV2));
    L.On = o; o += ws_al(sizeof(float) * ((size_t)M * NSAW));
    L.T1 = o; o += ws_al(sizeof(float) * ((size_t)MPAD * D));
    L.X1 = o; o += ws_al(sizeof(float) * ((size_t)M * D));
    L.FF = o; o += ws_al(sizeof(float) * ((size_t)MPAD * 2 * FFN) * CPU_ONLY);
    L.T2 = o; o += ws_al(sizeof(float) * ((size_t)MPAD * D));
    L.X2 = o; o += ws_al(sizeof(float) * ((size_t)M * D));
    L.G = o; o += ws_al(sizeof(float) * ((size_t)MPAD * D) * CPU_ONLY);
    L.PL = o; o += ws_al(sizeof(float) * ((size_t)MPAD * D));
    L.GNW = o; o += ws_al(sizeof(act_t) * (NCHUNKS * 64 * HD));
    L.GQG = o; o += ws_al(sizeof(act_t) * (NCHUNKS * 64 * HD));
    L.GKD = o; o += ws_al(sizeof(act_t) * (NCHUNKS * 64 * HD));
    L.GQK = o; o += ws_al(sizeof(act_t) * (NCHUNKS * 64 * 64));
    L.GU = o; o += ws_al(sizeof(float) * (NCHUNKS * 64 * HD));
    L.GEL = o; o += ws_al(sizeof(float) * (NCHUNKS));
    L.QN = o; o += ws_al(sizeof(bf16_t) * ((size_t)MPAD * NSAW));
    L.SELK = o; o += ws_al(sizeof(bf16_t) * ((size_t)MPR * KVW));
    L.SELV = o; o += ws_al(sizeof(bf16_t) * ((size_t)MPR * KVW));
    L.WINK = o; o += ws_al(sizeof(bf16_t) * ((size_t)MPR * KVW));
    L.WINV = o; o += ws_al(sizeof(bf16_t) * ((size_t)MPR * KVW));
    L.CMPK = o; o += ws_al(sizeof(bf16_t) * ((size_t)BATCH * NKV * NCP * HD));
    L.CMPV = o; o += ws_al(sizeof(bf16_t) * ((size_t)BATCH * NKV * NCP * HD));
    L.T1b = o; o += ws_al(sizeof(bf16_t) * ((size_t)MPAD * D)); L.T2b = o; o += ws_al(sizeof(bf16_t) * ((size_t)MPAD * D)); L.PLb = o; o += ws_al(sizeof(bf16_t) * ((size_t)MPAD * D));
    L.RXS = o; o += ws_al(sizeof(float) * ((size_t)4 * 64 * 64 * 256));
    L.end = o; return L; }
constexpr WsLayout WSL = make_ws_layout();
struct Params {
    const float *x_prompt, *x_sample, *cache_cmp, *cache_sel; const int* page_table;
    const float *state_win, *state_gdn, *state_conv, *p_prompt, *p_sample, *g_pre1, *w_in, *conv_w, *A_log, *dt_bias, *gdn_norm_w, *w_cmp,
                *w_o, *g_post1, *g_pre2, *w_ffn_in, *w_ffn_out, *g_post2, *w_ple, *w_ple_gate;
    float* out;
    unsigned char* ws;
    int ph_lo, ph_hi;
    DEVFN_M unsigned* ctl() const { return (unsigned*)(ws + WSL.ctl); }
    DEVFN_M bf16_t* T1b() const { return (bf16_t*)(ws + WSL.T1b); }
    DEVFN_M bf16_t* T2b() const { return (bf16_t*)(ws + WSL.T2b); }
    DEVFN_M bf16_t* PLb() const { return (bf16_t*)(ws + WSL.PLb); }
    DEVFN_M float* RXS() const { return (float*)(ws + WSL.RXS); }
    DEVFN_M bf16_t* QKVb() const { return (bf16_t*)(ws + WSL.QKVb); }
    DEVFN_M bf16_t* ZAs() const { return (bf16_t*)(ws + WSL.ZAs); }
    DEVFN_M bf16_t* GMs() const { return (bf16_t*)(ws + WSL.GMs); }
    DEVFN_M float* SMf() const { return (float*)(ws + WSL.SMf); }
    DEVFN_M act_t* Wt_in() const { return (act_t*)(ws + WSL.Wt_in); }
    DEVFN_M act_t* Wt_o() const { return (act_t*)(ws + WSL.Wt_o); }
    DEVFN_M act_t* Wt_ffi() const { return (act_t*)(ws + WSL.Wt_ffi); }
    DEVFN_M act_t* Wt_ffo() const { return (act_t*)(ws + WSL.Wt_ffo); }
    DEVFN_M act_t* Wt_pg() const { return (act_t*)(ws + WSL.Wt_pg); }
    DEVFN_M act_t* Wt_ple() const { return (act_t*)(ws + WSL.Wt_ple); }
    DEVFN_M act_t* H1() const { return (act_t*)(ws + WSL.H1); }
    DEVFN_M act_t* Pbf() const { return (act_t*)(ws + WSL.Pbf); }
    DEVFN_M act_t* MIX() const { return (act_t*)(ws + WSL.MIX); }
    DEVFN_M act_t* H2() const { return (act_t*)(ws + WSL.H2); }
    DEVFN_M act_t* ACT() const { return (act_t*)(ws + WSL.ACT); }
    DEVFN_M act_t* X2b() const { return (act_t*)(ws + WSL.X2b); }
    DEVFN_M float* Z() const { return (float*)(ws + WSL.Z); }
    DEVFN_M float* QKVc() const { return (float*)(ws + WSL.QKVc) - (CPU_ONLY ? 0 : (size_t)MPR * 3 * GW); }
    DEVFN_M float* GB() const { return (float*)(ws + WSL.GB); }
    DEVFN_M float* OA() const { return (float*)(ws + WSL.OA); }
    DEVFN_M bf16_t* OAh() const { return (bf16_t*)(ws + WSL.OA); }
    DEVFN_M float* KVCp() const { return (float*)(ws + WSL.KVCp); }
    DEVFN_M float* KVCs() const { return (float*)(ws + WSL.KVCs); }
    DEVFN_M float* On() const { return (float*)(ws + WSL.On); }
    DEVFN_M bf16_t* Onh() const { return (bf16_t*)(ws + WSL.On); }
    DEVFN_M float* T1() const { return (float*)(ws + WSL.T1); }
    DEVFN_M float* X1() const { return (float*)(ws + WSL.X1); }
    DEVFN_M bf16_t* X1h() const { return (bf16_t*)(ws + WSL.X1); }
    DEVFN_M float* FF() const { return (float*)(ws + WSL.FF); }
    DEVFN_M float* T2() const { return (float*)(ws + WSL.T2); }
    DEVFN_M float* X2() const { return (float*)(ws + WSL.X2); }
    DEVFN_M float* G() const { return (float*)(ws + WSL.G); }
    DEVFN_M float* PL() const { return (float*)(ws + WSL.PL); }
    DEVFN_M act_t* GNW() const { return (act_t*)(ws + WSL.GNW); }
    DEVFN_M act_t* GQG() const { return (act_t*)(ws + WSL.GQG); }
    DEVFN_M act_t* GKD() const { return (act_t*)(ws + WSL.GKD); }
    DEVFN_M act_t* GQK() const { return (act_t*)(ws + WSL.GQK); }
    DEVFN_M float* GU() const { return (float*)(ws + WSL.GU); }
    DEVFN_M float* GEL() const { return (float*)(ws + WSL.GEL); }
    DEVFN_M bf16_t* QN() const { return (bf16_t*)(ws + WSL.QN); }
    DEVFN_M bf16_t* SELK() const { return (bf16_t*)(ws + WSL.SELK); }
    DEVFN_M bf16_t* SELV() const { return (bf16_t*)(ws + WSL.SELV); }
    DEVFN_M bf16_t* WINK() const { return (bf16_t*)(ws + WSL.WINK); }
    DEVFN_M bf16_t* WINV() const { return (bf16_t*)(ws + WSL.WINV); }
    DEVFN_M bf16_t* CMPK() const { return (bf16_t*)(ws + WSL.CMPK); }
    DEVFN_M bf16_t* CMPV() const { return (bf16_t*)(ws + WSL.CMPV); }
};

DEVFN const float* x_row(const Params& p, int m) { return m < MPR ? p.x_prompt + (size_t)m * D : p.x_sample + (size_t)(m - MPR) * D; }
#ifndef CPU_SHIM
namespace pg8 {
#define PG8_LAS __attribute__((address_space(3)))
typedef unsigned short bf16_t;
typedef short bf16x8 __attribute__((ext_vector_type(8)));
typedef float f32x4 __attribute__((ext_vector_type(4)));
typedef unsigned u32x4 __attribute__((ext_vector_type(4)));
constexpr int BM = 256, BK = 64, HALF = 128, HTB = HALF * BK * 2  , STAGE_BYTES = 8 * HTB, NXCD = 8, WGM = 8;

__host__ __device__ __forceinline__ int lds_byte(int r, int c) { const int st = (r >> 4) * 2 + (c >> 5), rr = r & 15, cc = c & 31, ob = rr * 64 + cc * 2; return st * 1024 + (ob ^ (((ob >> 9) & 1) << 5)); }
__host__ __device__ __forceinline__ void stage_rc(int b, int& R, int& C) { const int st = b / 1024, sb = b % 1024, swz = sb ^ (((sb >> 9) & 1) << 5); R = (st >> 1) * 16 + swz / 64; C = (st & 1) * 32 + (swz % 64) / 2; }
__host__ __device__ __forceinline__ int perm32(int rho) { const int n = rho >> 4, i = rho & 15; return 8 * (i >> 2) + 4 * n + (i & 3); }

struct Unit { int pm, pn; };
struct Gemm { const bf16_t* A; const bf16_t* Bt; int M, N, K; };

struct StaticOrder {
    static constexpr bool DYNAMIC = false;
    int nM, nN, nwg, G, c;
    __host__ __device__ void init(int M, int N, int G_, int c_) { nM = M / BM; nN = N / BM; nwg = nM * nN; G = G_; c = c_; }
    __host__ __device__ bool next(int i, Unit& u) const { return unit_of((long)i * G + c, u); }
    __device__ __forceinline__ void claim(int) const {}
    __device__ __forceinline__ bool fetch(int, Unit&) const { return false; }
    __host__ __device__ bool unit_of(long L, Unit& u) const {
        if (L >= nwg) return false;
        int wgid = (int)L; { const int q = nwg / NXCD, r = nwg % NXCD, xcd = wgid % NXCD, off = wgid / NXCD; wgid = (xcd < r ? xcd * (q + 1) : r * (q + 1) + (xcd - r) * q) + off; }
        const int nig = WGM * nN, gid = wgid / nig, fm = gid * WGM, gsz = (nM - fm) < WGM ? (nM - fm) : WGM;
        u.pm = fm + ((wgid % nig) % gsz); u.pn = (wgid % nig) / gsz; return true;
    }
    __device__ __forceinline__ void a_ready(const Unit&) const {}
    __device__ __forceinline__ void done(const Unit&) const {}
};
struct CountedOrder : StaticOrder {
    const unsigned* ready; unsigned need; unsigned* tmo;
    __device__ __forceinline__ void a_ready(const Unit& u) const {
        if (threadIdx.x < 64) {
            const unsigned long long t0 = __builtin_amdgcn_s_memrealtime(); unsigned polls = 0;
            while ((unsigned)__builtin_amdgcn_readfirstlane(__hip_atomic_load(ready + 64 * u.pm, __ATOMIC_RELAXED, __HIP_MEMORY_SCOPE_AGENT)) < need) {
                if ((++polls & 255u) == 0u && __builtin_amdgcn_readfirstlane(__hip_atomic_load(tmo, __ATOMIC_RELAXED, __HIP_MEMORY_SCOPE_AGENT)) != 0u) break;
                if (__builtin_amdgcn_s_memrealtime() - t0 > 2000000ull) {
                    if (threadIdx.x == 0) { unsigned expect = 0u; __hip_atomic_compare_exchange_strong(tmo + 1, &expect, 0x600u | (unsigned)(u.pm & 0xff), __ATOMIC_RELAXED, __ATOMIC_RELAXED, __HIP_MEMORY_SCOPE_AGENT); __hip_atomic_store(tmo, 1u, __ATOMIC_RELAXED, __HIP_MEMORY_SCOPE_AGENT); }
                    break; }
                __builtin_amdgcn_s_sleep(2); }
            __builtin_amdgcn_fence(__ATOMIC_ACQUIRE, "agent");
            asm volatile("s_waitcnt vmcnt(0)" ::: "memory");
        }
#if !defined(BROKEN_HOOK_NO_BARRIER)
        asm volatile("" ::: "memory"); __builtin_amdgcn_s_barrier(); asm volatile("" ::: "memory");
#endif
    }
};

struct DynOrder : StaticOrder {
    static constexpr bool DYNAMIC = true;
    unsigned* qctr; volatile PG8_LAS unsigned* slot; mutable unsigned claimed;
    __device__ __forceinline__ void claim(int) const { if (threadIdx.x == 0) claimed = __hip_atomic_fetch_add(qctr + 64 * (c % NXCD), 1u, __ATOMIC_RELAXED, __HIP_MEMORY_SCOPE_AGENT); }
    __device__ __forceinline__ bool fetch(int i, Unit& u) const {
        if (threadIdx.x == 0) { slot[i & 1] = claimed; asm volatile("s_waitcnt lgkmcnt(0)" ::: "memory"); }
        asm volatile("" ::: "memory"); __builtin_amdgcn_s_barrier(); asm volatile("" ::: "memory");
        const unsigned k = __builtin_amdgcn_readfirstlane(slot[i & 1]);
        return unit_of(((long)(G / NXCD) + (long)k) * NXCD + (c % NXCD), u);
    }
};

__device__ __forceinline__ unsigned cvt_pk_bf16(float lo, float hi) { unsigned r; asm volatile("v_cvt_pk_bf16_f32 %0, %1, %2" : "=v"(r) : "v"(lo), "v"(hi)); return r; }
typedef float f32x2 __attribute__((ext_vector_type(2)));
__device__ __forceinline__ f32x2 gelu_pk(f32x2 v) {
    const f32x2 av = __builtin_elementwise_abs(v), d = av * 0.2316418882f + 1.0f;
    f32x2 t; t.x = __builtin_amdgcn_rcpf(d.x); t.y = __builtin_amdgcn_rcpf(d.y);
    f32x2 q = t * 0.5307027145f + (-0.7265760135f); q = q * t + 0.7107068705f; q = q * t + (-0.142248368f); q = q * t + 0.127414796f; q = q * t;
    const f32x2 s = (v * v) * (-0.72134752044f);
    f32x2 e; e.x = __builtin_amdgcn_exp2f(s.x); e.y = __builtin_amdgcn_exp2f(s.y);
    const f32x2 m = v * (q * e), r = v - m;
    f32x2 o; o.x = v.x < 0.f ? m.x : r.x; o.y = v.y < 0.f ? m.y : r.y; return o;
}

struct EpiF32 {
    static constexpr bool PERM = false, AFTER_DRAIN = false;
    float* C; int ldc; const float* bias;
    __device__ __forceinline__ void operator()(const f32x4 (&acc)[2][2][4][2], const Unit& u, int wr, int wc, int fr, int fq) const {
        const int row0 = u.pm * BM + wr * 64 + fr, col0 = u.pn * BM + wc * 32 + 4 * fq;
        f32x4 bv[2][2];
#pragma unroll
        for (int bj = 0; bj < 2; ++bj)
#pragma unroll
            for (int n = 0; n < 2; ++n) bv[bj][n] = bias ? *(const f32x4*)(bias + col0 + bj * HALF + n * 16) : (f32x4){0.f, 0.f, 0.f, 0.f};
#pragma unroll
        for (int ai = 0; ai < 2; ++ai)
#pragma unroll
            for (int m = 0; m < 4; ++m) { float* rowp = C + (size_t)(row0 + ai * HALF + m * 16) * ldc + col0;
#pragma unroll
                for (int bj = 0; bj < 2; ++bj)
#pragma unroll
                    for (int n = 0; n < 2; ++n) *(f32x4*)(rowp + bj * HALF + n * 16) = acc[ai][bj][m][n] + bv[bj][n]; }
    }
};
template <int ACT  > struct EpiBf16 {
    static constexpr bool PERM = true, AFTER_DRAIN = false;
    bf16_t* O; int ldc; const float* bias; int split_cols; size_t split_stride;
    __device__ __forceinline__ void operator()(const f32x4 (&acc)[2][2][4][2], const Unit& u, int wr, int wc, int fr, int fq) const {
        const int row0 = u.pm * BM + wr * 64 + fr; int colt = u.pn * BM; bf16_t* base = O;
        if (split_cols) { const int t = colt / split_cols; base += (size_t)t * split_stride; colt -= t * split_cols; }
        const int col0 = colt + wc * 32 + 8 * fq, bcol0 = u.pn * BM + wc * 32 + 8 * fq;
        f32x4 bv[2][2];
#pragma unroll
        for (int bj = 0; bj < 2; ++bj)
#pragma unroll
            for (int n = 0; n < 2; ++n) bv[bj][n] = bias ? *(const f32x4*)(bias + bcol0 + bj * HALF + 4 * n) : (f32x4){0.f, 0.f, 0.f, 0.f};
#pragma unroll
        for (int ai = 0; ai < 2; ++ai)
#pragma unroll
            for (int m = 0; m < 4; ++m) { bf16_t* rowp = base + (size_t)(row0 + ai * HALF + m * 16) * ldc + col0;
#pragma unroll
                for (int bj = 0; bj < 2; ++bj) { f32x4 v0 = acc[ai][bj][m][0] + bv[bj][0], v1 = acc[ai][bj][m][1] + bv[bj][1];
                    if (ACT == 1) { f32x2 a = gelu_pk((f32x2){v0[0], v0[1]}), b = gelu_pk((f32x2){v0[2], v0[3]}), c = gelu_pk((f32x2){v1[0], v1[1]}), d = gelu_pk((f32x2){v1[2], v1[3]});
                        v0 = (f32x4){a.x, a.y, b.x, b.y}; v1 = (f32x4){c.x, c.y, d.x, d.y}; }
                    if (ACT == 2) {
#pragma unroll
                        for (int j = 0; j < 4; ++j) { v0[j] = 0.5f * v0[j] * (1.0f + erff(v0[j] * 0.70710678f)); v1[j] = 0.5f * v1[j] * (1.0f + erff(v1[j] * 0.70710678f)); } }
                    u32x4 w; w.x = cvt_pk_bf16(v0[0], v0[1]); w.y = cvt_pk_bf16(v0[2], v0[3]); w.z = cvt_pk_bf16(v1[0], v1[1]); w.w = cvt_pk_bf16(v1[2], v1[3]);
                    *(u32x4*)(rowp + bj * HALF) = w; } }
    }
};
template <class Epi, class Sched, bool STAMP = false>
__device__ __forceinline__ void gemm_phase(PG8_LAS unsigned char* lds, const Gemm g, const Sched& S, const Epi& E, unsigned long long* stamps) {
    const int tid = threadIdx.x, wid = __builtin_amdgcn_readfirstlane(tid >> 6), lane = tid & 63, wr = wid >> 2, wc = wid & 3, fr = lane & 15, fq = lane >> 4;
    const int K = g.K, nt = K / BK;
    int ts_lo = 0, ts_hi = 0, nts = 0; const unsigned long long rt_entry = STAMP ? (unsigned long long)wall_clock64() : 0ull;
#define PG8_STAMP() do { if (STAMP && wid == 0 && nts < 64) { const unsigned long long _c = (unsigned long long)clock64(); \
        ts_lo = (lane == nts) ? (int)(unsigned)_c : ts_lo; ts_hi = (lane == nts) ? (int)(unsigned)(_c >> 32) : ts_hi; ++nts; } } while (0)
    PG8_STAMP();
    unsigned voffA[2], voffB[2];
#pragma unroll
    for (int i = 0; i < 2; ++i) { int R, C; stage_rc(tid * 16 + i * 8192, R, C); const int Rb = Epi::PERM ? ((R & ~31) + perm32(R & 31)) : R;
        voffA[i] = (unsigned)(R * K + C) * 2u; voffB[i] = (unsigned)(Rb * K + C) * 2u; }
    const size_t kstep = (size_t)(BK * 2);
    const size_t hstep = (size_t)HALF * K * 2;
    const size_t tstep = 2 * hstep;
    const unsigned ldsw = (unsigned)wid * 1024u;
    const int aoff = lds_byte(wr * 64 + fr, fq * 8), boff = lds_byte(wc * 32 + fr, fq * 8);
#define PG8_SA(b, h) (((b) * 2 + (h)) * HTB)
#define PG8_SB(b, h) ((4 + (b) * 2 + (h)) * HTB)
#define PG8_STAGE(bufoff, gbase, voff) do { _Pragma("unroll") for (int _i = 0; _i < 2; ++_i) \
        __builtin_amdgcn_global_load_lds((const unsigned*)((const char*)(gbase) + (voff)[_i]), (PG8_LAS unsigned*)(lds + (bufoff) + ldsw + _i * 8192), 16, 0, 0); } while (0)
#define PG8_LDA(dst, b, h) do { _Pragma("unroll") for (int m = 0; m < 4; ++m) _Pragma("unroll") for (int k = 0; k < 2; ++k) dst[m][k] = *(const PG8_LAS bf16x8*)(lds + PG8_SA(b, h) + aoff + m * 2048 + k * 1024); } while (0)
#define PG8_LDB(dst, b, h) do { _Pragma("unroll") for (int n = 0; n < 2; ++n) _Pragma("unroll") for (int k = 0; k < 2; ++k) dst[n][k] = *(const PG8_LAS bf16x8*)(lds + PG8_SB(b, h) + boff + n * 2048 + k * 1024); } while (0)
#define PG8_MMA(ai, bj, At, Bt) do { __builtin_amdgcn_s_setprio(1); _Pragma("unroll") for (int m = 0; m < 4; ++m) _Pragma("unroll") for (int n = 0; n < 2; ++n) _Pragma("unroll") for (int k = 0; k < 2; ++k) \
        acc[ai][bj][m][n] = __builtin_amdgcn_mfma_f32_16x16x32_bf16(Bt[n][k], At[m][k], acc[ai][bj][m][n], 0, 0, 0); __builtin_amdgcn_s_setprio(0); } while (0)
#define PG8_WAIT_V(n) asm volatile("s_waitcnt vmcnt(" #n ")" ::: "memory")
#define PG8_WAIT_L(n) asm volatile("s_waitcnt lgkmcnt(" #n ")" ::: "memory")
#define PG8_BAR __builtin_amdgcn_s_barrier()
#define PG8_SCHED __builtin_amdgcn_sched_barrier(0)
    Unit cur, nxt; int ui = 0;
    if (!S.next(0, cur)) return;
    f32x4 acc[2][2][4][2];
#pragma unroll
    for (int a = 0; a < 2; ++a)
#pragma unroll
        for (int b = 0; b < 2; ++b)
#pragma unroll
            for (int m = 0; m < 4; ++m)
#pragma unroll
                for (int n = 0; n < 2; ++n) acc[a][b][m][n] = (f32x4){0.f, 0.f, 0.f, 0.f};
    bf16x8 At[4][2], B0[2][2], B1[2][2];
    const char* cA = (const char*)g.A + (size_t)cur.pm * tstep; const char* cB = (const char*)g.Bt + (size_t)cur.pn * tstep;
    S.a_ready(cur);
    PG8_STAGE(PG8_SB(0, 0), cB, voffB); PG8_STAGE(PG8_SA(0, 0), cA, voffA); PG8_STAGE(PG8_SB(0, 1), cB + hstep, voffB); PG8_STAGE(PG8_SA(0, 1), cA + hstep, voffA);
    if (wr == 1) PG8_BAR;
    PG8_WAIT_V(4); PG8_BAR;
    PG8_STAGE(PG8_SB(1, 0), cB + kstep, voffB); PG8_STAGE(PG8_SA(1, 0), cA + kstep, voffA); PG8_STAGE(PG8_SB(1, 1), cB + hstep + kstep, voffB);
    PG8_WAIT_V(6); PG8_BAR;
    PG8_STAMP();
    for (;;) {
        bool has_next = false; const char* nA = cA; const char* nB = cB;
        if constexpr (Sched::DYNAMIC) S.claim(ui + 1);
        else { has_next = S.next(ui + 1, nxt);
               if (has_next) { nA = (const char*)g.A + (size_t)nxt.pm * tstep; nB = (const char*)g.Bt + (size_t)nxt.pn * tstep; } }
        for (int t = 0; t < nt; t += 2) {
            const bool last = (t == nt - 2);
            if constexpr (Sched::DYNAMIC) { if (last) { has_next = S.fetch(ui + 1, nxt); if (has_next) { nA = (const char*)g.A + (size_t)nxt.pm * tstep; nB = (const char*)g.Bt + (size_t)nxt.pn * tstep; } } }
            const char* a1 = cA + (size_t)(t + 1) * kstep;
            const char* a2 = last ? nA : cA + (size_t)(t + 2) * kstep; const char* b2 = last ? nB : cB + (size_t)(t + 2) * kstep;
            const char* a3 = a2 + kstep; const char* b3 = b2 + kstep;
            if (last && has_next) S.a_ready(nxt);
            PG8_LDB(B0, 0, 0); PG8_SCHED; PG8_LDA(At, 0, 0); PG8_STAGE(PG8_SA(1, 1), a1 + hstep, voffA);
            PG8_WAIT_L(8); PG8_BAR; PG8_WAIT_L(0); PG8_MMA(0, 0, At, B0); PG8_BAR; PG8_SCHED;
            PG8_LDB(B1, 0, 1); PG8_STAGE(PG8_SB(0, 0), b2, voffB);
            PG8_BAR; PG8_WAIT_L(0); PG8_MMA(0, 1, At, B1); PG8_BAR;
            PG8_LDA(At, 0, 1); PG8_STAGE(PG8_SA(0, 0), a2, voffA);
            PG8_BAR; PG8_WAIT_L(0); PG8_MMA(1, 0, At, B0); PG8_BAR; PG8_SCHED;
            PG8_STAGE(PG8_SB(0, 1), b2 + hstep, voffB);
            PG8_WAIT_V(6); PG8_BAR; PG8_MMA(1, 1, At, B1); PG8_BAR;
            PG8_LDB(B0, 1, 0); PG8_SCHED; PG8_LDA(At, 1, 0); PG8_STAGE(PG8_SA(0, 1), a2 + hstep, voffA);
            PG8_WAIT_L(8); PG8_BAR; PG8_WAIT_L(0); PG8_MMA(0, 0, At, B0); PG8_BAR; PG8_SCHED;
            PG8_LDB(B1, 1, 1); PG8_STAGE(PG8_SB(1, 0), b3, voffB);
            PG8_BAR; PG8_WAIT_L(0); PG8_MMA(0, 1, At, B1); PG8_BAR;
            PG8_LDA(At, 1, 1); PG8_STAGE(PG8_SA(1, 0), a3, voffA);
            PG8_BAR; PG8_WAIT_L(0); PG8_MMA(1, 0, At, B0); PG8_BAR; PG8_SCHED;
            PG8_STAGE(PG8_SB(1, 1), b3 + hstep, voffB);
            PG8_WAIT_V(6); PG8_BAR; PG8_MMA(1, 1, At, B1); PG8_BAR;
        }
        PG8_STAMP();
        if constexpr (!Epi::AFTER_DRAIN) { E(acc, cur, wr, wc, fr, fq); S.done(cur); }
        PG8_STAMP();
        if (!has_next) break;
#pragma unroll
        for (int a = 0; a < 2; ++a)
#pragma unroll
            for (int b = 0; b < 2; ++b)
#pragma unroll
                for (int m = 0; m < 4; ++m)
#pragma unroll
                    for (int n = 0; n < 2; ++n) acc[a][b][m][n] = (f32x4){0.f, 0.f, 0.f, 0.f};
        cur = nxt; cA = nA; cB = nB; ++ui;
    }
    PG8_WAIT_V(0);
    if (wr == 0) PG8_BAR;
    PG8_BAR;
    if constexpr (Epi::AFTER_DRAIN) { E.fused(acc, cur, wr, wc, fr, fq, lds, wid, lane); S.done(cur); }
    PG8_STAMP();
    if (STAMP && wid == 0) { stamps[lane] = lane < nts ? (((unsigned long long)(unsigned)ts_hi << 32) | (unsigned)ts_lo) : 0ull;
        if (lane == 62) stamps[62] = rt_entry; if (lane == 63) stamps[63] = (unsigned long long)wall_clock64(); }
#undef PG8_STAMP
#undef PG8_SA
#undef PG8_SB
#undef PG8_STAGE
#undef PG8_LDA
#undef PG8_LDB
#undef PG8_MMA
#undef PG8_WAIT_V
#undef PG8_WAIT_L
#undef PG8_BAR
#undef PG8_SCHED
}
}
#define XB_TMO      128
#define XB_XCNT(j)  (256  + 64 * (j))
#define XB_XSUB(j)  (1280 + 64 * (j))
#define XB_XGEN(j)  (2304 + 64 * (j))
#define XB_TOP      3328
#define XB_TOPGEN   3392
#define XCD_BAR_WORDS 3456
#define XB_SPIN_CAP (1u << 23)
#define LAS __attribute__((address_space(3)))

__device__ __forceinline__ unsigned xb_ld(unsigned* p)              { return __hip_atomic_load(p, __ATOMIC_RELAXED, __HIP_MEMORY_SCOPE_AGENT); }
__device__ __forceinline__ unsigned xb_add(unsigned* p, unsigned v) { return __hip_atomic_fetch_add(p, v, __ATOMIC_RELAXED, __HIP_MEMORY_SCOPE_AGENT); }
__device__ __forceinline__ unsigned xb_xcc_id() { return (unsigned)__builtin_amdgcn_s_getreg((3 << 11) | 20) & 0xFu; }
#define XB_SPIN(cond, bar) do { unsigned _sp = 0; while (cond) { __builtin_amdgcn_s_sleep(1); \
    if ((++_sp & 255u) == 0u) { if (xb_ld(&(bar)[XB_TMO])) break; if (_sp > XB_SPIN_CAP) { atomicAdd(&(bar)[XB_TMO], 1u); break; } } } } while (0)

struct XcdBarrier {
    unsigned* bar; unsigned x;
    volatile LAS unsigned* st;
};

__device__ __forceinline__ XcdBarrier xcd_barrier_post(unsigned* bar, volatile LAS unsigned* st) {
    XcdBarrier b; b.bar = bar; b.x = xb_xcc_id(); b.st = st;
    if (threadIdx.x == 0) (void)xb_add(&bar[XB_XCNT(b.x)], 1u);
    return b;
}
__device__ __forceinline__ void xcd_barrier_complete(unsigned* bar, unsigned x, unsigned& nloc, unsigned& nx) {
    const unsigned G = gridDim.x * gridDim.y * gridDim.z;
    unsigned sum, cnt, mine, sp = 0u;
    for (;;) {
        sum = 0u; cnt = 0u; mine = 0u;
#pragma unroll
        for (unsigned j = 0; j < 16; ++j) { const unsigned c = xb_ld(&bar[XB_XCNT(j)]); sum += c; cnt += (c > 0u) ? 1u : 0u; mine = (j == x) ? c : mine; }
        if (sum == G) break;
        __builtin_amdgcn_s_sleep(1);
        if ((++sp & 255u) == 0u) { if (xb_ld(&bar[XB_TMO])) break; if (sp > XB_SPIN_CAP) { atomicAdd(&bar[XB_TMO], 1u); break; } }
    }
    nloc = mine > 0u ? mine : 1u; nx = cnt > 0u ? cnt : 1u;
}

__device__ __forceinline__ void xcd_barrier(const XcdBarrier& b) {
    asm volatile("s_waitcnt vmcnt(0)" ::: "memory");
    __syncthreads();
    if (threadIdx.x == 0) {
        unsigned* bar = b.bar;
        __builtin_amdgcn_s_waitcnt(0);
        unsigned nloc = b.st[0], nx = b.st[1];
        if (nloc == 0u) { xcd_barrier_complete(bar, b.x, nloc, nx); b.st[0] = nloc; b.st[1] = nx; }
        const unsigned old = xb_add(&bar[XB_XSUB(b.x)], 1u);
        const unsigned gen = old / nloc;
        if (old + 1u == (gen + 1u) * nloc) {
            __builtin_amdgcn_fence(__ATOMIC_RELEASE, "agent");
            asm volatile("s_waitcnt vmcnt(0)" ::: "memory");
            const unsigned og = xb_add(&bar[XB_TOP], 1u);
            const unsigned tg = og / nx;
            if (og + 1u == (tg + 1u) * nx) xb_add(&bar[XB_TOPGEN], 1u);
            else XB_SPIN(xb_ld(&bar[XB_TOPGEN]) == tg, bar);
            __builtin_amdgcn_fence(__ATOMIC_ACQUIRE, "agent");
            xb_add(&bar[XB_XGEN(b.x)], 1u);
            asm volatile("s_waitcnt vmcnt(0)" ::: "memory");
        } else {
            XB_SPIN(xb_ld(&bar[XB_XGEN(b.x)]) == gen, bar);
            __builtin_amdgcn_fence(__ATOMIC_ACQUIRE, "agent");
            asm volatile("s_waitcnt vmcnt(0)" ::: "memory");
        }
    }
    __syncthreads();
}
#endif
DEVFN float block_sum(float v, float* red) {
    red[TID] = v; SYNC();
    for (int s = NTHR >> 1; s > 0; s >>= 1) { if (TID < s) red[TID] += red[TID + s]; SYNC(); }
    const float r = red[0]; SYNC(); return r;
}

DEVFN void tr_weight(const float* W, int K, int N, int NP, act_t* Wt) {
    GSL(i, (long)NP * K) { const int n = (int)(i / K), k = (int)(i % K); Wt[i] = n < N ? to_act(W[(size_t)k * N + n]) : to_act(0.f); }
}
DEVFN void st_prep_kvcs(const Params& p) {
    GSL(i, (long)DEC_BATCH * NCS * KV2) {
        const int c = (int)(i % KV2), n = (int)((i / KV2) % NCS), bs = (int)(i / ((long)KV2 * NCS));
        const float* base = p.cache_cmp + ((size_t)p.page_table[bs * N_PAGES + (32 * n) / PAGE] * PAGE + (32 * n) % PAGE) * KV2 + c;
        float acc = 0.f;
#pragma unroll 8
        for (int cc = 0; cc < 32; ++cc) acc += base[(size_t)cc * KV2] * p.w_cmp[cc * KV2 + c];
        p.KVCs()[i] = acc;
    }
}
DEVFN void st_prep(const Params& p, float* sm) {
#if 0
    tr_weight(p.w_in, D, PROJ, NPROJ, p.Wt_in()); tr_weight(p.w_o, D, D, D, p.Wt_o()); tr_weight(p.w_ffn_in, D, 2 * FFN, 2 * FFN, p.Wt_ffi());
    tr_weight(p.w_ffn_out, FFN, D, D, p.Wt_ffo()); tr_weight(p.w_ple_gate, D, D, D, p.Wt_pg()); tr_weight(p.w_ple, PLE, D, D, p.Wt_ple());
#endif
    USL(m, MPAD) {
        act_t* h = p.H1() + (size_t)m * D; act_t* pb = p.Pbf() + (size_t)m * PLE;
        if (m >= M) { BSL(k, D) h[k] = to_act(0.f); BSL(k, PLE) pb[k] = to_act(0.f); continue; }
        const float* x = x_row(p, m);
        float part = 0.f; BSL(k, D) part += x[k] * x[k];
        const float r = rsqrt_f(block_sum(part, sm) / (float)D + RMS_EPS);
        BSL(k, D) h[k] = to_act(x[k] * r * p.g_pre1[k]);
        const float* pl = m < MPR ? p.p_prompt + (size_t)m * PLE : p.p_sample + (size_t)(m - MPR) * PLE;
        BSL(k, PLE) pb[k] = to_act(pl[k]);
    }
    st_prep_kvcs(p);
}

DEVFN float conv_tap(const Params& p, int m, int j, int c) {
    if (m < MPR) { const int b = m / SEQ, tt = m % SEQ + j - 3; return tt >= 0 ? p.Z()[(size_t)(b * SEQ + tt) * NPROJ + C_QKV + c] : 0.f; }
    const int bs = (m - MPR) / DEC_SEQ, tt = (m - MPR) % DEC_SEQ + j - 3;
    return tt >= 0 ? p.Z()[(size_t)(MPR + bs * DEC_SEQ + tt) * NPROJ + C_QKV + c] : p.state_conv[(size_t)(bs * 3 + tt + 3) * (3 * GW) + c];
}
DEVFN void st_post_inproj(const Params& p) {
    GSL(i, (long)M * KV2) { const int c = (int)(i % KV2), m = (int)(i / KV2);
        const float vc = p.Z()[(size_t)m * NPROJ + C_CMP + c], vs = p.Z()[(size_t)m * NPROJ + C_SEL + c];
        if (m < MPR) { p.out[O_CMPP + i] = vc; p.out[O_SELP + i] = vs; } else { const long o = i - (long)MPR * KV2; p.out[O_CMPS + o] = vc; p.out[O_SELS + o] = vs; } }
    GSL(i, (long)BATCH * WINBUF * KV2) { const int c = (int)(i % KV2), j = (int)((i / KV2) % WINBUF), b = (int)(i / ((long)KV2 * WINBUF));
        p.out[O_WINP + i] = p.Z()[(size_t)(b * SEQ + SEQ - WINBUF + j) * NPROJ + C_WIN + c]; }
    GSL(i, (long)DEC_BATCH * WINBUF * KV2) { const int c = (int)(i % KV2), j = (int)((i / KV2) % WINBUF), bs = (int)(i / ((long)KV2 * WINBUF));
        const int jj = j + DEC_SEQ;
        p.out[O_WINS + i] = jj < WINBUF ? p.state_win[((size_t)bs * WINBUF + jj) * KV2 + c] : p.Z()[(size_t)(MPR + bs * DEC_SEQ + jj - WINBUF) * NPROJ + C_WIN + c]; }
    GSL(i, (long)BATCH * 3 * 3 * GW) { const int c = (int)(i % (3 * GW)), j = (int)((i / (3 * GW)) % 3), b = (int)(i / (9L * GW));
        p.out[O_CONVP + i] = p.Z()[(size_t)(b * SEQ + SEQ - 3 + j) * NPROJ + C_QKV + c]; }
    GSL(i, (long)DEC_BATCH * 3 * 3 * GW) { const int c = (int)(i % (3 * GW)), j = (int)((i / (3 * GW)) % 3), bs = (int)(i / (9L * GW));
        p.out[O_CONVS + i] = p.Z()[(size_t)(MPR + bs * DEC_SEQ + DEC_SEQ - 3 + j) * NPROJ + C_QKV + c]; }
    GSL(i, (long)MSA * 3 * GH) { const int h = (int)(i % GH), part = (int)((i / GH) % 3), m = MPR + (int)(i / (3 * GH));
        float* dst = p.QKVc() + (size_t)m * 3 * GW + part * GW + h * HD; float ss = 0.f;
        for (int d = 0; d < HD; ++d) { const int c = part * GW + h * HD + d; float a = 0.f;
            for (int j = 0; j < 4; ++j) a += conv_tap(p, m, j, c) * p.conv_w[(size_t)j * 3 * GW + c];
            const float v = silu_f(a); dst[d] = v; ss += v * v; }
        if (part < 2) { const float r = rsqrt_f(ss + RMS_EPS) * (part == 0 ? QSCALE : 1.0f); for (int d = 0; d < HD; ++d) dst[d] *= r; } }
    GSL(i, (long)M * GH) { const int h = (int)(i % GH), m = (int)(i / GH);
        p.GB()[(size_t)m * 2 * GH + h] = -expf(p.A_log[h]) * softplus_f(p.Z()[(size_t)m * NPROJ + C_A + h] + p.dt_bias[h]);
        p.GB()[(size_t)m * 2 * GH + GH + h] = sigmoid_f(p.Z()[(size_t)m * NPROJ + C_B + h]); }
    GSL(i, (long)BATCH * NCP * KV2) { const int c = (int)(i % KV2), n = (int)((i / KV2) % NCP), b = (int)(i / ((long)KV2 * NCP)); float acc = 0.f;
        for (int cc = 0; cc < 32; ++cc) acc += p.Z()[(size_t)(b * SEQ + 32 * n + cc) * NPROJ + C_CMP + c] * p.w_cmp[cc * KV2 + c];
        p.KVCp()[i] = acc; }
}

DEVFN void st_gdn_naive(const Params& p, int s_lo) {
    GSL(item, (long)(BATCH + DEC_BATCH - s_lo) * GH * HD) {
        const int v = (int)(item % HD), h = (int)((item / HD) % GH), s = s_lo + (int)(item / (HD * GH));
        float S[HD]; int m0, T; float* sout;
        if (s < BATCH) { m0 = s * SEQ; T = SEQ; sout = p.out + O_GDNP + ((size_t)(s * GH + h) * HD) * HD + v;
#pragma unroll
            for (int k = 0; k < HD; ++k) S[k] = 0.f; }
        else { const int bs = s - BATCH; m0 = MPR + bs * DEC_SEQ; T = DEC_SEQ; sout = p.out + O_GDNS + ((size_t)(bs * GH + h) * HD) * HD + v;
#pragma unroll
            for (int k = 0; k < HD; ++k) S[k] = p.state_gdn[((size_t)(bs * GH + h) * HD + k) * HD + v]; }
        for (int t = 0; t < T; ++t) { const int m = UNIFORM(m0 + t); const int hu = UNIFORM(h);
            const float* q = p.QKVc() + (size_t)m * 3 * GW + hu * HD; const float* kk = q + GW; const float vv = q[2 * GW + v];
            const float eg = expf(p.GB()[(size_t)m * 2 * GH + hu]), beta = p.GB()[(size_t)m * 2 * GH + GH + hu];
            float dot = 0.f;
#pragma unroll
            for (int c = 0; c < HD / 16; ++c) {
#pragma unroll
                for (int k = 0; k < 16; ++k) dot += S[c * 16 + k] * kk[c * 16 + k];
                CFENCE(); }
            const float vn = beta * (vv - eg * dot); float o = 0.f;
#pragma unroll
            for (int c = 0; c < HD / 16; ++c) {
#pragma unroll
                for (int k = 0; k < 16; ++k) { S[c * 16 + k] = eg * S[c * 16 + k] + kk[c * 16 + k] * vn; o += S[c * 16 + k] * q[c * 16 + k]; }
                CFENCE(); }
            p.OA()[(size_t)m * GW + h * HD + v] = o; }
#pragma unroll
        for (int k = 0; k < HD; ++k) sout[(size_t)k * HD] = S[k];
    }
}

constexpr int SCW = 1024;
static_assert(NCP <= SCW && NCS <= SCW && WINDOW <= SCW, "score buffer");
constexpr int NSMAX = NSP > NSS ? NSP : NSS;
DEVFN const float* sel_row(const Params& p, bool smp, int b, int kpos, int x, int g) {
    if (!smp) return p.Z() + (size_t)(b * SEQ + kpos) * NPROJ + C_SEL + x * KVW + g * HD;
    if (kpos < PAST) return p.cache_sel + ((size_t)p.page_table[b * N_PAGES + kpos / PAGE] * PAGE + kpos % PAGE) * KV2 + x * KVW + g * HD;
    return p.Z() + (size_t)(MPR + b * DEC_SEQ + kpos - PAST) * NPROJ + C_SEL + x * KVW + g * HD;
}
DEVFN const float* win_row(const Params& p, bool smp, int b, int wpos, int x, int g) {
    if (!smp) return p.Z() + (size_t)(b * SEQ + wpos) * NPROJ + C_WIN + x * KVW + g * HD;
    if (wpos < PAST) return p.state_win + ((size_t)b * WINBUF + (wpos - (PAST - WINBUF))) * KV2 + x * KVW + g * HD;
    return p.Z() + (size_t)(MPR + b * DEC_SEQ + wpos - PAST) * NPROJ + C_WIN + x * KVW + g * HD;
}
DEVFN void nsa_softmax(float* ssc, float* sstat, int n) {
    BSL(r, 4) { float mx = -3.0e38f; for (int i = 0; i < n; ++i) mx = fmaxf(mx, ssc[r * SCW + i]);
        if (mx < -1e29f) { sstat[r] = 0.f; sstat[4 + r] = 0.f; }
        else { float sum = 0.f; for (int i = 0; i < n; ++i) { const float s = ssc[r * SCW + i]; if (s > -1e29f) sum += expf(s - mx); } sstat[r] = mx; sstat[4 + r] = 1.0f / sum; } }
    SYNC();
    BSL(i, 4 * n) { const int r = i / n, ii = i % n; const float s = ssc[r * SCW + ii]; ssc[r * SCW + ii] = s > -1e29f ? expf(s - sstat[r]) * sstat[4 + r] : 0.f; }
    SYNC();
}
DEVFN void st_nsa_naive(const Params& p, float* sm, int m_lo) {
    float* sq = sm; float* sgate = sq + 4 * HD; float* so = sgate + 16; float* sstat = so + 4 * HD; float* sscore = sstat + 16; int* sidx = (int*)(sscore + ((NSMAX + 15) / 16) * 16);
    float* ssc = (float*)(sidx + 16);
    USL(u, (M - m_lo) * NKV) {
        const int m = m_lo + u / NKV, g = u % NKV; const bool smp = m >= MPR;
        const int b = smp ? (m - MPR) / DEC_SEQ : m / SEQ, tpos = smp ? PAST + (m - MPR) % DEC_SEQ : m % SEQ;
        const int NC = smp ? NCS : NCP, NS = smp ? NSS : NSP, ksel = smp ? KSEL_S : KSEL_P;
        const float* kvc = smp ? p.KVCs() + (size_t)b * NCS * KV2 : p.KVCp() + (size_t)b * NCP * KV2;
        BSL(i, 4 * HD) sq[i] = p.Z()[(size_t)m * NPROJ + C_QN + g * 4 * HD + i] * QSCALE;
        BSL(i, 12) sgate[i] = sigmoid_f(p.Z()[(size_t)m * NPROJ + C_GN + g * 12 + i]);
        SYNC();
        BSL(i, 4 * NC) { const int r = i / NC, n = i % NC, cend = 32 * n + 31; float s = NEG_INF;
            if (tpos >= cend) { const float* kr = kvc + (size_t)n * KV2 + g * HD; float a = 0.f; for (int d = 0; d < HD; ++d) a += sq[r * HD + d] * kr[d];
                s = a - exp2_f(-8.0f * (float)(g * 4 + r + 1) / (float)NH) * (float)(tpos - cend); }
            ssc[r * SCW + n] = s; }
        SYNC();
        nsa_softmax(ssc, sstat, NC);
        BSL(i, 4 * HD) { const int r = i / HD, d = i % HD; float a = 0.f;
            for (int n = 0; n < NC; ++n) { const float pr = ssc[r * SCW + n]; if (pr != 0.f) a += pr * kvc[(size_t)n * KV2 + KVW + g * HD + d]; }
            so[i] = sgate[r * 3 + 0] * a; }
        BSL(j, NS) { float imp = 0.f;
            for (int r = 0; r < 4; ++r) { if (2 * j < NC) imp += ssc[r * SCW + 2 * j]; if (2 * j + 1 < NC) imp += ssc[r * SCW + 2 * j + 1]; }
            const int cur = tpos / 64; const bool forced = (j == 0) || (j == cur) || (j == cur - 1), avail = j * 64 <= tpos;
            sscore[j] = forced ? imp + FORCE_BONUS : (avail ? imp : -1.0f); }
        SYNC();
        if (TID == 0) for (int kk = 0; kk < ksel; ++kk) { int best = 0; float bv = -3.0e38f;
            for (int j = 0; j < NS; ++j) if (sscore[j] > bv) { bv = sscore[j]; best = j; }
            sidx[kk] = best; sscore[best] = -3.0e38f; }
        SYNC();
        BSL(i, 4 * ksel * 64) { const int r = i / (ksel * 64), kk = i % (ksel * 64), kpos = sidx[kk / 64] * 64 + kk % 64; float s = NEG_INF;
            if (kpos <= tpos) { const float* kr = sel_row(p, smp, b, kpos, 0, g); float a = 0.f; for (int d = 0; d < HD; ++d) a += sq[r * HD + d] * kr[d];
                s = a - exp2_f(-8.0f * (float)(g * 4 + r + 1) / (float)NH) * (float)(tpos - kpos); }
            ssc[r * SCW + kk] = s; }
        SYNC();
        nsa_softmax(ssc, sstat, ksel * 64);
        BSL(i, 4 * HD) { const int r = i / HD, d = i % HD; float a = 0.f;
            for (int kk = 0; kk < ksel * 64; ++kk) { const float pr = ssc[r * SCW + kk]; if (pr != 0.f) a += pr * sel_row(p, smp, b, sidx[kk / 64] * 64 + kk % 64, 1, g)[d]; }
            so[i] += sgate[r * 3 + 1] * a; }
        SYNC();
        const int wmin = smp ? PAST - WINBUF : 0;
        BSL(i, 4 * WINDOW) { const int r = i / WINDOW, kk = i % WINDOW, wpos = tpos - (WINDOW - 1) + kk; float s = NEG_INF;
            if (wpos >= wmin) { const float* kr = win_row(p, smp, b, wpos, 0, g); float a = 0.f; for (int d = 0; d < HD; ++d) a += sq[r * HD + d] * kr[d];
                s = a - exp2_f(-8.0f * (float)(g * 4 + r + 1) / (float)NH) * (float)(tpos - wpos); }
            ssc[r * SCW + kk] = s; }
        SYNC();
        nsa_softmax(ssc, sstat, WINDOW);
        BSL(i, 4 * HD) { const int r = i / HD, d = i % HD; float a = 0.f;
            for (int kk = 0; kk < WINDOW; ++kk) { const float pr = ssc[r * SCW + kk]; if (pr != 0.f) a += pr * win_row(p, smp, b, tpos - (WINDOW - 1) + kk, 1, g)[d]; }
            p.On()[(size_t)m * NSAW + g * 4 * HD + i] = so[i] + sgate[r * 3 + 2] * a; }
        SYNC();
    }
}

DEVFN void st_merge(const Params& p) {
    GSL(i, (long)MPAD * GH) { const int h = (int)(i % GH), m = (int)(i / GH); act_t* dst = p.MIX() + (size_t)m * D + h * HD;
        if (m >= M) { for (int d = 0; d < HD; ++d) dst[d] = to_act(0.f); continue; }
        const float* o = p.OA() + (size_t)m * GW + h * HD; float ss = 0.f;
        for (int d = 0; d < HD; ++d) ss += o[d] * o[d];
        const float r = rsqrt_f(ss / (float)HD + RMS_EPS); const float* z = p.Z() + (size_t)m * NPROJ;
        for (int d = 0; d < HD; ++d) { const int c = h * HD + d;
            const float oa = o[d] * r * p.gdn_norm_w[d] * silu_f(z[C_Z + c]);
            dst[d] = to_act(sigmoid_f(z[C_GM + c]) * oa + sigmoid_f(z[C_GM + D + c]) * p.On()[(size_t)m * NSAW + c]); } }
}
DEVFN void st_norm1(const Params& p, float* sm) {
    USL(m, MPAD) { act_t* h2 = p.H2() + (size_t)m * D;
        if (m >= M) { BSL(k, D) h2[k] = to_act(0.f); continue; }
        const float* t1 = p.T1() + (size_t)m * D; const float* x = x_row(p, m); float* x1 = p.X1() + (size_t)m * D;
        float part = 0.f; BSL(k, D) part += t1[k] * t1[k];
        const float r1 = rsqrt_f(block_sum(part, sm) / (float)D + RMS_EPS);
        part = 0.f; BSL(k, D) { const float v = x[k] + t1[k] * r1 * p.g_post1[k]; x1[k] = v; part += v * v; }
        const float r2 = rsqrt_f(block_sum(part, sm) / (float)D + RMS_EPS);
        BSL(k, D) h2[k] = to_act(x1[k] * r2 * p.g_pre2[k]); }
}
DEVFN void st_act(const Params& p) {
    GSL(i, (long)MPAD * FFN) { const int j = (int)(i % FFN), m = (int)(i / FFN);
        p.ACT()[i] = m < M ? to_act(silu_f(p.FF()[(size_t)m * 2 * FFN + j]) * p.FF()[(size_t)m * 2 * FFN + FFN + j]) : to_act(0.f); }
}
DEVFN void st_norm2(const Params& p, float* sm) {
    USL(m, MPAD) { act_t* xb = p.X2b() + (size_t)m * D;
        if (m >= M) { BSL(k, D) xb[k] = to_act(0.f); continue; }
        const float* t2 = p.T2() + (size_t)m * D; const float* x1 = p.X1() + (size_t)m * D; float* x2 = p.X2() + (size_t)m * D;
        float part = 0.f; BSL(k, D) part += t2[k] * t2[k];
        const float r = rsqrt_f(block_sum(part, sm) / (float)D + RMS_EPS);
        BSL(k, D) { const float v = x1[k] + t2[k] * r * p.g_post2[k]; x2[k] = v; xb[k] = to_act(v); } }
}
DEVFN void st_final(const Params& p) {
    GSL(i, (long)M * D) { const int m = (int)(i / D);
        const float y = p.X2()[i] + sigmoid_f(p.G()[i]) * p.PL()[i];
        if (m < MPR) p.out[O_YP + i] = y; else p.out[O_YS + (i - (long)MPR * D)] = y; }
}

constexpr int GC = 64, NCHK = SEQ / GC;
constexpr int G1_LP = GC + 4, HP = HD + 1;
DEVFN void st_gdn_g1(const Params& p, float* sm) {
    float* Qh = sm; float* Kh = Qh + GC * HP; float* Vh = Kh + GC * HP; float* Lm = Vh + GC * HP; float* gcs = Lm + GC * G1_LP; float* bet = gcs + GC; float* rs = bet + GC;
    USL(u, BATCH * GH * NCHK) {
        const int c = u % NCHK, h = (u / NCHK) % GH, b = u / (NCHK * GH); const int m0 = b * SEQ + c * GC;
        BSL(i, GC * 3 * HD) { const int d = i % HD, part = (i / HD) % 3, r = i / (3 * HD); const int ch = part * GW + h * HD + d; float a = 0.f;
            for (int j = 0; j < 4; ++j) a += conv_tap(p, m0 + r, j, ch) * p.conv_w[(size_t)j * 3 * GW + ch];
            const float v = silu_f(a); if (part == 0) Qh[r * HP + d] = v; else if (part == 1) Kh[r * HP + d] = v; else Vh[r * HP + d] = v; }
        BSL(r, GC) { const float* z = p.Z() + (size_t)(m0 + r) * NPROJ; gcs[r] = -expf(p.A_log[h]) * softplus_f(z[C_A + h] + p.dt_bias[h]); bet[r] = sigmoid_f(z[C_B + h]); }
        SYNC();
        BSL(i, 2 * GC) { const int r = i % GC; const float* src = (i < GC ? Qh : Kh) + r * HP; float ss = 0.f; for (int d = 0; d < HD; ++d) ss += src[d] * src[d];
            rs[i] = rsqrt_f(ss + RMS_EPS) * (i < GC ? QSCALE : 1.0f); }
        if (TID == 0) { float a = 0.f; for (int r = 0; r < GC; ++r) { a += gcs[r]; gcs[r] = a; } }
        SYNC();
        BSL(i, GC * HD) { const int r = i / HD, x = r * HP + i % HD; Qh[x] *= rs[r]; Kh[x] *= rs[GC + r]; Vh[x] *= bet[r]; }
        SYNC();
        const size_t cu = (size_t)u;
        BSL(i, GC * GC) { const int j = i % GC, r = i / GC; float kk = 0.f, qk = 0.f;
            if (j <= r) { for (int d = 0; d < HD; ++d) { const float kj = Kh[j * HP + d]; kk += Kh[r * HP + d] * kj; qk += Qh[r * HP + d] * kj; } }
            const float dec = j <= r ? expf(gcs[r] - gcs[j]) : 0.f;
            Lm[r * G1_LP + j] = j < r ? kk * dec * bet[r] : 0.f;
            p.GQK()[cu * GC * GC + i] = to_act(qk * dec); }
        SYNC();
        BSL(i, GC * HD) { const int r = i / HD, x = r * HP + i % HD; p.GQG()[cu * GC * HD + i] = to_act(Qh[x] * expf(gcs[r])); p.GKD()[(cu * HD + i % HD) * GC + r] = to_act(Kh[x] * expf(gcs[GC - 1] - gcs[r])); }
        SYNC();
        BSL(i, GC * HD) { const int r = i / HD; Kh[r * HP + i % HD] *= bet[r] * expf(gcs[r]); }
        SYNC();
        BSL(col, 2 * HD) { float* X = col < HD ? Vh + col : Kh + (col - HD);
            for (int r = 1; r < GC; ++r) { float a = X[r * HP]; const float* lr = Lm + r * G1_LP;
                for (int j = 0; j < r; ++j) a -= lr[j] * X[j * HP];
                X[r * HP] = a; } }
        SYNC();
        BSL(i, GC * HD) { const int x = (i / HD) * HP + i % HD; p.GU()[cu * GC * HD + i] = Vh[x]; p.GNW()[cu * GC * HD + i] = to_act(-Kh[x]); }
        if (TID == 0) p.GEL()[cu] = expf(gcs[GC - 1]);
        SYNC();
    }
}
constexpr int G2_SL = 16, G2_NSL = HD / G2_SL;
DEVFN void st_gdn_g2(const Params& p, float* sm) {
    float* S = sm; float* Us = S + HD * G2_SL; float* VN = Us + GC * G2_SL; float* O1 = VN + GC * G2_SL; act_t* NW = (act_t*)(O1 + GC * G2_SL); act_t* QG = NW + GC * HD; act_t* KD = QG + GC * HD; act_t* QK = KD + GC * HD;
    USL(u, BATCH * GH * G2_NSL) {
        const int sl = u % G2_NSL, h = (u / G2_NSL) % GH, b = u / (G2_NSL * GH); const int v0 = sl * G2_SL;
        BSL(i, HD * G2_SL) S[i] = 0.f;
        SYNC();
        for (int c = 0; c < NCHK; ++c) {
            const size_t cu = (size_t)(b * GH + h) * NCHK + c;
            BSL(i, GC * HD) { NW[i] = p.GNW()[cu * GC * HD + i]; QG[i] = p.GQG()[cu * GC * HD + i]; KD[i] = p.GKD()[(cu * HD + i % HD) * GC + i / HD]; }
            BSL(i, GC * GC) QK[i] = p.GQK()[cu * GC * GC + i];
            BSL(i, GC * G2_SL) { const int v = i % G2_SL, r = i / G2_SL; Us[i] = p.GU()[(cu * GC + r) * HD + v0 + v]; }
            const float egl = p.GEL()[cu];
            SYNC();
            BSL(i, GC * G2_SL) { const int v = i % G2_SL, r = i / G2_SL; float a = Us[i], o = 0.f;
                for (int k = 0; k < HD; ++k) { const float s = S[k * G2_SL + v]; a += from_act(NW[r * HD + k]) * s; o += from_act(QG[r * HD + k]) * s; }
                VN[i] = a; O1[i] = o; }
            SYNC();
            BSL(i, GC * G2_SL) { const int v = i % G2_SL, r = i / G2_SL; float o = O1[i];
                for (int j = 0; j <= r; ++j) o += from_act(QK[r * GC + j]) * VN[j * G2_SL + v];
                p.OA()[(size_t)(b * SEQ + c * GC + r) * GW + h * HD + v0 + v] = o; }
            BSL(i, HD * G2_SL) { const int v = i % G2_SL, k = i / G2_SL; float a = S[i] * egl;
                for (int r = 0; r < GC; ++r) a += from_act(KD[r * HD + k]) * VN[r * G2_SL + v];
                S[i] = a; }
            SYNC();
        }
        BSL(i, HD * G2_SL) { const int v = i % G2_SL, k = i / G2_SL; p.out[O_GDNP + ((size_t)(b * GH + h) * HD + k) * HD + v0 + v] = S[i]; }
        SYNC();
    }
}
#ifndef CPU_SHIM
DEVFN void st_attn_operands(const Params& p) {
    constexpr float QS2 = QSCALE * 1.4426950408889634f;
    GSL(i, (long)MPR * NSAW) { const int c = (int)(i % NSAW), m = (int)(i / NSAW); p.QN()[i] = f2bf(p.Z()[(size_t)m * NPROJ + C_QN + c] * QS2); }
    GSL(i, (long)BATCH * NKV * SEQ * HD) { const int d = (int)(i % HD), pos = (int)((i / HD) % SEQ), g = (int)((i / ((long)HD * SEQ)) % NKV), b = (int)(i / ((long)HD * SEQ * NKV));
        const float* z = p.Z() + (size_t)(b * SEQ + pos) * NPROJ;
        p.SELK()[i] = f2bf(z[C_SEL + g * HD + d]); p.SELV()[i] = f2bf(z[C_SEL + KVW + g * HD + d]);
        p.WINK()[i] = f2bf(z[C_WIN + g * HD + d]); p.WINV()[i] = f2bf(z[C_WIN + KVW + g * HD + d]); }
    GSL(i, (long)BATCH * NKV * NCP * HD) { const int d = (int)(i % HD), n = (int)((i / HD) % NCP), g = (int)((i / ((long)HD * NCP)) % NKV), b = (int)(i / ((long)HD * NCP * NKV));
        float ak = 0.f, av = 0.f;
        for (int cc = 0; cc < 32; ++cc) { const float* z = p.Z() + (size_t)(b * SEQ + 32 * n + cc) * NPROJ + C_CMP + g * HD + d;
            ak += z[0] * p.w_cmp[cc * KV2 + g * HD + d]; av += z[KVW] * p.w_cmp[cc * KV2 + KVW + g * HD + d]; }
        p.CMPK()[i] = f2bf(ak); p.CMPV()[i] = f2bf(av); }
}

namespace na {
using bf16x8 = __attribute__((ext_vector_type(8))) short;
using s16x4  = __attribute__((ext_vector_type(4))) short;
using f32x16 = __attribute__((ext_vector_type(16))) float;
using u32x4  = __attribute__((ext_vector_type(4))) unsigned;
constexpr int TILE_B = 64 * HD * 2;
constexpr int OFF_V = 0, OFF_K = 2 * TILE_B, OFF_WS = 4 * TILE_B, OFF_IMP = OFF_WS + 8 * 512, OFF_MASK = OFF_IMP + 64 * 64 * 4, OFF_ACC = OFF_MASK + 64 * 8, OFF_END = OFF_ACC + 8 * 32 * 64 * 4;
constexpr float NEGM = -1.0e5f, MFLOOR = -3.0e4f, THR2 = 8.0f;
#define NA_KSWZ(row, colB) ((row) * 256 + ((colB) ^ (((row) & 7) << 4)))
#define NA_SBAR() __builtin_amdgcn_sched_barrier(0)
__device__ __forceinline__ int crow(int r, int hi) { return (r & 3) + 8 * (r >> 2) + 4 * hi; }
__device__ __forceinline__ unsigned cvtpk(float lo, float hi) { unsigned r; asm volatile("v_cvt_pk_bf16_f32 %0, %1, %2" : "=v"(r) : "v"(lo), "v"(hi)); return r; }
__device__ __forceinline__ int v_st(int k, int c) { const int kk = (k & ~0xC) | ((k & 4) << 1) | ((k & 8) >> 1); return ((kk >> 3) * 4 + (c >> 5)) * 512 + ((kk & 7) * 32 + (c & 31)) * 2; }
__device__ __forceinline__ int v_rd_base(int lane) { return ((lane & 3) << 3) | (((lane >> 2) & 3) << 6) | (((lane >> 4) & 1) << 5) | (((lane >> 5) & 1) << 8); }
constexpr int v_rd_off(int d0, int ks, int half) { return d0 * 512 + ks * 4096 + half * 2048; }
template <int OFF> __device__ __forceinline__ s16x4 tr_read(int vb) { s16x4 r; asm volatile("ds_read_b64_tr_b16 %0, %1 offset:%2" : "=&v"(r) : "v"(vb), "i"(OFF) : "memory"); return r; }
template <int D0> __device__ __forceinline__ void pv_one(f32x16& od, int vb, bf16x8 pa0, bf16x8 pa1, bf16x8 pa2, bf16x8 pa3) {
    const s16x4 l0 = tr_read<v_rd_off(D0, 0, 0)>(vb), h0 = tr_read<v_rd_off(D0, 0, 1)>(vb), l1 = tr_read<v_rd_off(D0, 1, 0)>(vb), h1 = tr_read<v_rd_off(D0, 1, 1)>(vb);
    const s16x4 l2 = tr_read<v_rd_off(D0, 2, 0)>(vb), h2 = tr_read<v_rd_off(D0, 2, 1)>(vb), l3 = tr_read<v_rd_off(D0, 3, 0)>(vb), h3 = tr_read<v_rd_off(D0, 3, 1)>(vb);
    asm volatile("s_waitcnt lgkmcnt(0)" ::: "memory"); NA_SBAR();
#define NA_PK(L, H) (bf16x8){L[0], L[1], L[2], L[3], H[0], H[1], H[2], H[3]}
    od = __builtin_amdgcn_mfma_f32_32x32x16_bf16(pa0, NA_PK(l0, h0), od, 0, 0, 0);
    od = __builtin_amdgcn_mfma_f32_32x32x16_bf16(pa1, NA_PK(l1, h1), od, 0, 0, 0);
    od = __builtin_amdgcn_mfma_f32_32x32x16_bf16(pa2, NA_PK(l2, h2), od, 0, 0, 0);
    od = __builtin_amdgcn_mfma_f32_32x32x16_bf16(pa3, NA_PK(l3, h3), od, 0, 0, 0);
#undef NA_PK
}
__device__ __forceinline__ void pv_d0(f32x16* o, int vb, bf16x8 pa0, bf16x8 pa1, bf16x8 pa2, bf16x8 pa3) {
    pv_one<0>(o[0], vb, pa0, pa1, pa2, pa3); pv_one<1>(o[1], vb, pa0, pa1, pa2, pa3); pv_one<2>(o[2], vb, pa0, pa1, pa2, pa3); pv_one<3>(o[3], vb, pa0, pa1, pa2, pa3);
}
template <bool EDGE = true> __device__ __forceinline__ void qkt_bias(f32x16& p0, f32x16& p1, const char* Ks, const bf16x8* qr, int r32, int hi, float A, float Bv, int lo, int hi_lim) {
    const float B0 = fmaf(A, (float)(4 * hi), Bv), B1 = fmaf(A, 32.0f, B0); const int l0 = lo - 4 * hi, h0 = hi_lim - 4 * hi;
#pragma unroll
    for (int r = 0; r < 16; ++r) { const int c = (r & 3) + 8 * (r >> 2);
        if (EDGE) { p0[r] = (c >= l0 && c <= h0) ? fmaf(A, (float)c, B0) : NEGM; p1[r] = (c + 32 >= l0 && c + 32 <= h0) ? fmaf(A, (float)c, B1) : NEGM; }
        else { p0[r] = fmaf(A, (float)c, B0); p1[r] = fmaf(A, (float)c, B1); } }
#pragma unroll
    for (int d0 = 0; d0 < 8; ++d0) { const int cb = (d0 * 16 + hi * 8) * 2;
        const bf16x8 b0 = *reinterpret_cast<const bf16x8*>(Ks + NA_KSWZ(r32, cb));
        const bf16x8 b1 = *reinterpret_cast<const bf16x8*>(Ks + NA_KSWZ(32 + r32, cb));
        p0 = __builtin_amdgcn_mfma_f32_32x32x16_bf16(b0, qr[d0], p0, 0, 0, 0);
        p1 = __builtin_amdgcn_mfma_f32_32x32x16_bf16(b1, qr[d0], p1, 0, 0, 0); }
}
__device__ __forceinline__ void softmax_pack(f32x16& p0, f32x16& p1, float& m_reg, float& l_reg, float& alpha, bf16x8& pa0, bf16x8& pa1, bf16x8& pa2, bf16x8& pa3) {
    float pmax = p0[0];
#pragma unroll
    for (int r = 1; r < 16; ++r) pmax = fmaxf(pmax, p0[r]);
#pragma unroll
    for (int r = 0; r < 16; ++r) pmax = fmaxf(pmax, p1[r]);
    { auto rr = __builtin_amdgcn_permlane32_swap(__float_as_uint(pmax), __float_as_uint(pmax), false, false); pmax = fmaxf(__uint_as_float(rr[0]), __uint_as_float(rr[1])); }
    float mn;
    if (__all(pmax - m_reg <= THR2)) { mn = m_reg; alpha = 1.f; }
    else { mn = fmaxf(m_reg, pmax); alpha = __builtin_amdgcn_exp2f(m_reg - mn); m_reg = mn; }
    float ps = 0.f;
#pragma unroll
    for (int r = 0; r < 16; ++r) { p0[r] = __builtin_amdgcn_exp2f(p0[r] - mn); p1[r] = __builtin_amdgcn_exp2f(p1[r] - mn); ps += p0[r] + p1[r]; }
    { auto rr = __builtin_amdgcn_permlane32_swap(__float_as_uint(ps), __float_as_uint(ps), false, false); ps = __uint_as_float(rr[0]) + __uint_as_float(rr[1]); }
    l_reg = l_reg * alpha + ps;
#define NA_PK4(P, BASE, OUT) do { unsigned a0 = cvtpk(P[BASE + 0], P[BASE + 1]), a1 = cvtpk(P[BASE + 2], P[BASE + 3]);   \
    unsigned b0 = cvtpk(P[BASE + 4], P[BASE + 5]), b1 = cvtpk(P[BASE + 6], P[BASE + 7]);                              \
    auto r0 = __builtin_amdgcn_permlane32_swap(a0, b0, false, false); auto r1 = __builtin_amdgcn_permlane32_swap(a1, b1, false, false); \
    u32x4 w = {r0[0], r1[0], r0[1], r1[1]}; OUT = *reinterpret_cast<bf16x8*>(&w); } while (0)
    NA_PK4(p0, 0, pa0); NA_PK4(p0, 8, pa1); NA_PK4(p1, 0, pa2); NA_PK4(p1, 8, pa3);
#undef NA_PK4
}

struct Tile { const bf16_t* K; const bf16_t* V; };

__device__ __forceinline__ void nsa_unit(const Params& p, char* lds, int b, int i, int g) {
    const int tid = tid_now(), wid = tid >> 6, lane = tid & 63, r32 = lane & 31, hi = lane >> 5;
    const int tl = r32 >> 2, rh = r32 & 3, row = 8 * wid + tl, t = 64 * i + row, h = 4 * g + rh;
    const float slope2 = exp2f(-8.0f * (float)(h + 1) / (float)NH) * 1.4426950408889634f, tf = (float)t;
    char* V_lds = lds + OFF_V; char* K_lds = lds + OFF_K;
    float* ws = (float*)(lds + OFF_WS) + wid * 128; float* li_l = ws; float* al_l = ws + 32;
    float* imp_t = (float*)(lds + OFF_IMP); unsigned* masks = (unsigned*)(lds + OFF_MASK);
    bf16x8 qr[8];
    { const bf16_t* Qw = p.QN() + (size_t)(b * SEQ + t) * NSAW + h * HD + hi * 8;
#pragma unroll
      for (int d0 = 0; d0 < 8; ++d0) qr[d0] = *reinterpret_cast<const bf16x8*>(Qw + d0 * 16); }
    const float* gz = p.SMf() + (size_t)(b * SEQ + t) * 128 + 2 * GH + g * 12 + rh * 3;
#define NA_GATE(x) (gz[x])
    const int sr = tid >> 4, sc = (tid & 15) * 8, vst0 = v_st(sr, sc), vst1 = v_st(32 + sr, sc), kst0 = NA_KSWZ(sr, sc * 2), kst1 = NA_KSWZ(32 + sr, sc * 2);
    const int vb0 = (int)(uintptr_t)V_lds + v_rd_base(lane);
    bf16x8 sK0, sK1, sV0, sV1;
#define NA_SLOAD(T) do { sK0 = *reinterpret_cast<const bf16x8*>((T).K + (size_t)sr * HD + sc); sK1 = *reinterpret_cast<const bf16x8*>((T).K + (size_t)(32 + sr) * HD + sc); \
                         sV0 = *reinterpret_cast<const bf16x8*>((T).V + (size_t)sr * HD + sc); sV1 = *reinterpret_cast<const bf16x8*>((T).V + (size_t)(32 + sr) * HD + sc); } while (0)
#define NA_SWRITE(bf) do { *(bf16x8*)(V_lds + (bf) * TILE_B + vst0) = sV0; *(bf16x8*)(V_lds + (bf) * TILE_B + vst1) = sV1; \
                           *(bf16x8*)(K_lds + (bf) * TILE_B + kst0) = sK0; *(bf16x8*)(K_lds + (bf) * TILE_B + kst1) = sK1; } while (0)
#define NA_RESC(a) do { if (__any((a) < 1.f)) { if (hi == 0) al_l[r32] = (a); asm volatile("s_waitcnt lgkmcnt(0)" ::: "memory"); \
    _Pragma("unroll") for (int d = 0; d < 4; ++d) _Pragma("unroll") for (int r = 0; r < 16; ++r) o[d][r] *= al_l[crow(r, hi)]; } } while (0)
    unsigned* accw = (unsigned*)(lds + OFF_ACC) + wid * (32 * 64) + lane;
#define NA_FOLD(gt, STAGE) do { if (hi == 0) li_l[r32] = l_reg > 0.f ? (gt) / l_reg : 0.f; asm volatile("s_waitcnt lgkmcnt(0)" ::: "memory"); \
    _Pragma("unroll") for (int r = 0; r < 16; ++r) { const int q = crow(r, hi); const float f = li_l[q]; \
        float v0 = o[0][r] * f, v1 = o[1][r] * f, v2 = o[2][r] * f, v3 = o[3][r] * f; \
        if ((STAGE) > 0) { const unsigned w0 = accw[(2 * r) * 64], w1 = accw[(2 * r + 1) * 64]; \
            v0 += __uint_as_float(w0 << 16); v1 += __uint_as_float(w0 & 0xffff0000u); v2 += __uint_as_float(w1 << 16); v3 += __uint_as_float(w1 & 0xffff0000u); } \
        if ((STAGE) < 2) { accw[(2 * r) * 64] = cvtpk(v0, v1); accw[(2 * r + 1) * 64] = cvtpk(v2, v3); } \
        else { bf16_t* dst = p.Onh() + (size_t)(b * SEQ + 64 * i + 8 * wid + (q >> 2)) * NSAW + (4 * g + (q & 3)) * HD + r32; \
            __builtin_nontemporal_store(f2bf(v0), dst); __builtin_nontemporal_store(f2bf(v1), dst + 32); __builtin_nontemporal_store(f2bf(v2), dst + 64); __builtin_nontemporal_store(f2bf(v3), dst + 96); } } } while (0)
    f32x16 o[4];
#pragma unroll
    for (int d = 0; d < 4; ++d)
#pragma unroll
        for (int r = 0; r < 16; ++r) o[d][r] = 0.f;
    float m_reg = MFLOOR, l_reg = 0.f, alpha; f32x16 p0, p1; bf16x8 pa0, pa1, pa2, pa3;

    const int ncmp = (2 * i + 1) / 64 + 1;
    const bf16_t* ck = p.CMPK() + ((size_t)(b * NKV + g) * NCP) * HD; const bf16_t* cv = p.CMPV() + ((size_t)(b * NKV + g) * NCP) * HD;
    __syncthreads();
    for (int c = 0; c < ncmp; ++c) { Tile T{ck + (size_t)c * 64 * HD, cv + (size_t)c * 64 * HD}; NA_SLOAD(T); asm volatile("s_waitcnt vmcnt(0)" ::: "memory"); NA_SWRITE(c); }
    __syncthreads();
    const int climb = ((t + 1) >> 5) - 1;
    for (int c = 0; c < ncmp; ++c) {
        qkt_bias(p0, p1, K_lds + c * TILE_B, qr, r32, hi, 32.0f * slope2, slope2 * ((float)(2048 * c + 31) - tf), 0, climb - 64 * c);
        softmax_pack(p0, p1, m_reg, l_reg, alpha, pa0, pa1, pa2, pa3);
        NA_RESC(alpha);
        pv_d0(o, vb0 + c * TILE_B, pa0, pa1, pa2, pa3);
    }
    { const float inv = l_reg > 0.f ? 1.0f / l_reg : 0.f;
      for (int c = 0; c < ncmp; ++c) {
        qkt_bias(p0, p1, K_lds + c * TILE_B, qr, r32, hi, 32.0f * slope2, slope2 * ((float)(2048 * c + 31) - tf), 0, climb - 64 * c);
#pragma unroll
        for (int a = 0; a < 8; ++a) {
            const int r0 = 4 * (a >> 1) + 2 * (a & 1);
            float v0 = (__builtin_amdgcn_exp2f(p0[r0] - m_reg) + __builtin_amdgcn_exp2f(p0[r0 + 1] - m_reg)) * inv;
            float v1 = (__builtin_amdgcn_exp2f(p1[r0] - m_reg) + __builtin_amdgcn_exp2f(p1[r0 + 1] - m_reg)) * inv;
            v0 += __shfl_xor(v0, 1); v0 += __shfl_xor(v0, 2); v1 += __shfl_xor(v1, 1); v1 += __shfl_xor(v1, 2);
            const int jl = 4 * (a >> 1) + 2 * hi + (a & 1);
            if (rh == 0) { imp_t[row * 64 + 32 * c + jl] = v0; imp_t[row * 64 + 32 * c + 16 + jl] = v1; }
        }
      } }
    NA_FOLD(NA_GATE(0), 0);
    asm volatile("s_waitcnt lgkmcnt(0)" ::: "memory");
    for (int k8 = 0; k8 < 8; ++k8) {
        const int rw = 8 * wid + k8;
        const float im = imp_t[rw * 64 + lane];
        const bool forced = (lane == 0) || (lane == i) || (lane == i - 1), avail = lane <= i;
        const float s = forced ? im + FORCE_BONUS : (avail ? im : -1.0f);
        int cnt = 0;
#pragma unroll
        for (int k = 0; k < 64; ++k) { const float sk = __int_as_float(__builtin_amdgcn_readlane(__float_as_int(s), k)); cnt += (sk > s || (sk == s && k < lane)) ? 1 : 0; }
        const unsigned long long mk = __ballot(cnt < 16);
        if (lane == 0) { masks[2 * rw] = (unsigned)mk; masks[2 * rw + 1] = (unsigned)(mk >> 32); }
    }
    __syncthreads();
    unsigned long long umask;
    { unsigned ulo = masks[2 * lane], uhi = masks[2 * lane + 1];
#pragma unroll
      for (int s = 1; s < 64; s <<= 1) { ulo |= __shfl_xor(ulo, s); uhi |= __shfl_xor(uhi, s); }
      umask = (unsigned long long)__builtin_amdgcn_readfirstlane(ulo) | ((unsigned long long)__builtin_amdgcn_readfirstlane(uhi) << 32); }
    unsigned long long wmask;
    { unsigned wlo = masks[2 * row], whi = masks[2 * row + 1];
#pragma unroll
      for (int s = 1; s < 64; s <<= 1) { wlo |= __shfl_xor(wlo, s); whi |= __shfl_xor(whi, s); }
      wmask = (unsigned long long)__builtin_amdgcn_readfirstlane(wlo) | ((unsigned long long)__builtin_amdgcn_readfirstlane(whi) << 32); }

    {
        const bf16_t* kb = p.SELK() + ((size_t)(b * NKV + g) * SEQ) * HD; const bf16_t* vb = p.SELV() + ((size_t)(b * NKV + g) * SEQ) * HD;
        unsigned long long todo = umask & ((i >= 63) ? ~0ull : ((1ull << (i + 1)) - 1ull));
        m_reg = MFLOOR; l_reg = 0.f;
#pragma unroll
        for (int d = 0; d < 4; ++d)
#pragma unroll
            for (int r = 0; r < 16; ++r) o[d][r] = 0.f;
        int buf = 0;
        if (todo) { const int j0 = __builtin_ctzll(todo); Tile T{kb + (size_t)j0 * 64 * HD, vb + (size_t)j0 * 64 * HD}; NA_SLOAD(T); asm volatile("s_waitcnt vmcnt(0)" ::: "memory"); NA_SWRITE(0); }
        __syncthreads();
        while (todo) {
            const int j = __builtin_ctzll(todo); todo &= todo - 1;
            if (todo) { const int jn = __builtin_ctzll(todo); Tile T{kb + (size_t)jn * 64 * HD, vb + (size_t)jn * 64 * HD}; NA_SLOAD(T); }
            if ((wmask >> j) & 1ull) {
            const float pen = ((masks[2 * row + (j >> 5)] >> (j & 31)) & 1u) ? 0.f : NEGM;
            if (j == i) qkt_bias<true>(p0, p1, K_lds + buf * TILE_B, qr, r32, hi, slope2, slope2 * ((float)(64 * j) - tf) + pen, 0, row);
            else qkt_bias<false>(p0, p1, K_lds + buf * TILE_B, qr, r32, hi, slope2, slope2 * ((float)(64 * j) - tf) + pen, 0, 63);
            softmax_pack(p0, p1, m_reg, l_reg, alpha, pa0, pa1, pa2, pa3);
            NA_RESC(alpha);
            pv_d0(o, vb0 + buf * TILE_B, pa0, pa1, pa2, pa3);
            }
            if (todo) { asm volatile("s_waitcnt vmcnt(0)" ::: "memory"); NA_SWRITE(buf ^ 1); }
            __syncthreads();
            if (DUP_PHASE == 340) __syncthreads();
            buf ^= 1;
        }
        NA_FOLD(NA_GATE(1), 1);
    }
    {
        const bf16_t* kb = p.WINK() + ((size_t)(b * NKV + g) * SEQ) * HD; const bf16_t* vb = p.WINV() + ((size_t)(b * NKV + g) * SEQ) * HD;
        const int jlo = i >= 8 ? i - 8 : 0;
        m_reg = MFLOOR; l_reg = 0.f;
#pragma unroll
        for (int d = 0; d < 4; ++d)
#pragma unroll
            for (int r = 0; r < 16; ++r) o[d][r] = 0.f;
        int buf = 0;
        { Tile T{kb + (size_t)jlo * 64 * HD, vb + (size_t)jlo * 64 * HD}; NA_SLOAD(T); asm volatile("s_waitcnt vmcnt(0)" ::: "memory"); NA_SWRITE(0); }
        __syncthreads();
        for (int j = jlo; j <= i; ++j) {
            if (j < i) { Tile T{kb + (size_t)(j + 1) * 64 * HD, vb + (size_t)(j + 1) * 64 * HD}; NA_SLOAD(T); }
            if (j == i || j == i - 8) qkt_bias<true>(p0, p1, K_lds + buf * TILE_B, qr, r32, hi, slope2, slope2 * ((float)(64 * j) - tf), (j == i - 8) ? row + 1 : 0, j == i ? row : 63);
            else qkt_bias<false>(p0, p1, K_lds + buf * TILE_B, qr, r32, hi, slope2, slope2 * ((float)(64 * j) - tf), 0, 63);
            softmax_pack(p0, p1, m_reg, l_reg, alpha, pa0, pa1, pa2, pa3);
            NA_RESC(alpha);
            pv_d0(o, vb0 + buf * TILE_B, pa0, pa1, pa2, pa3);
            if (j < i) { asm volatile("s_waitcnt vmcnt(0)" ::: "memory"); NA_SWRITE(buf ^ 1); }
            __syncthreads();
            buf ^= 1;
        }
        NA_FOLD(NA_GATE(2), 2);
    }
#undef NA_SLOAD
#undef NA_SWRITE
#undef NA_RESC
#undef NA_FOLD
#undef NA_GATE
}
}
DEVFN void st_nsa_fast_prompt(const Params& p, char* lds) {
    constexpr int NU = BATCH * NKV * (SEQ / 64);
    for (int u = blockIdx.x; u < NU; u += gridDim.x) {
        const int i = (SEQ / 64 - 1) - u / (BATCH * NKV), bg = u % (BATCH * NKV), b = bg / NKV, g = bg % NKV;
        na::nsa_unit(p, lds, b, i, g);
    }
}
#endif
#ifndef CPU_SHIM
__device__ __forceinline__ unsigned pk2bf(float lo, float hi) { unsigned r; asm volatile("v_cvt_pk_bf16_f32 %0, %1, %2" : "=v"(r) : "v"(lo), "v"(hi)); return r; }
typedef unsigned v4u __attribute__((ext_vector_type(4)));
typedef float v4f __attribute__((ext_vector_type(4)));
#ifndef NT_STORES
#define NT_STORES 1
#endif
#if NT_STORES
#define NT_ST(ptr, val) __builtin_nontemporal_store((val), (v4u*)(ptr))
#else
#define NT_ST(ptr, val) (*(v4u*)(ptr) = (val))
#endif
__device__ __forceinline__ v4f load_bf4(const bf16_t* src) { const unsigned long long w = *(const unsigned long long*)src; const unsigned lo = (unsigned)w, hi2 = (unsigned)(w >> 32);
    return (v4f){__uint_as_float(lo << 16), __uint_as_float(lo & 0xffff0000u), __uint_as_float(hi2 << 16), __uint_as_float(hi2 & 0xffff0000u)}; }
__device__ __forceinline__ v4f bf4_unpack(unsigned long long w) { const unsigned lo = (unsigned)w, hi2 = (unsigned)(w >> 32);
    return (v4f){__uint_as_float(lo << 16), __uint_as_float(lo & 0xffff0000u), __uint_as_float(hi2 << 16), __uint_as_float(hi2 & 0xffff0000u)}; }
template <class SrcCol> __device__ __forceinline__ void tr_range(const float* W, int K, int N, int NP, bf16_t* Wt, float* scr_base, SrcCol src, int it0, int it1, int stride) {
    const int lane = tid_now() & 63, wave = tid_now() >> 6; float* scr = scr_base + wave * (64 * 65 + 32);
    const int nblk = NP / 64, nitems = it1, kr = lane >> 4, nq = lane & 15, nr = lane >> 3, kc = lane & 7;
    v4f cur[16], nxt[16];
    int it = it0 + wave;
    auto load = [&](int item, v4f (&dst)[16]) { const int kb = item / nblk, nb = item % nblk; const int sc = src(64 * nb + 4 * nq);
#pragma unroll
        for (int i = 0; i < 16; ++i) dst[i] = sc >= 0 ? *(const v4f*)(W + (size_t)(64 * kb + 4 * i + kr) * N + sc) : (v4f){0.f, 0.f, 0.f, 0.f}; };
    if (it < nitems) load(it, cur);
    for (; it < nitems; it += stride) {
        const int kb = it / nblk, nb = it % nblk, k0 = 64 * kb, n0 = 64 * nb, itn = it + stride;
        if (itn < nitems) load(itn, nxt);
#pragma unroll
        for (int i = 0; i < 16; ++i) { float* d = scr + (4 * i + kr) * 65 + 4 * nq; d[0] = cur[i][0]; d[1] = cur[i][1]; d[2] = cur[i][2]; d[3] = cur[i][3]; }
        asm volatile("s_waitcnt lgkmcnt(0)" ::: "memory");
#pragma unroll
        for (int j = 0; j < 8; ++j) { const int n = 8 * j + nr; const float* s = scr + (8 * kc) * 65 + n;
            v4u o; o.x = pk2bf(s[0 * 65], s[1 * 65]); o.y = pk2bf(s[2 * 65], s[3 * 65]); o.z = pk2bf(s[4 * 65], s[5 * 65]); o.w = pk2bf(s[6 * 65], s[7 * 65]);
            *(v4u*)(Wt + (size_t)(n0 + n) * K + k0 + 8 * kc) = o; }
        asm volatile("s_waitcnt lgkmcnt(0)" ::: "memory");
#pragma unroll
        for (int i = 0; i < 16; ++i) cur[i] = nxt[i];
    }
}
template <class SrcCol> __device__ __forceinline__ void tr_fast(const float* W, int K, int N, int NP, bf16_t* Wt, float* scr_base, SrcCol src) {
    tr_range(W, K, N, NP, Wt, scr_base, src, (int)blockIdx.x * 8, (K / 64) * (NP / 64), (int)gridDim.x * 8);
}
struct SrcIdent { __device__ int operator()(int n) const { return n; } };
struct SrcPad { int N; __device__ int operator()(int n) const { return n < N ? n : -1; } };
struct SrcFfnIn { __device__ int operator()(int n) const { const int t = n >> 8, r = n & 255; return r < 128 ? t * 128 + r : FFN + t * 128 + (r - 128); } };
namespace ip {
constexpr int E_QKV = 0, E_ZA = E_QKV + 3 * GW, E_QN = E_ZA + GW, E_CMP = E_QN + NSAW, E_SEL = E_CMP + KV2, E_WIN = E_SEL + KV2, E_GM = E_WIN + KV2, E_SM = E_GM + 2 * D, E_END = E_SM + 256;
static_assert(E_END == NPROJ && (3 * GW) % 256 == 0 && GW % 256 == 0 && NSAW % 256 == 0 && KV2 % 256 == 0 && 2 * GH + 3 * NH <= 128, "projection tile map");
constexpr int SMW = 128;
struct SrcIn { __device__ int operator()(int n) const {
    if (n < E_QN) return n;
    if (n < E_CMP) return C_QN + (n - E_QN);
    if (n < E_SEL) return C_CMP + (n - E_CMP);
    if (n < E_WIN) return C_SEL + (n - E_SEL);
    if (n < E_GM) return C_WIN + (n - E_WIN);
    if (n < E_SM) return C_GM + (n - E_GM);
    const int c = n - E_SM;
    if (c < GH) return C_A + c; if (c < 2 * GH) return C_B + (c - GH); if (c < 2 * GH + 3 * NH) return C_GN + (c - 2 * GH);
    return -1; } };
__device__ __forceinline__ v4u pack8(const float* v) { v4u w; w.x = pk2bf(v[0], v[1]); w.y = pk2bf(v[2], v[3]); w.z = pk2bf(v[4], v[5]); w.w = pk2bf(v[6], v[7]); return w; }
struct Epi {
    static constexpr bool PERM = true, AFTER_DRAIN = false;
    unsigned char* ws; float* out; const float* A_log; const float* dt_bias;
    template <int SEG> __device__ __forceinline__ void seg(const pg8::f32x4 (&acc)[2][2][4][2], int col0, int rowb, int clb) const {
#pragma unroll
        for (int ai = 0; ai < 2; ++ai)
#pragma unroll
            for (int m = 0; m < 4; ++m) {
                const int row = rowb + ai * 128 + m * 16; const bool prm = row < MPR, real = row < M;
                const int b = prm ? row / SEQ : (row - MPR) / DEC_SEQ, t = prm ? row % SEQ : (row - MPR) % DEC_SEQ;
#pragma unroll
                for (int bj = 0; bj < 2; ++bj) {
                    const int cl = bj * 128 + clb, col = col0 + cl; float v[8];
#pragma unroll
                    for (int e = 0; e < 4; ++e) { v[e] = acc[ai][bj][m][0][e]; v[4 + e] = acc[ai][bj][m][1][e]; }
                    if (SEG == 0) {
                        NT_ST(((bf16_t*)(ws + WSL.QKVb)) + (size_t)row * (3 * GW) + col, pack8(v));
                        if (real && t >= (prm ? SEQ : DEC_SEQ) - 3) { float* d = out + (prm ? O_CONVP : O_CONVS) + ((size_t)(b * 3 + t - ((prm ? SEQ : DEC_SEQ) - 3))) * (3 * GW) + col;
                            *(v4f*)d = (v4f){v[0], v[1], v[2], v[3]}; *(v4f*)(d + 4) = (v4f){v[4], v[5], v[6], v[7]}; }
                    } else if (SEG == 1) {
#pragma unroll
                        for (int e = 0; e < 8; ++e) v[e] = v[e] / (1.0f + __expf(-v[e]));
                        NT_ST(((bf16_t*)(ws + WSL.ZAs)) + (size_t)row * GW + (col - E_ZA), pack8(v));
                    } else if (SEG == 2) {
#pragma unroll
                        for (int e = 0; e < 8; ++e) v[e] *= QSCALE * 1.4426950408889634f;
                        NT_ST(((bf16_t*)(ws + WSL.QN)) + (size_t)row * NSAW + (col - E_QN), pack8(v));
                    } else if (SEG <= 5) {
                        constexpr int sg3 = SEG - 3; const int c = col - (sg3 == 0 ? E_CMP : sg3 == 1 ? E_SEL : E_WIN);
                        if (real) {
                            if (sg3 < 2) { float* d = out + (sg3 == 0 ? (prm ? O_CMPP : O_CMPS) : (prm ? O_SELP : O_SELS)) + (size_t)(prm ? row : row - MPR) * KV2 + c;
                                *(v4f*)d = (v4f){v[0], v[1], v[2], v[3]}; *(v4f*)(d + 4) = (v4f){v[4], v[5], v[6], v[7]}; }
                            else if (!prm || t >= SEQ - WINBUF) { float* d = out + (prm ? O_WINP + ((size_t)b * WINBUF + t - (SEQ - WINBUF)) * KV2 : O_WINS + ((size_t)b * WINBUF + WINBUF - DEC_SEQ + t) * KV2) + c;
                                *(v4f*)d = (v4f){v[0], v[1], v[2], v[3]}; *(v4f*)(d + 4) = (v4f){v[4], v[5], v[6], v[7]}; }
                            if (prm && sg3 > 0) { const int x = c / KVW, g = (c % KVW) / HD, dd = c % HD;
                                bf16_t* base = (bf16_t*)(ws + (sg3 == 1 ? (x ? WSL.SELV : WSL.SELK) : (x ? WSL.WINV : WSL.WINK)));
                                *(v4u*)(base + ((size_t)(b * NKV + g) * SEQ + t) * HD + dd) = pack8(v); } }
                    } else if (SEG == 6) {
#pragma unroll
                        for (int e = 0; e < 8; ++e) v[e] = 1.0f / (1.0f + __expf(-v[e]));
                        NT_ST(((bf16_t*)(ws + WSL.GMs)) + (size_t)row * (2 * D) + (col - E_GM), pack8(v));
                    } else if (cl < SMW) {
#pragma unroll
                        for (int e = 0; e < 8; ++e) { const int c = cl + e;
                            v[e] = c < GH ? -__expf(A_log[c]) * softplus_f(v[e] + dt_bias[c]) : 1.0f / (1.0f + __expf(-v[e])); }
                        float* d = ((float*)(ws + WSL.SMf)) + (size_t)row * SMW + cl; *(v4f*)d = (v4f){v[0], v[1], v[2], v[3]}; *(v4f*)(d + 4) = (v4f){v[4], v[5], v[6], v[7]};
                    }
                }
            }
    }
    __device__ __forceinline__ void operator()(const pg8::f32x4 (&acc)[2][2][4][2], const pg8::Unit& u, int wr, int wc, int fr, int fq) const {
        const int col0 = u.pn * 256, rowb = u.pm * 256 + wr * 64 + fr, clb = wc * 32 + 8 * fq;
        if (col0 < E_ZA) seg<0>(acc, col0, rowb, clb); else if (col0 < E_QN) seg<1>(acc, col0, rowb, clb); else if (col0 < E_CMP) seg<2>(acc, col0, rowb, clb);
        else if (col0 < E_SEL) seg<3>(acc, col0, rowb, clb); else if (col0 < E_WIN) seg<4>(acc, col0, rowb, clb); else if (col0 < E_GM) seg<5>(acc, col0, rowb, clb);
        else if (col0 < E_SM) seg<6>(acc, col0, rowb, clb); else seg<7>(acc, col0, rowb, clb);
    }
};
template <int FORCE> struct EpiProbe {
    static constexpr bool PERM = true, AFTER_DRAIN = false;
    bf16_t* dummy;
    __device__ __forceinline__ void operator()(const pg8::f32x4 (&acc)[2][2][4][2], const pg8::Unit& u, int wr, int wc, int fr, int fq) const {
        const int col0 = u.pn * 256, rowb = u.pm * 256 + wr * 64 + fr, clb = wc * 32 + 8 * fq;
#pragma unroll
        for (int ai = 0; ai < 2; ++ai)
#pragma unroll
            for (int m = 0; m < 4; ++m) { const int row = rowb + ai * 128 + m * 16;
#pragma unroll
                for (int bj = 0; bj < 2; ++bj) { const int col = col0 + bj * 128 + clb; float v[8];
#pragma unroll
                    for (int e = 0; e < 4; ++e) { v[e] = acc[ai][bj][m][0][e]; v[4 + e] = acc[ai][bj][m][1][e]; }
                    if (FORCE == 1) {
#pragma unroll
                        for (int e = 0; e < 8; ++e) v[e] = v[e] / (1.0f + __expf(-v[e])); }
                    if (FORCE == 2) { float* d = (float*)dummy + (size_t)row * (NPROJ / 2) + (col >> 1) / 4 * 4;
                        *(v4f*)d = (v4f){v[0], v[1], v[2], v[3]}; }
                    *(v4u*)(dummy + (size_t)row * NPROJ + col) = pack8(v); } }
    }
};
}
DEVFN void st_prep_weights_fast(const Params& p, float* sm) {
    tr_fast(p.w_in, D, PROJ, NPROJ, p.Wt_in(), sm, ip::SrcIn{});
}
constexpr int TRI_O = (D / 64) * (D / 64), TRI_FI = (D / 64) * (2 * FFN / 64), TRI_FO = (FFN / 64) * (D / 64), TRI_PG = (D / 64) * (D / 64), TRI_PL = (PLE / 64) * (D / 64);
constexpr int TRU = 32;
constexpr int TRN_O = (TRI_O + TRU - 1) / TRU, TRN_FI = (TRI_FI + TRU - 1) / TRU, TRN_FO = (TRI_FO + TRU - 1) / TRU, TRN_PG = (TRI_PG + TRU - 1) / TRU, TRN_PL = (TRI_PL + TRU - 1) / TRU;
constexpr int TRN_ALL = TRN_O + TRN_FI + TRN_FO + TRN_PG + TRN_PL;
DEVFN void tr_filler_unit(const Params& p, float* sm, int u) {
    __syncthreads();
    int v = u;
    if (v < TRN_O) { const int a = v * TRU, b = a + TRU < TRI_O ? a + TRU : TRI_O; tr_range(p.w_o, D, D, D, p.Wt_o(), sm, SrcIdent{}, a, b, 8); return; } v -= TRN_O;
    if (v < TRN_FI) { const int a = v * TRU, b = a + TRU < TRI_FI ? a + TRU : TRI_FI; tr_range(p.w_ffn_in, D, 2 * FFN, 2 * FFN, p.Wt_ffi(), sm, SrcFfnIn{}, a, b, 8); return; } v -= TRN_FI;
    if (v < TRN_FO) { const int a = v * TRU, b = a + TRU < TRI_FO ? a + TRU : TRI_FO; tr_range(p.w_ffn_out, FFN, D, D, p.Wt_ffo(), sm, SrcIdent{}, a, b, 8); return; } v -= TRN_FO;
    if (v < TRN_PG) { const int a = v * TRU, b = a + TRU < TRI_PG ? a + TRU : TRI_PG; tr_range(p.w_ple_gate, D, D, D, p.Wt_pg(), sm, SrcIdent{}, a, b, 8); return; } v -= TRN_PG;
    { const int a = v * TRU, b = a + TRU < TRI_PL ? a + TRU : TRI_PL; tr_range(p.w_ple, PLE, D, D, p.Wt_ple(), sm, SrcIdent{}, a, b, 8); }
}
struct EpiSwiGLU {
    static constexpr bool PERM = true, AFTER_DRAIN = false;
    bf16_t* O; int ldc;
    __device__ __forceinline__ void operator()(const pg8::f32x4 (&acc)[2][2][4][2], const pg8::Unit& u, int wr, int wc, int fr, int fq) const {
        const int row0 = u.pm * 256 + wr * 64 + fr, col0 = u.pn * 128 + wc * 32 + 8 * fq;
#pragma unroll
        for (int ai = 0; ai < 2; ++ai)
#pragma unroll
            for (int m = 0; m < 4; ++m) { float v[8];
#pragma unroll
                for (int n = 0; n < 2; ++n)
#pragma unroll
                    for (int e = 0; e < 4; ++e) { const float g = acc[ai][0][m][n][e], up = acc[ai][1][m][n][e]; v[4 * n + e] = g / (1.0f + __expf(-g)) * up; }
                v4u w; w.x = pk2bf(v[0], v[1]); w.y = pk2bf(v[2], v[3]); w.z = pk2bf(v[4], v[5]); w.w = pk2bf(v[6], v[7]);
                NT_ST(O + (size_t)(row0 + ai * 128 + m * 16) * ldc + col0, w); }
    }
};
struct EpiFinal {
    static constexpr bool PERM = false, AFTER_DRAIN = false;
    const bf16_t* X2; const bf16_t* PL; float* out;
    __device__ __forceinline__ void operator()(const pg8::f32x4 (&acc)[2][2][4][2], const pg8::Unit& u, int wr, int wc, int fr, int fq) const {
        const int row0 = u.pm * 256 + wr * 64 + fr, col0 = u.pn * 256 + wc * 32 + 4 * fq;
#pragma unroll
        for (int ai = 0; ai < 2; ++ai) {
            unsigned long long xq[4][2][2], pq[4][2][2];
#pragma unroll
            for (int m = 0; m < 4; ++m) { const int row = row0 + ai * 128 + m * 16, rl = row < M ? row : 0;
#pragma unroll
                for (int bj = 0; bj < 2; ++bj)
#pragma unroll
                    for (int n = 0; n < 2; ++n) { const int col = col0 + bj * 128 + n * 16;
                        xq[m][bj][n] = *(const unsigned long long*)(X2 + (size_t)rl * D + col); pq[m][bj][n] = *(const unsigned long long*)(PL + (size_t)rl * D + col); } }
#pragma unroll
            for (int m = 0; m < 4; ++m) { const int row = row0 + ai * 128 + m * 16; if (row >= M) continue;
                float* orow = row < MPR ? out + O_YP + (size_t)row * D : out + O_YS + (size_t)(row - MPR) * D;
#pragma unroll
                for (int bj = 0; bj < 2; ++bj)
#pragma unroll
                    for (int n = 0; n < 2; ++n) { const int col = col0 + bj * 128 + n * 16;
                        const v4f x2 = bf4_unpack(xq[m][bj][n]), pl = bf4_unpack(pq[m][bj][n]); const pg8::f32x4 a = acc[ai][bj][m][n]; v4f y;
#pragma unroll
                        for (int e = 0; e < 4; ++e) y[e] = x2[e] + pl[e] / (1.0f + __expf(-a[e]));
                        __builtin_nontemporal_store(y, (v4f*)(orow + col)); } } }
    }
};
DEVFN void st_merge_fast(const Params& p) {
    const int t = tid_now(), c0 = 4 * t;
    const v4f gw = *(const v4f*)(p.gdn_norm_w + (c0 & (HD - 1)));
    constexpr int MR = 8;
    for (int m0 = blockIdx.x; m0 < MPR; m0 += MR * gridDim.x) {
        unsigned long long oq[MR], nq[MR], zq[MR], gaq[MR], gnq[MR];
#pragma unroll
        for (int k = 0; k < MR; ++k) { const int m = m0 + k * (int)gridDim.x, ml = m < MPR ? m : 0;
            oq[k] = *(const unsigned long long*)(p.OAh() + (size_t)ml * GW + c0); nq[k] = *(const unsigned long long*)(p.Onh() + (size_t)ml * NSAW + c0);
            zq[k] = *(const unsigned long long*)(p.ZAs() + (size_t)ml * GW + c0); gaq[k] = *(const unsigned long long*)(p.GMs() + (size_t)ml * 2 * D + c0);
            gnq[k] = *(const unsigned long long*)(p.GMs() + (size_t)ml * 2 * D + D + c0); }
#pragma unroll
        for (int k = 0; k < MR; ++k) { const int m = m0 + k * (int)gridDim.x;
            const v4f o = bf4_unpack(oq[k]), on = bf4_unpack(nq[k]), za = bf4_unpack(zq[k]), ga = bf4_unpack(gaq[k]), gn = bf4_unpack(gnq[k]);
            float ss = o[0] * o[0] + o[1] * o[1] + o[2] * o[2] + o[3] * o[3];
#pragma unroll
            for (int sft = 1; sft < 32; sft <<= 1) ss += __shfl_xor(ss, sft);
            const float r = 1.0f / sqrtf(ss * (1.0f / HD) + RMS_EPS);
            float v[4];
#pragma unroll
            for (int e = 0; e < 4; ++e) v[e] = o[e] * r * gw[e] * za[e] * ga[e] + on[e] * gn[e];
            if (m < MPR) *(unsigned long long*)(p.MIX() + (size_t)m * D + c0) = (unsigned long long)pk2bf(v[0], v[1]) | ((unsigned long long)pk2bf(v[2], v[3]) << 32); }
    }
    for (int m = MPR + blockIdx.x; m < MPAD; m += gridDim.x) {
        bf16_t* dst = p.MIX() + (size_t)m * D + c0;
        if (m >= M) { *(unsigned long long*)dst = 0ull; continue; }
        const v4f o = *(const v4f*)(p.OA() + (size_t)m * GW + c0);
        float ss = o[0] * o[0] + o[1] * o[1] + o[2] * o[2] + o[3] * o[3];
#pragma unroll
        for (int sft = 1; sft < 32; sft <<= 1) ss += __shfl_xor(ss, sft);
        const float r = 1.0f / sqrtf(ss * (1.0f / HD) + RMS_EPS);
        const v4f on = *(const v4f*)(p.On() + (size_t)m * NSAW + c0);
        const v4f za = load_bf4(p.ZAs() + (size_t)m * GW + c0), ga = load_bf4(p.GMs() + (size_t)m * 2 * D + c0), gn = load_bf4(p.GMs() + (size_t)m * 2 * D + D + c0);
        float v[4];
#pragma unroll
        for (int e = 0; e < 4; ++e) v[e] = o[e] * r * gw[e] * za[e] * ga[e] + on[e] * gn[e];
        *(unsigned long long*)dst = (unsigned long long)pk2bf(v[0], v[1]) | ((unsigned long long)pk2bf(v[2], v[3]) << 32);
    }
}
#endif
#ifndef CPU_SHIM
namespace ns {
constexpr float LOG2E = 1.4426950408889634f;
struct Src {
    const Params p;
    __device__ __forceinline__ float q2(int m, int col) const { return bf2f(p.QN()[(size_t)m * NSAW + col]); }
    __device__ __forceinline__ float gate(int m, int idx) const { return p.SMf()[(size_t)m * 128 + 2 * GH + idx]; }
    __device__ __forceinline__ const float* selnew(int bs, int tt, int x, int g) const { return p.out + O_SELS + (size_t)(bs * DEC_SEQ + tt) * KV2 + x * KVW + g * HD; }
    __device__ __forceinline__ const float* winnew(int bs, int tt, int x, int g) const { return p.out + O_WINS + ((size_t)bs * WINBUF + WINBUF - DEC_SEQ + tt) * KV2 + x * KVW + g * HD; }
};
constexpr int SW = 1024;
template <class RowPtr, class Pos> __device__ __forceinline__ void scores(float* ssc, const float* sq, const float* sslope, int nkeys, int tpos, RowPtr rowptr, Pos pos) {
    const int tid = tid_now(), grp = tid >> 4, l16 = tid & 15;
    float q[4][8];
#pragma unroll
    for (int h = 0; h < 4; ++h)
#pragma unroll
        for (int e = 0; e < 8; ++e) q[h][e] = sq[h * HD + l16 * 8 + e];
    constexpr int UN = 16;
    for (int k0 = grp; k0 < nkeys; k0 += 32 * UN) {
        v4f x0[UN], x1[UN]; int kp[UN]; bool valid[UN];
#pragma unroll
        for (int u = 0; u < UN; ++u) { const int k = k0 + 32 * u; const bool in = k < nkeys; kp[u] = in ? pos(k) : 0x7fffffff; valid[u] = in && kp[u] <= tpos && kp[u] >= 0;
            if (valid[u]) { const float* r = rowptr(k) + l16 * 8; x0[u] = *(const v4f*)r; x1[u] = *(const v4f*)(r + 4); } else { x0[u] = (v4f){0.f, 0.f, 0.f, 0.f}; x1[u] = x0[u]; } }
#pragma unroll
        for (int u = 0; u < UN; ++u) { const int k = k0 + 32 * u; float a[4];
#pragma unroll
            for (int h = 0; h < 4; ++h) { a[h] = q[h][0] * x0[u][0] + q[h][1] * x0[u][1] + q[h][2] * x0[u][2] + q[h][3] * x0[u][3] + q[h][4] * x1[u][0] + q[h][5] * x1[u][1] + q[h][6] * x1[u][2] + q[h][7] * x1[u][3];
                a[h] += __shfl_xor(a[h], 1); a[h] += __shfl_xor(a[h], 2); a[h] += __shfl_xor(a[h], 4); a[h] += __shfl_xor(a[h], 8); }
            if (l16 < 4 && k < nkeys) { const float v = l16 == 0 ? a[0] : l16 == 1 ? a[1] : l16 == 2 ? a[2] : a[3];
                ssc[l16 * SW + k] = valid[u] ? v + sslope[l16] * (float)(kp[u] - tpos) : -1.0e30f; } }
    }
}
__device__ __forceinline__ void softmax4(float* ssc, int n) {
    const int wave = tid_now() >> 6, lane = tid_now() & 63;
    if (wave < 4) { float* row = ssc + wave * SW; float mx = -3.0e38f;
        for (int i = lane; i < n; i += 64) mx = fmaxf(mx, row[i]);
#pragma unroll
        for (int s = 1; s < 64; s <<= 1) mx = fmaxf(mx, __shfl_xor(mx, s));
        float sum = 0.f;
        for (int i = lane; i < n; i += 64) { const float s = row[i]; const float e = s > -1.0e29f ? exp2f(s - mx) : 0.f; row[i] = e; sum += e; }
#pragma unroll
        for (int s = 1; s < 64; s <<= 1) sum += __shfl_xor(sum, s);
        const float inv = sum > 0.f ? 1.0f / sum : 0.f;
        for (int i = lane; i < n; i += 64) row[i] *= inv; }
}
constexpr int PVS = 16;
template <class RowPtr> __device__ __forceinline__ void pv(float* sacc  , const float* ssc, int nkeys, RowPtr vrow) {
    const int lane = tid_now() & 63, slot = (tid_now() >> 6) * 2 + (lane >> 5), l32 = lane & 31;
    v4f a[4];
#pragma unroll
    for (int h = 0; h < 4; ++h) a[h] = (v4f){0.f, 0.f, 0.f, 0.f};
    constexpr int UN = 16;
    for (int k0 = slot; k0 < nkeys; k0 += PVS * UN) {
        v4f x[UN]; float pp[UN][4];
#pragma unroll
        for (int u = 0; u < UN; ++u) { const int k = k0 + PVS * u; const bool in = k < nkeys;
            pp[u][0] = in ? ssc[k] : 0.f; pp[u][1] = in ? ssc[SW + k] : 0.f; pp[u][2] = in ? ssc[2 * SW + k] : 0.f; pp[u][3] = in ? ssc[3 * SW + k] : 0.f;
            if (pp[u][0] != 0.f || pp[u][1] != 0.f || pp[u][2] != 0.f || pp[u][3] != 0.f) x[u] = *(const v4f*)(vrow(k) + 4 * l32); else x[u] = (v4f){0.f, 0.f, 0.f, 0.f}; }
#pragma unroll
        for (int u = 0; u < UN; ++u) {
#pragma unroll
            for (int h = 0; h < 4; ++h) a[h] += pp[u][h] * x[u]; }
    }
#pragma unroll
    for (int h = 0; h < 4; ++h) *(v4f*)(sacc + (slot * 4 + h) * HD + 4 * l32) = a[h];
}
}
DEVFN void st_nsa_sample_unit(const Params& p, float* sm, int u) {
    using namespace ns;
    float* sq = sm; float* sgate = sq + 4 * HD; float* sslope = sgate + 16; float* so = sslope + 4; float* sscore = so + 4 * HD; int* sidx = (int*)(sscore + 272);
    float* ssc = (float*)(sidx + 16); float* sacc = ssc + 4 * SW;
    long long* sbase = (long long*)(sacc + PVS * 4 * HD);
    const Src S{p}; const int tid = tid_now();
    {
        const int g = u % NKV, mm = u / NKV, bs = mm / DEC_SEQ, tt = mm % DEC_SEQ, m = MPR + mm, tpos = PAST + tt;
        __syncthreads();
        if (tid < 4 * HD) sq[tid] = S.q2(m, g * 4 * HD + tid);
        if (tid < 12) sgate[tid] = S.gate(m, g * 12 + tid);
        if (tid < 4) sslope[tid] = exp2f(-8.0f * (float)(g * 4 + tid + 1) / (float)NH) * LOG2E;
        __syncthreads();
        const float* kvc = p.KVCs() + (size_t)bs * NCS * KV2;
        scores(ssc, sq, sslope, NCS, tpos, [=](int n) { return kvc + (size_t)n * KV2 + g * HD; }, [=](int n) { return 32 * n + 31; });
        __syncthreads();
        softmax4(ssc, NCS);
        __syncthreads();
        pv(sacc, ssc, NCS, [=](int n) { return kvc + (size_t)n * KV2 + KVW + g * HD; });
        for (int j = tid; j < NSS; j += 512) { float imp = 0.f;
#pragma unroll
            for (int r = 0; r < 4; ++r) { if (2 * j < NCS) imp += ssc[r * SW + 2 * j]; if (2 * j + 1 < NCS) imp += ssc[r * SW + 2 * j + 1]; }
            const int cur = tpos / 64; const bool forced = (j == 0) || (j == cur) || (j == cur - 1), avail = j * 64 <= tpos;
            sscore[j] = forced ? imp + FORCE_BONUS : (avail ? imp : -1.0f); }
        __syncthreads();
        if (tid < 4 * HD) { const int h = tid / HD, d = tid % HD; float a = 0.f;
#pragma unroll
            for (int w = 0; w < PVS; ++w) a += sacc[(w * 4 + h) * HD + d];
            so[tid] = sgate[h * 3 + 0] * a; }
        for (int j = tid; j < NSS; j += 512) { const float s = sscore[j]; int cnt = 0;
            for (int k = 0; k < NSS; ++k) { const float sk = sscore[k]; cnt += (sk > s || (sk == s && k < j)) ? 1 : 0; }
            if (cnt < KSEL_S) sidx[cnt] = j; }
        __syncthreads();
        if (tid < KSEL_S) { const int kpos0 = sidx[tid] * 64;
            sbase[tid] = kpos0 < PAST ? (long long)(((size_t)p.page_table[bs * N_PAGES + kpos0 / PAGE] * PAGE + kpos0 % PAGE) * KV2) : -1ll; }
        __syncthreads();
        auto selptr = [=](int kk, int x) -> const float* { const long long bo = sbase[kk >> 6]; const int r = kk & 63;
            if (bo >= 0) return p.cache_sel + (size_t)bo + (size_t)r * KV2 + x * KVW + g * HD;
            return S.selnew(bs, r < DEC_SEQ ? r : DEC_SEQ - 1, x, g); };
        scores(ssc, sq, sslope, KSEL_S * 64, tpos, [=](int kk) { return selptr(kk, 0); }, [=](int kk) { return sidx[kk >> 6] * 64 + (kk & 63); });
        __syncthreads();
        softmax4(ssc, KSEL_S * 64);
        __syncthreads();
        pv(sacc, ssc, KSEL_S * 64, [=](int kk) { return selptr(kk, 1); });
        __syncthreads();
        if (tid < 4 * HD) { const int h = tid / HD, d = tid % HD; float a = 0.f;
#pragma unroll
            for (int w = 0; w < PVS; ++w) a += sacc[(w * 4 + h) * HD + d];
            so[tid] += sgate[h * 3 + 1] * a; }
        auto winptr = [=](int kk, int x) -> const float* { const int wpos = tpos - (WINDOW - 1) + kk;
            if (wpos < PAST) return p.state_win + ((size_t)bs * WINBUF + (wpos - (PAST - WINBUF))) * KV2 + x * KVW + g * HD;
            return S.winnew(bs, wpos - PAST, x, g); };
        scores(ssc, sq, sslope, WINDOW, tpos, [=](int kk) { return winptr(kk, 0); }, [=](int kk) { return tpos - (WINDOW - 1) + kk; });
        __syncthreads();
        softmax4(ssc, WINDOW);
        __syncthreads();
        pv(sacc, ssc, WINDOW, [=](int kk) { return winptr(kk, 1); });
        __syncthreads();
        if (tid < 4 * HD) { const int h = tid / HD, d = tid % HD; float a = 0.f;
#pragma unroll
            for (int w = 0; w < PVS; ++w) a += sacc[(w * 4 + h) * HD + d];
            p.On()[(size_t)m * NSAW + g * 4 * HD + tid] = so[tid] + sgate[h * 3 + 2] * a; }
    }
}
#endif
#ifndef CPU_SHIM
__device__ __forceinline__ float wave_sum64(float v) {
#pragma unroll
    for (int o = 1; o < 64; o <<= 1) v += __shfl_xor(v, o);
    return v;
}
constexpr int RV = D / 256;
__device__ __forceinline__ void store_bf4(bf16_t* dst, v4f v) { *(unsigned long long*)dst = (unsigned long long)pk2bf(v[0], v[1]) | ((unsigned long long)pk2bf(v[2], v[3]) << 32); }
constexpr int NRW = 3;
DEVFN void st_prep_rows_fast(const Params& p) {
    const int lane = tid_now() & 63, wave = tid_now() >> 6, stride = (int)gridDim.x * 8;
    for (int m0 = blockIdx.x * 8 + wave; m0 < MPAD; m0 += NRW * stride) {
        v4f xv[NRW][RV], plv[NRW];
#pragma unroll
        for (int k = 0; k < NRW; ++k) { const int m = m0 + k * stride, ml = m < M ? m : 0;
            const float* x = x_row(p, ml) + 4 * lane;
#pragma unroll
            for (int j = 0; j < RV; ++j) xv[k][j] = *(const v4f*)(x + 256 * j);
            plv[k] = *(const v4f*)((ml < MPR ? p.p_prompt + (size_t)ml * PLE : p.p_sample + (size_t)(ml - MPR) * PLE) + 4 * lane); }
#pragma unroll
        for (int k = 0; k < NRW; ++k) { const int m = m0 + k * stride; if (m >= MPAD) continue;
            bf16_t* h = p.H1() + (size_t)m * D + 4 * lane; bf16_t* pb = p.Pbf() + (size_t)m * PLE + 4 * lane;
            if (m >= M) {
#pragma unroll
                for (int j = 0; j < RV; ++j) *(unsigned long long*)(h + 256 * j) = 0ull;
                *(unsigned long long*)pb = 0ull; continue; }
            float ss = 0.f;
#pragma unroll
            for (int j = 0; j < RV; ++j) ss += xv[k][j][0] * xv[k][j][0] + xv[k][j][1] * xv[k][j][1] + xv[k][j][2] * xv[k][j][2] + xv[k][j][3] * xv[k][j][3];
            const float r = 1.0f / sqrtf(wave_sum64(ss) * (1.0f / D) + RMS_EPS);
#pragma unroll
            for (int j = 0; j < RV; ++j) { const v4f g = *(const v4f*)(p.g_pre1 + 4 * lane + 256 * j); store_bf4(h + 256 * j, xv[k][j] * r * g); }
            store_bf4(pb, plv[k]); }
    }
}
DEVFN void st_norm1_fast(const Params& p) {
    const int lane = tid_now() & 63, wave = tid_now() >> 6, stride = (int)gridDim.x * 8;
    for (int m0 = blockIdx.x * 8 + wave; m0 < MPAD; m0 += NRW * stride) {
        unsigned long long tq[NRW][RV]; v4f xv[NRW][RV];
#pragma unroll
        for (int k = 0; k < NRW; ++k) { const int m = m0 + k * stride, ml = m < M ? m : 0;
            const bf16_t* t1 = p.T1b() + (size_t)ml * D + 4 * lane; const float* x = x_row(p, ml) + 4 * lane;
#pragma unroll
            for (int j = 0; j < RV; ++j) { tq[k][j] = *(const unsigned long long*)(t1 + 256 * j); xv[k][j] = *(const v4f*)(x + 256 * j); } }
#pragma unroll
        for (int k = 0; k < NRW; ++k) { const int m = m0 + k * stride; if (m >= MPAD) continue;
            bf16_t* h2 = p.H2() + (size_t)m * D + 4 * lane;
            if (m >= M) {
#pragma unroll
                for (int j = 0; j < RV; ++j) *(unsigned long long*)(h2 + 256 * j) = 0ull;
                continue; }
            bf16_t* x1 = p.X1h() + (size_t)m * D + 4 * lane; float ss = 0.f;
#pragma unroll
            for (int j = 0; j < RV; ++j) { const v4f t = bf4_unpack(tq[k][j]); ss += t[0] * t[0] + t[1] * t[1] + t[2] * t[2] + t[3] * t[3]; }
            const float r1 = 1.0f / sqrtf(wave_sum64(ss) * (1.0f / D) + RMS_EPS); ss = 0.f;
#pragma unroll
            for (int j = 0; j < RV; ++j) { const v4f g = *(const v4f*)(p.g_post1 + 4 * lane + 256 * j); const v4f y = xv[k][j] + bf4_unpack(tq[k][j]) * r1 * g; xv[k][j] = y; store_bf4(x1 + 256 * j, y);
                ss += y[0] * y[0] + y[1] * y[1] + y[2] * y[2] + y[3] * y[3]; }
            const float r2 = 1.0f / sqrtf(wave_sum64(ss) * (1.0f / D) + RMS_EPS);
#pragma unroll
            for (int j = 0; j < RV; ++j) { const v4f g = *(const v4f*)(p.g_pre2 + 4 * lane + 256 * j); store_bf4(h2 + 256 * j, xv[k][j] * r2 * g); } }
    }
}
DEVFN void st_norm2_fast(const Params& p) {
    const int lane = tid_now() & 63, wave = tid_now() >> 6, stride = (int)gridDim.x * 8;
    for (int m0 = blockIdx.x * 8 + wave; m0 < MPAD; m0 += NRW * stride) {
        unsigned long long tq[NRW][RV], xq[NRW][RV];
#pragma unroll
        for (int k = 0; k < NRW; ++k) { const int m = m0 + k * stride, ml = m < M ? m : 0;
            const bf16_t* t2 = p.T2b() + (size_t)ml * D + 4 * lane; const bf16_t* x1 = p.X1h() + (size_t)ml * D + 4 * lane;
#pragma unroll
            for (int j = 0; j < RV; ++j) { tq[k][j] = *(const unsigned long long*)(t2 + 256 * j); xq[k][j] = *(const unsigned long long*)(x1 + 256 * j); } }
#pragma unroll
        for (int k = 0; k < NRW; ++k) { const int m = m0 + k * stride; if (m >= MPAD) continue;
            bf16_t* xb = p.X2b() + (size_t)m * D + 4 * lane;
            if (m >= M) {
#pragma unroll
                for (int j = 0; j < RV; ++j) *(unsigned long long*)(xb + 256 * j) = 0ull;
                continue; }
            float ss = 0.f;
#pragma unroll
            for (int j = 0; j < RV; ++j) { const v4f t = bf4_unpack(tq[k][j]); ss += t[0] * t[0] + t[1] * t[1] + t[2] * t[2] + t[3] * t[3]; }
            const float r = 1.0f / sqrtf(wave_sum64(ss) * (1.0f / D) + RMS_EPS);
#pragma unroll
            for (int j = 0; j < RV; ++j) { const v4f g = *(const v4f*)(p.g_post2 + 4 * lane + 256 * j); store_bf4(xb + 256 * j, bf4_unpack(xq[k][j]) + bf4_unpack(tq[k][j]) * r * g); } }
    }
}
#endif
#ifndef CPU_SHIM
namespace gd {
using na::bf16x8; using na::f32x16; using na::s16x4;
constexpr int TILE = 64 * HD * 2;
constexpr int G1_KT = 0, G1_QT = G1_KT + TILE, G1_KB = G1_QT + TILE, G1_VB = G1_KB + TILE, G1_LM = G1_VB + TILE, G1_TF = G1_LM + 64 * 68 * 4, G1_TB = G1_TF + 64 * 68 * 4,
              G1_RF = G1_TB + 64 * 144, G1_SM = G1_RF + 16 * 64 * 4, G1_CW = G1_SM + 4 * 64 * 4, G1_END = G1_CW + 3 * 4 * 128 * 4;
__device__ __forceinline__ bf16_t bf1(float f) { return (bf16_t)(pk2bf(f, 0.f) & 0xffffu); }
typedef _Float16 h16x8 __attribute__((ext_vector_type(8)));
__device__ __forceinline__ bf16_t h1(float f) { const _Float16 h = (_Float16)f; return __builtin_bit_cast(unsigned short, h); }
__device__ __forceinline__ unsigned pk2h(float lo, float hi) { return (unsigned)h1(lo) | ((unsigned)h1(hi) << 16); }
template <int D0> __device__ __forceinline__ void pvh_one(f32x16& od, int vb, bf16x8 pa0, bf16x8 pa1, bf16x8 pa2, bf16x8 pa3) {
    const s16x4 l0 = na::tr_read<na::v_rd_off(D0, 0, 0)>(vb), h0 = na::tr_read<na::v_rd_off(D0, 0, 1)>(vb), l1 = na::tr_read<na::v_rd_off(D0, 1, 0)>(vb), h1_ = na::tr_read<na::v_rd_off(D0, 1, 1)>(vb);
    const s16x4 l2 = na::tr_read<na::v_rd_off(D0, 2, 0)>(vb), h2 = na::tr_read<na::v_rd_off(D0, 2, 1)>(vb), l3 = na::tr_read<na::v_rd_off(D0, 3, 0)>(vb), h3 = na::tr_read<na::v_rd_off(D0, 3, 1)>(vb);
    asm volatile("s_waitcnt lgkmcnt(0)" ::: "memory"); __builtin_amdgcn_sched_barrier(0);
#define GD_PK(L, H) __builtin_bit_cast(h16x8, (bf16x8){L[0], L[1], L[2], L[3], H[0], H[1], H[2], H[3]})
    od = __builtin_amdgcn_mfma_f32_32x32x16_f16(__builtin_bit_cast(h16x8, pa0), GD_PK(l0, h0), od, 0, 0, 0);
    od = __builtin_amdgcn_mfma_f32_32x32x16_f16(__builtin_bit_cast(h16x8, pa1), GD_PK(l1, h1_), od, 0, 0, 0);
    od = __builtin_amdgcn_mfma_f32_32x32x16_f16(__builtin_bit_cast(h16x8, pa2), GD_PK(l2, h2), od, 0, 0, 0);
    od = __builtin_amdgcn_mfma_f32_32x32x16_f16(__builtin_bit_cast(h16x8, pa3), GD_PK(l3, h3), od, 0, 0, 0);
#undef GD_PK
}
__device__ __forceinline__ void pvh_blk(f32x16& od, int db, int vb, bf16x8 a0, bf16x8 a1, bf16x8 a2, bf16x8 a3) {
    if (db == 0) pvh_one<0>(od, vb, a0, a1, a2, a3); else if (db == 1) pvh_one<1>(od, vb, a0, a1, a2, a3);
    else if (db == 2) pvh_one<2>(od, vb, a0, a1, a2, a3); else pvh_one<3>(od, vb, a0, a1, a2, a3);
}
template <int NDB> struct PvSel;
__device__ __forceinline__ void pv_blk(f32x16& od, int db, int vb, bf16x8 a0, bf16x8 a1, bf16x8 a2, bf16x8 a3) {
    if (db == 0) na::pv_one<0>(od, vb, a0, a1, a2, a3); else if (db == 1) na::pv_one<1>(od, vb, a0, a1, a2, a3);
    else if (db == 2) na::pv_one<2>(od, vb, a0, a1, a2, a3); else na::pv_one<3>(od, vb, a0, a1, a2, a3);
}
}
DEVFN void st_gdn_g1_mfma(const Params& p, char* lds) {
    using namespace gd;
    float* Lm = (float*)(lds + G1_LM); float* Tf = (float*)(lds + G1_TF); bf16_t* Tb = (bf16_t*)(lds + G1_TB); float* Rf = (float*)(lds + G1_RF);
    float* gcs = (float*)(lds + G1_SM); float* bet = gcs + 64;
    float* cw = (float*)(lds + G1_CW);
    constexpr int UPW = 8;
    static_assert(NCHK % UPW == 0, "chunks per sequence");
    for (int blk = blockIdx.x; blk < BATCH * GH * NCHK / UPW; blk += gridDim.x) {
      { const int tid = tid_now(), h = (blk * UPW / NCHK) % GH;
        __syncthreads();
        if (tid < 384) { const int idx = tid * 4, part = idx / 512, j = (idx / 128) % 4, d = idx % 128; *(v4f*)(cw + idx) = *(const v4f*)(p.conv_w + (size_t)j * 3 * GW + part * GW + h * HD + d); }
        __syncthreads(); }
      v4u zr[3][4][2];
#define G1_LOADZ(cc) do { const int r_ = tid_now() >> 3, sg_ = tid_now() & 7, t_ = (cc) * GC + r_, h_ = (blk * UPW / NCHK) % GH, b_ = blk * UPW / (NCHK * GH); \
        _Pragma("unroll") for (int part = 0; part < 3; ++part) _Pragma("unroll") for (int j = 0; j < 4; ++j) { const int tt = t_ + j - 3; \
            if (tt >= 0) { const bf16_t* z = p.QKVb() + (size_t)(b_ * SEQ + tt) * (3 * GW) + part * GW + h_ * HD + sg_ * 16; zr[part][j][0] = *(const v4u*)z; zr[part][j][1] = *(const v4u*)(z + 8); } \
            else { zr[part][j][0] = (v4u){0u, 0u, 0u, 0u}; zr[part][j][1] = zr[part][j][0]; } } } while (0)
      G1_LOADZ((blk * UPW) % NCHK);
      for (int k8 = 0; k8 < UPW; ++k8) {
        const int u = blk * UPW + k8;
        const int tid = tid_now(), wave = tid >> 6, lane = tid & 63, r32 = lane & 31, hi = lane >> 5;
        const int c = u % NCHK, h = (u / NCHK) % GH, b = u / (NCHK * GH); const int m0 = b * SEQ + c * GC; const size_t cu = (size_t)u;
        const int r = tid >> 3, sg = tid & 7, t = c * GC + r;
        for (int rep1 = 0; rep1 < 1; ++rep1) {
        float gcl, btl;
        { const float* z = p.SMf() + (size_t)(m0 + lane) * ip::SMW; gcl = z[h]; btl = z[GH + h];
#pragma unroll
          for (int s2 = 1; s2 < 64; s2 <<= 1) { const float o = __shfl_up(gcl, s2); if (lane >= s2) gcl += o; }
          if (wave == 0) { gcs[lane] = gcl; bet[lane] = btl; } }
        float xq[16], xk[16], xv[16];
        {
            float ssq = 0.f, ssk = 0.f;
#pragma unroll
            for (int part = 0; part < 3; ++part) {
                const int ch0 = part * GW + h * HD + sg * 16;
                float a[16];
#pragma unroll
                for (int e = 0; e < 16; ++e) a[e] = 0.f;
#pragma unroll
                for (int j = 0; j < 4; ++j) {
                    { const float* w = cw + (part * 4 + j) * 128 + sg * 16;
#pragma unroll
                        for (int e8 = 0; e8 < 2; ++e8) { const v4u zv = zr[part][j][e8]; const v4f w0 = *(const v4f*)(w + 8 * e8), w1 = *(const v4f*)(w + 8 * e8 + 4);
                            a[8 * e8 + 0] += __uint_as_float(zv.x << 16) * w0[0]; a[8 * e8 + 1] += __uint_as_float(zv.x & 0xffff0000u) * w0[1];
                            a[8 * e8 + 2] += __uint_as_float(zv.y << 16) * w0[2]; a[8 * e8 + 3] += __uint_as_float(zv.y & 0xffff0000u) * w0[3];
                            a[8 * e8 + 4] += __uint_as_float(zv.z << 16) * w1[0]; a[8 * e8 + 5] += __uint_as_float(zv.z & 0xffff0000u) * w1[1];
                            a[8 * e8 + 6] += __uint_as_float(zv.w << 16) * w1[2]; a[8 * e8 + 7] += __uint_as_float(zv.w & 0xffff0000u) * w1[3]; } } }
#pragma unroll
                for (int e = 0; e < 16; ++e) { const float v = a[e] / (1.0f + __expf(-a[e])); if (part == 0) { xq[e] = v; ssq += v * v; } else if (part == 1) { xk[e] = v; ssk += v * v; } else xv[e] = v; }
            }
            ssq += __shfl_xor(ssq, 1); ssq += __shfl_xor(ssq, 2); ssq += __shfl_xor(ssq, 4);
            ssk += __shfl_xor(ssk, 1); ssk += __shfl_xor(ssk, 2); ssk += __shfl_xor(ssk, 4);
            const float rq = QSCALE / sqrtf(ssq + RMS_EPS), rk = 1.0f / sqrtf(ssk + RMS_EPS);
#pragma unroll
            for (int e = 0; e < 16; ++e) { xq[e] *= rq; xk[e] *= rk; }
#pragma unroll
            for (int hf = 0; hf < 2; ++hf) { v4u wq, wk;
                wq.x = pk2bf(xq[8 * hf + 0], xq[8 * hf + 1]); wq.y = pk2bf(xq[8 * hf + 2], xq[8 * hf + 3]); wq.z = pk2bf(xq[8 * hf + 4], xq[8 * hf + 5]); wq.w = pk2bf(xq[8 * hf + 6], xq[8 * hf + 7]);
                wk.x = pk2bf(xk[8 * hf + 0], xk[8 * hf + 1]); wk.y = pk2bf(xk[8 * hf + 2], xk[8 * hf + 3]); wk.z = pk2bf(xk[8 * hf + 4], xk[8 * hf + 5]); wk.w = pk2bf(xk[8 * hf + 6], xk[8 * hf + 7]);
                const int off = NA_KSWZ(r, (sg * 16 + hf * 8) * 2);
                *(v4u*)(lds + G1_QT + off) = wq; *(v4u*)(lds + G1_KT + off) = wk; }
        }
        {
            const float gr = __shfl(gcl, r), br = __shfl(btl, r), glast = __shfl(gcl, 63), fk = br * __expf(gr), eq = __expf(gr), ekd = __expf(glast - gr);
#pragma unroll
            for (int hf = 0; hf < 2; ++hf) { v4u wkb, wvb, wqg;
                wkb.x = pk2bf(xk[8 * hf + 0] * fk, xk[8 * hf + 1] * fk); wkb.y = pk2bf(xk[8 * hf + 2] * fk, xk[8 * hf + 3] * fk); wkb.z = pk2bf(xk[8 * hf + 4] * fk, xk[8 * hf + 5] * fk); wkb.w = pk2bf(xk[8 * hf + 6] * fk, xk[8 * hf + 7] * fk);
                wvb.x = pk2bf(xv[8 * hf + 0] * br, xv[8 * hf + 1] * br); wvb.y = pk2bf(xv[8 * hf + 2] * br, xv[8 * hf + 3] * br); wvb.z = pk2bf(xv[8 * hf + 4] * br, xv[8 * hf + 5] * br); wvb.w = pk2bf(xv[8 * hf + 6] * br, xv[8 * hf + 7] * br);
                wqg.x = pk2h(xq[8 * hf + 0] * eq, xq[8 * hf + 1] * eq); wqg.y = pk2h(xq[8 * hf + 2] * eq, xq[8 * hf + 3] * eq); wqg.z = pk2h(xq[8 * hf + 4] * eq, xq[8 * hf + 5] * eq); wqg.w = pk2h(xq[8 * hf + 6] * eq, xq[8 * hf + 7] * eq);
                const int voff = na::v_st(r, sg * 16 + hf * 8);
                *(v4u*)(lds + G1_KB + voff) = wkb; *(v4u*)(lds + G1_VB + voff) = wvb;
                *(v4u*)(p.GQG() + cu * GC * HD + ((size_t)(((r >> 5) * 8 + sg) * 64 + (r & 31) + 32 * hf)) * 8) = wqg; }
#pragma unroll
            for (int e = 0; e < 16; ++e) { const int dd = sg * 16 + e; p.GKD()[cu * GC * HD + ((size_t)(((dd >> 5) * 4 + (r >> 4)) * 64 + (dd & 31) + 32 * ((r >> 3) & 1))) * 8 + (r & 7)] = h1(xk[e] * ekd); }
            if (tid == 0) p.GEL()[cu] = __expf(glast);
        }
        }
        if (k8 + 1 < UPW) G1_LOADZ(c + 1);
        __syncthreads();
        for (int rep4 = 0; rep4 < (DUP_PHASE == 224 ? 2 : 1); ++rep4) {
            const int prod = wave >> 2, half = (wave >> 1) & 1, kh = wave & 1, i = 32 * half + r32;
            f32x16 p0;
#pragma unroll
            for (int q = 0; q < 16; ++q) p0[q] = 0.f;
#pragma unroll
            for (int d0 = 0; d0 < 8; ++d0) { const int cb = (d0 * 16 + hi * 8) * 2;
                const bf16x8 qf = *reinterpret_cast<const bf16x8*>(lds + (prod ? G1_QT : G1_KT) + NA_KSWZ(i, cb));
                const bf16x8 b0 = *reinterpret_cast<const bf16x8*>(lds + G1_KT + NA_KSWZ(32 * kh + r32, cb));
                p0 = __builtin_amdgcn_mfma_f32_32x32x16_bf16(b0, qf, p0, 0, 0, 0); }
            const float gi = gcs[i], bi = bet[i];
            if (prod == 0) {
#pragma unroll
                for (int q = 0; q < 16; ++q) { const int j0 = 32 * kh + na::crow(q, hi);
                    Lm[i * 68 + j0] = j0 < i ? p0[q] * __expf(gi - gcs[j0]) * bi : 0.f; }
            } else {
#pragma unroll
                for (int q4 = 0; q4 < 4; ++q4) {
                    float v0[4];
#pragma unroll
                    for (int e = 0; e < 4; ++e) { const int j0 = 32 * kh + 8 * q4 + 4 * hi + e; v0[e] = j0 <= i ? p0[4 * q4 + e] * __expf(gi - gcs[j0]) : 0.f; }
                    const int j0c = 32 * kh + 8 * q4 + 4 * hi; bf16_t* dst = p.GQK() + cu * GC * GC + ((size_t)(((i >> 5) * 4 + (j0c >> 4)) * 64 + (i & 31) + 32 * ((j0c >> 3) & 1))) * 8 + (j0c & 7);
                    *(unsigned long long*)dst = (unsigned long long)pk2h(v0[0], v0[1]) | ((unsigned long long)pk2h(v0[2], v0[3]) << 32); }
            }
        }
        __syncthreads();
        for (int rep5 = 0; rep5 < (DUP_PHASE == 225 ? 2 : 1); ++rep5) {
        if (wave == 0) {
            { const int a = lane >> 4, cc = lane & 15; f32x16 x;
#pragma unroll
              for (int i = 0; i < 16; ++i) { float s = (i == cc) ? 1.0f : 0.f;
#pragma unroll
                  for (int j = 0; j < i; ++j) s -= Lm[(16 * a + i) * 68 + 16 * a + j] * x[j];
                  x[i] = s; }
#pragma unroll
              for (int i = 0; i < 16; ++i) Tf[(16 * a + i) * 68 + 16 * a + cc] = x[i]; }
            asm volatile("s_waitcnt lgkmcnt(0)" ::: "memory");
            typedef _Float16 h16x4 __attribute__((ext_vector_type(4)));
            const int rw = lane & 15, kq = lane >> 4;
#define G1_LDA(base, rb, cb) ({ const v4f x_ = *(const v4f*)((base) + (16 * (rb) + rw) * 68 + 16 * (cb) + 4 * kq); (h16x4){(_Float16)x_[0], (_Float16)x_[1], (_Float16)x_[2], (_Float16)x_[3]}; })
#define G1_LDB(blk) ((h16x4){(_Float16)Tf[(16 * (blk) + 4 * kq + 0) * 68 + 16 * (blk) + rw], (_Float16)Tf[(16 * (blk) + 4 * kq + 1) * 68 + 16 * (blk) + rw], \
                             (_Float16)Tf[(16 * (blk) + 4 * kq + 2) * 68 + 16 * (blk) + rw], (_Float16)Tf[(16 * (blk) + 4 * kq + 3) * 68 + 16 * (blk) + rw]})
#define G1_MM(A_, B_, C_) __builtin_amdgcn_mfma_f32_16x16x16f16(A_, B_, C_, 0, 0, 0)
#define G1_NEGH(c_) ((h16x4){(_Float16)(-(c_)[0]), (_Float16)(-(c_)[1]), (_Float16)(-(c_)[2]), (_Float16)(-(c_)[3])})
#define G1_POSH(c_) ((h16x4){(_Float16)((c_)[0]), (_Float16)((c_)[1]), (_Float16)((c_)[2]), (_Float16)((c_)[3])})
#define G1_PUT(t_, rb, cb) do { _Pragma("unroll") for (int e_ = 0; e_ < 4; ++e_) Tb[(16 * (rb) + 4 * kq + e_) * 72 + 16 * (cb) + rw] = bf1((float)(t_)[e_]); } while (0)
            const v4f z4 = (v4f){0.f, 0.f, 0.f, 0.f};
            const h16x4 d0 = G1_LDB(0), d1 = G1_LDB(1), d2 = G1_LDB(2);
            const h16x4 D1 = G1_LDA(Tf, 1, 1), D2 = G1_LDA(Tf, 2, 2), D3 = G1_LDA(Tf, 3, 3);
            const h16x4 L10 = G1_LDA(Lm, 1, 0), L20 = G1_LDA(Lm, 2, 0), L21 = G1_LDA(Lm, 2, 1), L30 = G1_LDA(Lm, 3, 0), L31 = G1_LDA(Lm, 3, 1), L32 = G1_LDA(Lm, 3, 2);
            v4f r; h16x4 t10, t20, t21, t30, t31, t32;
            r = G1_MM(L10, d0, z4); r = G1_MM(D1, G1_POSH(r), z4); t10 = G1_NEGH(r);
            r = G1_MM(L20, d0, z4); r = G1_MM(L21, t10, r); r = G1_MM(D2, G1_POSH(r), z4); t20 = G1_NEGH(r);
            r = G1_MM(L21, d1, z4); r = G1_MM(D2, G1_POSH(r), z4); t21 = G1_NEGH(r);
            r = G1_MM(L30, d0, z4); r = G1_MM(L31, t10, r); r = G1_MM(L32, t20, r); r = G1_MM(D3, G1_POSH(r), z4); t30 = G1_NEGH(r);
            r = G1_MM(L31, d1, z4); r = G1_MM(L32, t21, r); r = G1_MM(D3, G1_POSH(r), z4); t31 = G1_NEGH(r);
            r = G1_MM(L32, d2, z4); r = G1_MM(D3, G1_POSH(r), z4); t32 = G1_NEGH(r);
            G1_PUT(t10, 1, 0); G1_PUT(t20, 2, 0); G1_PUT(t21, 2, 1); G1_PUT(t30, 3, 0); G1_PUT(t31, 3, 1); G1_PUT(t32, 3, 2);
#undef G1_LDA
#undef G1_LDB
#undef G1_MM
#undef G1_NEGH
#undef G1_POSH
#undef G1_PUT
        }
        __syncthreads();
        for (int idx = tid; idx < 64 * 64; idx += 512) { const int j = idx & 63, i = idx >> 6;
            if ((j >> 4) >= (i >> 4)) Tb[i * 72 + j] = bf1((j >> 4) == (i >> 4) ? Tf[i * 68 + j] : 0.f); }
        __syncthreads();
        }
        for (int rep6 = 0; rep6 < (DUP_PHASE == 226 ? 2 : 1); ++rep6) {
            const int db = wave & 3, rhf = wave >> 2, row = 32 * rhf + r32;
            bf16x8 pa[4];
#pragma unroll
            for (int ks = 0; ks < 4; ++ks) pa[ks] = *reinterpret_cast<const bf16x8*>((const char*)Tb + row * 144 + (16 * ks + 8 * hi) * 2);
            f32x16 ow, ou;
#pragma unroll
            for (int q = 0; q < 16; ++q) { ow[q] = 0.f; ou[q] = 0.f; }
            const int vbase = (int)(uintptr_t)lds + na::v_rd_base(lane);
            pv_blk(ow, db, vbase + G1_KB, pa[0], pa[1], pa[2], pa[3]);
            pv_blk(ou, db, vbase + G1_VB, pa[0], pa[1], pa[2], pa[3]);
#pragma unroll
            for (int q = 0; q < 16; ++q) { const int rr = 32 * rhf + na::crow(q, hi), cc = 32 * db + r32; const size_t o = (cu * GC + rr) * HD + cc;
                p.GNW()[cu * GC * HD + ((size_t)(((rr >> 5) * 8 + (cc >> 4)) * 64 + (rr & 31) + 32 * ((cc >> 3) & 1))) * 8 + (cc & 7)] = h1(-ow[q]); p.GU()[o] = ou[q]; }
        }
        __syncthreads();
      }
    }
}
#endif
#ifndef CPU_SHIM
namespace gd {
__device__ __forceinline__ int v_st_e(int k, int c) { const int kk = (k & ~0xC) | ((k & 4) << 1) | ((k & 8) >> 1); return ((kk >> 3) * 4 + (c >> 5)) * 512 + ((kk & 7) * 32 + (c & 31)) * 2; }
constexpr int G2_S = 0, G2_VN = 4 * TILE, G2_END = 5 * TILE;
}
DEVFN void gdn_g2_unit(const Params& p, char* lds, int b, int h, int dvh) {
    using namespace gd;
    const int tid = tid_now(), wave = tid >> 6, lane = tid & 63, r32 = lane & 31, hi = lane >> 5, db = 2 * dvh + (wave & 1), rhf = (wave >> 1) & 1, col = 32 * db + r32;
    const bool act = wave < 4;
    const int vbase = (int)(uintptr_t)lds + na::v_rd_base(lane);
    f32x16 S0, S1;
#pragma unroll
    for (int q = 0; q < 16; ++q) { S0[q] = 0.f; S1[q] = 0.f; }
    __syncthreads();
    for (int i = tid; i < 2 * TILE / 16; i += 512) *(v4u*)(lds + G2_S + i * 16) = (v4u){0u, 0u, 0u, 0u};
    int cur = 0;
    const size_t cu0 = (size_t)(b * GH + h) * NCHK;
    bf16x8 nw[8]; f32x16 vn;
#define G2_LOAD_A(dst, base, pitch, n) do { _Pragma("unroll") for (int ks = 0; ks < (n); ++ks) dst[ks] = *reinterpret_cast<const bf16x8*>((base) + (size_t)(ks * 64 + lane) * 8); } while (0)
    if (act) { const bf16_t* src = p.GNW() + cu0 * GC * HD + (size_t)rhf * 8 * 512; G2_LOAD_A(nw, src, HD, 8);
#pragma unroll
      for (int q = 0; q < 16; ++q) vn[q] = p.GU()[(cu0 * GC + 32 * rhf + na::crow(q, hi)) * HD + col]; }
    __syncthreads();
    for (int c = 0; c < NCHK; ++c) {
        const size_t cu = cu0 + c;
        bf16x8 qg[8], qk[4], kd0[4], kd1[4]; float egl = 0.f;
        if (act) {
            { const bf16_t* s1 = p.GQG() + cu * GC * HD + (size_t)rhf * 8 * 512; G2_LOAD_A(qg, s1, HD, 8);
              const bf16_t* s2 = p.GQK() + cu * GC * GC + (size_t)rhf * 4 * 512; G2_LOAD_A(qk, s2, GC, 4);
              const bf16_t* s3 = p.GKD() + cu * GC * HD + (size_t)rhf * 4 * 512; G2_LOAD_A(kd0, s3, GC, 4);
              const bf16_t* s4 = p.GKD() + cu * GC * HD + (size_t)(2 + rhf) * 4 * 512; G2_LOAD_A(kd1, s4, GC, 4); }
            egl = p.GEL()[cu];
            gd::pvh_blk(vn, db, vbase + G2_S + (cur * 2 + 0) * TILE, nw[0], nw[1], nw[2], nw[3]);
            gd::pvh_blk(vn, db, vbase + G2_S + (cur * 2 + 1) * TILE, nw[4], nw[5], nw[6], nw[7]);
#pragma unroll
            for (int q = 0; q < 16; ++q) *(bf16_t*)(lds + G2_VN + v_st_e(32 * rhf + na::crow(q, hi), col)) = h1(vn[q]);
        }
        __syncthreads();
        if (act) {
            if (c + 1 < NCHK) { const bf16_t* src = p.GNW() + (cu + 1) * GC * HD + (size_t)rhf * 8 * 512; G2_LOAD_A(nw, src, HD, 8);
#pragma unroll
                for (int q = 0; q < 16; ++q) vn[q] = p.GU()[((cu + 1) * GC + 32 * rhf + na::crow(q, hi)) * HD + col]; }
            f32x16 o;
#pragma unroll
            for (int q = 0; q < 16; ++q) o[q] = 0.f;
            gd::pvh_blk(o, db, vbase + G2_S + (cur * 2 + 0) * TILE, qg[0], qg[1], qg[2], qg[3]);
            gd::pvh_blk(o, db, vbase + G2_S + (cur * 2 + 1) * TILE, qg[4], qg[5], qg[6], qg[7]);
            gd::pvh_blk(o, db, vbase + G2_VN, qk[0], qk[1], qk[2], qk[3]);
#pragma unroll
            for (int q = 0; q < 16; ++q) __builtin_nontemporal_store(f2bf(o[q]), p.OAh() + (size_t)(b * SEQ + c * GC + 32 * rhf + na::crow(q, hi)) * GW + h * HD + col);
#pragma unroll
            for (int q = 0; q < 16; ++q) { S0[q] *= egl; S1[q] *= egl; }
            gd::pvh_blk(S0, db, vbase + G2_VN, kd0[0], kd0[1], kd0[2], kd0[3]);
            gd::pvh_blk(S1, db, vbase + G2_VN, kd1[0], kd1[1], kd1[2], kd1[3]);
#pragma unroll
            for (int q = 0; q < 16; ++q) { const int off = v_st_e(32 * rhf + na::crow(q, hi), col);
                *(bf16_t*)(lds + G2_S + ((cur ^ 1) * 2 + 0) * TILE + off) = h1(S0[q]); *(bf16_t*)(lds + G2_S + ((cur ^ 1) * 2 + 1) * TILE + off) = h1(S1[q]); }
        }
        __syncthreads();
        cur ^= 1;
    }
#undef G2_LOAD_A
    if (act) {
#pragma unroll
        for (int q = 0; q < 16; ++q) { const int k = 32 * rhf + na::crow(q, hi);
            p.out[O_GDNP + ((size_t)(b * GH + h) * HD + k) * HD + col] = S0[q]; p.out[O_GDNP + ((size_t)(b * GH + h) * HD + 64 + k) * HD + col] = S1[q]; } }
}
constexpr int QW_P3 = XCD_BAR_WORDS + 64;
#ifndef TIME_PHASE
#define TIME_PHASE -1
#endif
DEVFN void st_mixers(const Params& p, char* lds, volatile LAS unsigned* misc, int qw, int only = 0, unsigned long long tp0 = 0ull) {
    constexpr int NG2 = BATCH * GH * 2, NSM = MSA * NKV, NPA = BATCH * NKV * (SEQ / 64), NTOT = NG2 + NSM + NPA + TRN_ALL;
    for (;;) {
        if (tid_now() == 0) misc[4] = __hip_atomic_fetch_add(p.ctl() + qw, 1u, __ATOMIC_RELAXED, __HIP_MEMORY_SCOPE_AGENT);
        __syncthreads();
        const int u = (int)misc[4];
        __syncthreads();
        if (u >= NTOT) break;
        constexpr int NPL = (NPA * 2) / 5;
        constexpr int NCH = 16 * BATCH * NKV, ND = NPA - NCH - NPL;
        static_assert(TRN_ALL >= 2 * NCH && ND >= 0 && SEQ / 64 > 16, "queue map");
        int cls = 0, arg = 0;
        if (u < NG2) { cls = 0; arg = u; }
        else if (u < NG2 + NPL) { cls = 1; arg = u - NG2; }
        else if (u < NG2 + NPL + NSM) { cls = 2; arg = u - NG2 - NPL; }
        else if (u < NG2 + NPL + NSM + ND) { cls = 1; arg = NPL + (u - NG2 - NPL - NSM); }
        else { const int w = u - NG2 - NPL - NSM - ND;
            if (w < 3 * NCH) { if (w % 3 == 0) { cls = 1; arg = NPA - NCH + w / 3; } else { cls = 4; arg = w - w / 3 - 1; } }
            else { cls = 4; arg = w - NCH; } }
        if (cls == 0) { if (only == 0 || only == 2) gdn_g2_unit(p, lds, (arg >> 1) / GH, (arg >> 1) % GH, arg & 1); }
        else if (only == 2) continue;
        else if (cls == 2) { if (only != 4) st_nsa_sample_unit(p, (float*)lds, arg); }
        else if (cls == 4) { if (only == 0) tr_filler_unit(p, (float*)lds, arg); }
        else { if (only == 3) continue; const int v = arg, i = (SEQ / 64 - 1) - v / (BATCH * NKV), bg = v % (BATCH * NKV); na::nsa_unit(p, lds, bg / NKV, i, bg % NKV); }
        if (TIME_PHASE >= 300 && TIME_PHASE < 310 && tid_now() == 0) {
            __hip_atomic_fetch_max(p.ctl() + 32300 + cls, (unsigned)(wall_clock64() - tp0), __ATOMIC_RELAXED, __HIP_MEMORY_SCOPE_AGENT); }
    }
}
#endif
#ifndef CPU_SHIM
__device__ __forceinline__ float wave_sum64(float v);
DEVFN void st_post_fast(const Params& p) {
    { const int lane = tid_now() & 63, wave = tid_now() >> 6;
      for (int i = blockIdx.x * 8 + wave; i < MSA * 3 * GH; i += gridDim.x * 8) {
        const int h = i % GH, part = (i / GH) % 3, mm = i / (3 * GH), m = MPR + mm, bs = mm / DEC_SEQ, tq = mm % DEC_SEQ, c = part * GW + h * HD + 2 * lane;
        float a0 = 0.f, a1 = 0.f;
#pragma unroll
        for (int j = 0; j < 4; ++j) { const int tt = tq + j - 3; float x0, x1;
            if (tt >= 0) { const unsigned uu = *(const unsigned*)(p.QKVb() + (size_t)(MPR + bs * DEC_SEQ + tt) * (3 * GW) + c); x0 = __uint_as_float(uu << 16); x1 = __uint_as_float(uu & 0xffff0000u); }
            else { const float* sc = p.state_conv + (size_t)(bs * 3 + tt + 3) * (3 * GW) + c; x0 = sc[0]; x1 = sc[1]; }
            a0 += x0 * p.conv_w[(size_t)j * 3 * GW + c]; a1 += x1 * p.conv_w[(size_t)j * 3 * GW + c + 1]; }
        float v0 = a0 / (1.0f + __expf(-a0)), v1 = a1 / (1.0f + __expf(-a1));
        if (part < 2) { const float ss = wave_sum64(v0 * v0 + v1 * v1), r = (part == 0 ? QSCALE : 1.0f) / sqrtf(ss + RMS_EPS); v0 *= r; v1 *= r; }
        float* dst = p.QKVc() + (size_t)m * 3 * GW + c; dst[0] = v0; dst[1] = v1; } }
    GSL(i, (long)MSA * GH) { const int h = (int)(i % GH), m = MPR + (int)(i / GH);
        p.GB()[(size_t)m * 2 * GH + h] = p.SMf()[(size_t)m * ip::SMW + h]; p.GB()[(size_t)m * 2 * GH + GH + h] = p.SMf()[(size_t)m * ip::SMW + GH + h]; }
    GSL(i, (long)DEC_BATCH * (WINBUF - DEC_SEQ) * KV2) { const int c = (int)(i % KV2), j = (int)((i / KV2) % (WINBUF - DEC_SEQ)), bs = (int)(i / ((long)KV2 * (WINBUF - DEC_SEQ)));
        p.out[O_WINS + ((size_t)bs * WINBUF + j) * KV2 + c] = p.state_win[((size_t)bs * WINBUF + j + DEC_SEQ) * KV2 + c]; }
    GSL(i, (long)BATCH * NKV * NCP * HD) { const int d = (int)(i % HD), n = (int)((i / HD) % NCP), g = (int)((i / ((long)HD * NCP)) % NKV), b = (int)(i / ((long)HD * NCP * NKV));
        float ak = 0.f, av = 0.f; const float* z = p.out + O_CMPP + (size_t)(b * SEQ + 32 * n) * KV2 + g * HD + d;
#pragma unroll 8
        for (int cc = 0; cc < 32; ++cc) { ak += z[(size_t)cc * KV2] * p.w_cmp[cc * KV2 + g * HD + d]; av += z[(size_t)cc * KV2 + KVW] * p.w_cmp[cc * KV2 + KVW + g * HD + d]; }
        p.CMPK()[i] = f2bf(ak); p.CMPV()[i] = f2bf(av); }
}
#endif
#ifndef CPU_SHIM
template <int N, int K, class EpiS> __device__ __forceinline__ void gemm_small32_unit(char* lds, const bf16_t* A, const bf16_t* Bt, EpiS epi, int unit) {
    using na::bf16x8; using na::f32x16;
    float* red = (float*)lds;
    {
        const int tid = tid_now(), wave = tid >> 6, lane = tid & 63, r32 = lane & 31, hi = lane >> 5, n0 = 32 * unit;
        f32x16 acc;
#pragma unroll
        for (int q = 0; q < 16; ++q) acc[q] = 0.f;
        const bf16_t* ap = A + (size_t)r32 * K + 8 * hi; const bf16_t* bp = Bt + (size_t)(n0 + r32) * K + 8 * hi;
#pragma unroll 8
        for (int s8 = 0; s8 < K / 128; ++s8) { const int ks = wave * (K / 128) + s8;
            const bf16x8 a = *reinterpret_cast<const bf16x8*>(ap + 16 * ks), bb = *reinterpret_cast<const bf16x8*>(bp + 16 * ks);
            acc = __builtin_amdgcn_mfma_f32_32x32x16_bf16(a, bb, acc, 0, 0, 0); }
        __syncthreads();
#pragma unroll
        for (int q = 0; q < 16; ++q) red[(wave * 16 + q) * 64 + lane] = acc[q];
        __syncthreads();
#pragma unroll
        for (int rep = 0; rep < 2; ++rep) { const int e = tid + 512 * rep, q = e >> 6, ln = e & 63; float s = 0.f;
#pragma unroll
            for (int w = 0; w < 8; ++w) s += red[(w * 16 + q) * 64 + ln];
            epi(na::crow(q, ln >> 5), n0 + (ln & 31), s); }
    }
}
template <int N, int K, class EpiS> __device__ __forceinline__ void gemm_small32(char* lds, const bf16_t* A, const bf16_t* Bt, EpiS epi) {
    for (int unit = blockIdx.x; unit < N / 32; unit += gridDim.x) gemm_small32_unit<N, K>(lds, A, Bt, epi, unit);
}
struct EpiSF32 { float* C; int ldc; __device__ __forceinline__ void operator()(int row, int col, float v) const { C[(size_t)row * ldc + col] = v; } };
struct EpiSFinal { const bf16_t* X2; const bf16_t* PL; float* y; __device__ __forceinline__ void operator()(int row, int col, float v) const {
    const size_t o = (size_t)row * D + col; y[o] = bf2f(X2[o]) + bf2f(PL[o]) / (1.0f + __expf(-v)); } };
struct EpiSBf16 { bf16_t* C; int ldc; __device__ __forceinline__ void operator()(int row, int col, float v) const { C[(size_t)row * ldc + col] = f2bf(v); } };
#endif
#ifndef CPU_SHIM
namespace rx {
constexpr int NT = D / 256, NSETS = 4, RX_CNT0 = 4096;
static_assert(RX_CNT0 + NSETS * 64 * 64 <= (int)(CTL_BYTES / 4) && XCD_BAR_WORDS + 256 <= RX_CNT0, "control block map");
struct RowEx { float* slots; unsigned* cnt; unsigned* tmo; };
__device__ __forceinline__ void wait_count(unsigned* c, unsigned want, unsigned* tmo) {
    unsigned sp = 0;
    while ((unsigned)__builtin_amdgcn_readfirstlane(__hip_atomic_load(c, __ATOMIC_RELAXED, __HIP_MEMORY_SCOPE_AGENT)) < want) {
        __builtin_amdgcn_s_sleep(2);
        if ((++sp & 255u) == 0u) { if (__hip_atomic_load(tmo, __ATOMIC_RELAXED, __HIP_MEMORY_SCOPE_AGENT)) break; if (sp > (1u << 22)) { __hip_atomic_store(tmo, 1u, __ATOMIC_RELAXED, __HIP_MEMORY_SCOPE_AGENT); break; } } }
    __builtin_amdgcn_fence(__ATOMIC_ACQUIRE, "agent");
    asm volatile("s_waitcnt vmcnt(0)" ::: "memory");
}
__device__ __forceinline__ void tile(const RowEx& X, const pg8::f32x4 (&v)[2][2][4][2], int pm, int pn, int wr, int wc, int fr, int fq, float* P, float* S, int tid) {
#pragma unroll
    for (int ai = 0; ai < 2; ++ai)
#pragma unroll
        for (int m = 0; m < 4; ++m) { float s = 0.f;
#pragma unroll
            for (int bj = 0; bj < 2; ++bj)
#pragma unroll
                for (int n = 0; n < 2; ++n) { const pg8::f32x4 x = v[ai][bj][m][n]; s += (x[0] * x[0] + x[1] * x[1]) + (x[2] * x[2] + x[3] * x[3]); }
            s += __shfl_xor(s, 16); s += __shfl_xor(s, 32);
            if (fq == 0) P[(ai * 128 + wr * 64 + m * 16 + fr) * 4 + wc] = s; }
    asm volatile("s_waitcnt lgkmcnt(0)" ::: "memory"); __builtin_amdgcn_s_barrier(); asm volatile("" ::: "memory");
    if (tid < 256) { const float s = (P[tid * 4] + P[tid * 4 + 1]) + (P[tid * 4 + 2] + P[tid * 4 + 3]);
        __hip_atomic_store((unsigned*)X.slots + ((size_t)(pm * 64 + pn) * 256 + tid), __float_as_uint(s), __ATOMIC_RELAXED, __HIP_MEMORY_SCOPE_AGENT); }
    asm volatile("s_waitcnt vmcnt(0)" ::: "memory");
    if (tid < 256 && (tid & 63) == 0) __hip_atomic_fetch_add(X.cnt + 64 * pm, 1u, __ATOMIC_RELAXED, __HIP_MEMORY_SCOPE_AGENT);
    if (tid < 64) wait_count(X.cnt + 64 * pm, 4u * NT, X.tmo);
    asm volatile("s_waitcnt vmcnt(0) lgkmcnt(0)" ::: "memory"); __builtin_amdgcn_s_barrier(); asm volatile("" ::: "memory");
    if (tid < 256) { float tot = 0.f;
#pragma unroll
        for (int t = 0; t < NT; ++t) tot += __uint_as_float(__hip_atomic_load((unsigned*)X.slots + ((size_t)(pm * 64 + t) * 256 + tid), __ATOMIC_RELAXED, __HIP_MEMORY_SCOPE_AGENT));
        S[tid] = 1.0f / sqrtf(tot * (1.0f / D) + RMS_EPS); }
    asm volatile("s_waitcnt lgkmcnt(0)" ::: "memory"); __builtin_amdgcn_s_barrier(); asm volatile("" ::: "memory");
}
}
struct EpiWoNorm {
    static constexpr bool PERM = false, AFTER_DRAIN = true;
    const float* x; float* X1; bf16_t* H2; const float* g1; const float* g2; rx::RowEx e1, e2;
    __device__ __forceinline__ void fused(pg8::f32x4 (&acc)[2][2][4][2], const pg8::Unit& u, int wr, int wc, int fr, int fq, PG8_LAS unsigned char* ldsp, int wid, int lane) const {
        float* P = (float*)ldsp; float* S = P + 1024; const int tid = wid * 64 + lane, col0 = u.pn * 256 + wc * 32 + 4 * fq;
        rx::tile(e1, acc, u.pm, u.pn, wr, wc, fr, fq, P, S, tid);
#pragma unroll
        for (int ai = 0; ai < 2; ++ai)
#pragma unroll
            for (int m = 0; m < 4; ++m) { const int r = ai * 128 + wr * 64 + m * 16 + fr; const float rs = S[r]; const size_t off = (size_t)(u.pm * 256 + r) * D + col0;
#pragma unroll
                for (int bj = 0; bj < 2; ++bj)
#pragma unroll
                    for (int n = 0; n < 2; ++n) { const int c = bj * 128 + n * 16; const v4f xv = *(const v4f*)(x + off + c), g = *(const v4f*)(g1 + col0 + c);
                        pg8::f32x4 y; y[0] = xv[0] + acc[ai][bj][m][n][0] * rs * g[0]; y[1] = xv[1] + acc[ai][bj][m][n][1] * rs * g[1]; y[2] = xv[2] + acc[ai][bj][m][n][2] * rs * g[2]; y[3] = xv[3] + acc[ai][bj][m][n][3] * rs * g[3];
                        acc[ai][bj][m][n] = y; *(v4f*)(X1 + off + c) = (v4f){y[0], y[1], y[2], y[3]}; }
                asm volatile("" : "+v"(acc[ai][0][m][0]), "+v"(acc[ai][0][m][1]), "+v"(acc[ai][1][m][0]), "+v"(acc[ai][1][m][1]));
                asm volatile("" ::: "memory"); }
        rx::tile(e2, acc, u.pm, u.pn, wr, wc, fr, fq, P, S, tid);
#pragma unroll
        for (int ai = 0; ai < 2; ++ai)
#pragma unroll
            for (int m = 0; m < 4; ++m) { const int r = ai * 128 + wr * 64 + m * 16 + fr; const float rs = S[r]; const size_t off = (size_t)(u.pm * 256 + r) * D + col0;
#pragma unroll
                for (int bj = 0; bj < 2; ++bj)
#pragma unroll
                    for (int n = 0; n < 2; ++n) { const int c = bj * 128 + n * 16; const v4f g = *(const v4f*)(g2 + col0 + c); const pg8::f32x4 y = acc[ai][bj][m][n];
                        *(unsigned long long*)(H2 + off + c) = (unsigned long long)pk2bf(y[0] * rs * g[0], y[1] * rs * g[1]) | ((unsigned long long)pk2bf(y[2] * rs * g[2], y[3] * rs * g[3]) << 32); }
                asm volatile("" ::: "memory"); }
    }
};
struct EpiFfoNorm {
    static constexpr bool PERM = false, AFTER_DRAIN = true;
    const float* X1; float* X2; bf16_t* X2b; const float* g; rx::RowEx e1;
    __device__ __forceinline__ void fused(pg8::f32x4 (&acc)[2][2][4][2], const pg8::Unit& u, int wr, int wc, int fr, int fq, PG8_LAS unsigned char* ldsp, int wid, int lane) const {
        float* P = (float*)ldsp; float* S = P + 1024; const int tid = wid * 64 + lane, col0 = u.pn * 256 + wc * 32 + 4 * fq;
        rx::tile(e1, acc, u.pm, u.pn, wr, wc, fr, fq, P, S, tid);
#pragma unroll
        for (int ai = 0; ai < 2; ++ai)
#pragma unroll
            for (int m = 0; m < 4; ++m) { const int r = ai * 128 + wr * 64 + m * 16 + fr; const float rs = S[r]; const size_t off = (size_t)(u.pm * 256 + r) * D + col0;
#pragma unroll
                for (int bj = 0; bj < 2; ++bj)
#pragma unroll
                    for (int n = 0; n < 2; ++n) { const int c = bj * 128 + n * 16; const v4f xv = *(const v4f*)(X1 + off + c), gg = *(const v4f*)(g + col0 + c); const pg8::f32x4 a = acc[ai][bj][m][n];
                        const v4f y = (v4f){xv[0] + a[0] * rs * gg[0], xv[1] + a[1] * rs * gg[1], xv[2] + a[2] * rs * gg[2], xv[3] + a[3] * rs * gg[3]};
                        *(v4f*)(X2 + off + c) = y; *(unsigned long long*)(X2b + off + c) = (unsigned long long)pk2bf(y[0], y[1]) | ((unsigned long long)pk2bf(y[2], y[3]) << 32); }
                asm volatile("" ::: "memory"); }
    }
};
template <int K, int MODE> __device__ __forceinline__ void small32_norm(const Params& p, char* lds, const bf16_t* A, const bf16_t* Bt, rx::RowEx e1, rx::RowEx e2) {
    using na::bf16x8; using na::f32x16;
    constexpr int NB = D / 32;
    float* red = (float*)lds; float* Prow = red + 8 * 16 * 64; float* S = Prow + 32;
    for (int unit = blockIdx.x; unit < NB; unit += gridDim.x) {
        const int tid = tid_now(), wave = tid >> 6, lane = tid & 63, r32 = lane & 31, hi = lane >> 5, n0 = 32 * unit;
        f32x16 acc;
#pragma unroll
        for (int q = 0; q < 16; ++q) acc[q] = 0.f;
        const bf16_t* ap = A + (size_t)r32 * K + 8 * hi; const bf16_t* bp = Bt + (size_t)(n0 + r32) * K + 8 * hi;
#pragma unroll 8
        for (int s8 = 0; s8 < K / 128; ++s8) { const int ks = wave * (K / 128) + s8;
            const bf16x8 a = *reinterpret_cast<const bf16x8*>(ap + 16 * ks), bb = *reinterpret_cast<const bf16x8*>(bp + 16 * ks);
            acc = __builtin_amdgcn_mfma_f32_32x32x16_bf16(a, bb, acc, 0, 0, 0); }
        __syncthreads();
#pragma unroll
        for (int q = 0; q < 16; ++q) red[(wave * 16 + q) * 64 + lane] = acc[q];
        __syncthreads();
        float val[2]; int row[2]; const int col = n0 + r32;
#pragma unroll
        for (int rep = 0; rep < 2; ++rep) { const int q = wave + 8 * rep; float s = 0.f;
#pragma unroll
            for (int w = 0; w < 8; ++w) s += red[(w * 16 + q) * 64 + lane];
            val[rep] = s; row[rep] = na::crow(q, hi); }
        const rx::RowEx* ex[2] = {&e1, &e2};
#pragma unroll
        for (int pass = 0; pass < (MODE == 0 ? 2 : 1); ++pass) {
            const rx::RowEx& X = *ex[pass];
#pragma unroll
            for (int rep = 0; rep < 2; ++rep) { float s = val[rep] * val[rep];
#pragma unroll
                for (int o = 1; o < 32; o <<= 1) s += __shfl_xor(s, o);
                if (r32 == 0) Prow[row[rep]] = s; }
            __syncthreads();
            if (tid < 32) __hip_atomic_store((unsigned*)X.slots + ((size_t)(32 * 64 + unit) * 256 + tid), __float_as_uint(Prow[tid]), __ATOMIC_RELAXED, __HIP_MEMORY_SCOPE_AGENT);
            asm volatile("s_waitcnt vmcnt(0)" ::: "memory");
            if (tid == 0) __hip_atomic_fetch_add(X.cnt + 64 * 32, 1u, __ATOMIC_RELAXED, __HIP_MEMORY_SCOPE_AGENT);
            if (tid < 64) rx::wait_count(X.cnt + 64 * 32, (unsigned)NB, X.tmo);
            __syncthreads();
            if (tid < 32) { float tot = 0.f; for (int t = 0; t < NB; ++t) tot += __uint_as_float(__hip_atomic_load((unsigned*)X.slots + ((size_t)(32 * 64 + t) * 256 + tid), __ATOMIC_RELAXED, __HIP_MEMORY_SCOPE_AGENT));
                S[tid] = 1.0f / sqrtf(tot * (1.0f / D) + RMS_EPS); }
            __syncthreads();
#pragma unroll
            for (int rep = 0; rep < 2; ++rep) { const size_t o = (size_t)(MPR + row[rep]) * D + col; const float rs = S[row[rep]];
                if (MODE == 0 && pass == 0) { val[rep] = p.x_sample[(size_t)row[rep] * D + col] + val[rep] * rs * p.g_post1[col]; p.X1()[o] = val[rep]; }
                else if (MODE == 0) p.H2()[o] = f2bf(val[rep] * rs * p.g_pre2[col]);
                else { const float y = p.X1()[o] + val[rep] * rs * p.g_post2[col]; p.X2()[o] = y; p.X2b()[o] = f2bf(y); } }
            __syncthreads();
        }
    }
}
#endif
#ifndef CPU_SHIM
DEVFN void st_h2_pad(const Params& p) {
    for (long i = (long)blockIdx.x * 512 + tid_now(); i < (long)(MPAD - M) * D / 8; i += (long)gridDim.x * 512) *(v4u*)(p.H2() + (size_t)M * D + i * 8) = (v4u){0u, 0u, 0u, 0u};
}
#endif
#ifndef CPU_SHIM
#ifndef P1_DYNAMIC
#define P1_DYNAMIC 0
#endif
#if P1_DYNAMIC
using PoolBase = pg8::DynOrder;
#else
using PoolBase = pg8::StaticOrder;
#endif
struct PoolOrder : PoolBase {
    const float* cache; const int* page_table; const float* w_cmp; float* kvcs; mutable int step;
    static constexpr long NV = (long)DEC_BATCH * NCS * (KV2 / 4);
    __device__ __forceinline__ void pool_step(int k) const {
        const long o = (long)k * ((long)gridDim.x * 512) + (long)blockIdx.x * 512 + tid_now();
        if (o >= NV) return;
        const int c4 = (int)(o % (KV2 / 4)), n = (int)((o / (KV2 / 4)) % NCS), bs = (int)(o / ((long)(KV2 / 4) * NCS));
        const float* base = cache + ((size_t)page_table[bs * N_PAGES + (32 * n) / PAGE] * PAGE + (32 * n) % PAGE) * KV2 + 4 * c4;
        v4f acc = (v4f){0.f, 0.f, 0.f, 0.f}; v4f x[32];
#pragma unroll
        for (int cc = 0; cc < 32; ++cc) x[cc] = *(const v4f*)(base + (size_t)cc * KV2);
#pragma unroll
        for (int hf = 0; hf < 2; ++hf) { v4f w[16];
#pragma unroll
            for (int cc = 0; cc < 16; ++cc) w[cc] = *(const v4f*)(w_cmp + (size_t)(16 * hf + cc) * KV2 + 4 * c4);
#pragma unroll
            for (int cc = 0; cc < 16; ++cc) acc += x[16 * hf + cc] * w[cc]; }
        *(v4f*)(kvcs + o * 4) = acc;
    }
    __device__ __forceinline__ void perm(pg8::Unit& u) const {
        constexpr int T_H0 = ip::E_CMP / 256, NHV = (ip::E_GM - ip::E_CMP) / 256;
        const int k = u.pn;
        if (k % 5 == 4 && k / 5 < NHV) u.pn = T_H0 + k / 5;
        else { const int li = k - (k / 5 < NHV ? k / 5 : NHV); u.pn = li < T_H0 ? li : li + NHV; } }
    __device__ __forceinline__ bool next(int i, pg8::Unit& u) const { if (!PoolBase::next(i, u)) return false; perm(u); return true; }
    __device__ __forceinline__ bool fetch(int i, pg8::Unit& u) const { if (!PoolBase::fetch(i, u)) return false; perm(u); return true; }
    __device__ __forceinline__ void done(const pg8::Unit&) const { pool_step(step); ++step; }
    __device__ __forceinline__ void finish() const { const int nsteps = (int)((NV + (long)gridDim.x * 512 - 1) / ((long)gridDim.x * 512)); for (; step < nsteps; ++step) pool_step(step); }
};
#endif
constexpr int N_PHASES = 13;
#ifndef MK_N_LAUNCHES
#define MK_N_LAUNCHES 1
#endif
static void fill_inputs(Params& p, void* const* d_in, void* d_out) {
    p.x_prompt = (const float*)d_in[0]; p.x_sample = (const float*)d_in[1]; p.cache_cmp = (const float*)d_in[2]; p.cache_sel = (const float*)d_in[3];
    p.page_table = (const int*)d_in[4]; p.state_win = (const float*)d_in[5]; p.state_gdn = (const float*)d_in[6]; p.state_conv = (const float*)d_in[7];
    p.p_prompt = (const float*)d_in[8]; p.p_sample = (const float*)d_in[9]; p.g_pre1 = (const float*)d_in[10]; p.w_in = (const float*)d_in[11];
    p.conv_w = (const float*)d_in[12]; p.A_log = (const float*)d_in[13]; p.dt_bias = (const float*)d_in[14]; p.gdn_norm_w = (const float*)d_in[15];
    p.w_cmp = (const float*)d_in[16]; p.w_o = (const float*)d_in[17]; p.g_post1 = (const float*)d_in[18]; p.g_pre2 = (const float*)d_in[19];
    p.w_ffn_in = (const float*)d_in[20]; p.w_ffn_out = (const float*)d_in[21]; p.g_post2 = (const float*)d_in[22]; p.w_ple = (const float*)d_in[23];
    p.w_ple_gate = (const float*)d_in[24]; p.out = (float*)d_out;
}

#ifndef CPU_SHIM
constexpr int LDS_BYTES = 160 * 1024;
constexpr int MISC_OFF = LDS_BYTES - 256;
static_assert(gd::G2_END <= MISC_OFF && gd::G1_END <= MISC_OFF && na::OFF_END <= MISC_OFF && pg8::STAGE_BYTES <= MISC_OFF, "LDS map");
template <class Epi> __device__ __forceinline__ void run_gemm(PG8_LAS unsigned char* lds, const bf16_t* A, const bf16_t* Bt, int Mr, int N, int K, const Epi& E) {
    pg8::Gemm g{A, Bt, Mr, N, K}; pg8::StaticOrder S; S.init(Mr, N, (int)gridDim.x, (int)blockIdx.x);
    pg8::gemm_phase<Epi, pg8::StaticOrder, false>(lds, g, S, E, nullptr);
}
__global__ void __launch_bounds__(512, 2) fwd(Params p) {
    extern __shared__ __attribute__((aligned(16))) unsigned char lds_raw[];
    PG8_LAS unsigned char* lds = (PG8_LAS unsigned char*)lds_raw;
    float* sm = (float*)lds_raw;
    volatile LAS unsigned* misc = (volatile LAS unsigned*)(lds + MISC_OFF);
    if (threadIdx.x < 4) misc[threadIdx.x] = 0u;
    __syncthreads();
    XcdBarrier bar = xcd_barrier_post(p.ctl(), misc);
    const int lo = p.ph_lo, hi = p.ph_hi;
#define IN(k) (lo <= (k) && (k) < hi)
#ifndef TIME_PHASE
#define TIME_PHASE -1
#endif
    unsigned long long tp_a = (TIME_PHASE % 100 == 0) ? wall_clock64() : 0ull, tp_b = 0ull;
#define SEAM(k) do { if (TIME_PHASE == 100 + (k)) tp_b = wall_clock64(); \
                     if (TIME_PHASE == 200 + (k) && threadIdx.x == 0) __hip_atomic_store(p.ctl() + 32000 + blockIdx.x, (unsigned)(wall_clock64() - tp_a), __ATOMIC_RELAXED, __HIP_MEMORY_SCOPE_AGENT); \
                     if (IN(k) && IN((k) + 1)) xcd_barrier(bar); if (TIME_PHASE == (k)) tp_b = wall_clock64(); \
                     if (TIME_PHASE >= 300 && TIME_PHASE < 310 && (k) == 3) tp_b = tp_a + __hip_atomic_load(p.ctl() + 32300 + (TIME_PHASE - 300), __ATOMIC_RELAXED, __HIP_MEMORY_SCOPE_AGENT); \
                     if (TIME_PHASE == 200 + (k) && blockIdx.x == 0) { unsigned sacc = 0; for (int w = 0; w < (int)gridDim.x; ++w) sacc += __hip_atomic_load(p.ctl() + 32000 + w, __ATOMIC_RELAXED, __HIP_MEMORY_SCOPE_AGENT); tp_b = tp_a + sacc / gridDim.x; } \
                     if (TIME_PHASE >= 0 && ((TIME_PHASE < 300 && TIME_PHASE % 100 == (k) + 1) || (TIME_PHASE % 100 == 9 && (k) == 7) || (TIME_PHASE >= 300 && (k) == 2))) tp_a = wall_clock64(); } while (0)
#ifndef DUP_PHASE
#define DUP_PHASE -1
#endif
#define RUN(id, ...) do { __VA_ARGS__; if (DUP_PHASE == (id)) { __syncthreads(); __VA_ARGS__; } } while (0)
    if (DUP_PHASE == 200) { for (int k = 0; k < 10; ++k) xcd_barrier(bar); }
    if (IN(0)) { RUN(0, st_prep_weights_fast(p, sm); __syncthreads(); st_prep_rows_fast(p)); if (DUP_PHASE == 1000) { __syncthreads(); st_prep_weights_fast(p, sm); } if (DUP_PHASE == 1001) { __syncthreads(); st_prep_rows_fast(p); } } SEAM(0);
    if (IN(1)) { if (STAGGER_US > 0) { const unsigned long long t0 = wall_clock64(), dt = (unsigned long long)((blockIdx.x / 8) % 8) * STAGGER_US * 100ull; while (wall_clock64() - t0 < dt) __builtin_amdgcn_s_sleep(8); }
                 { pg8::Gemm g{p.H1(), p.Wt_in(), MPAD, NPROJ, D}; PoolOrder S; S.init(MPAD, NPROJ, (int)gridDim.x, (int)blockIdx.x);
                   S.cache = p.cache_cmp; S.page_table = p.page_table; S.w_cmp = p.w_cmp; S.kvcs = p.KVCs(); S.step = 0;
#if P1_DYNAMIC
                   S.qctr = p.ctl() + 31000; S.slot = (volatile PG8_LAS unsigned*)(lds + MISC_OFF) + 8; S.claimed = 0u;
#endif
                   pg8::gemm_phase<ip::Epi, PoolOrder, false>(lds, g, S, ip::Epi{p.ws, p.out, p.A_log, p.dt_bias}, nullptr); S.finish(); }
                 if (DUP_PHASE == 1) { __syncthreads(); run_gemm(lds, p.H1(), p.Wt_in(), MPAD, NPROJ, D, ip::Epi{p.ws, p.out, p.A_log, p.dt_bias}); } } SEAM(1);
    if (IN(2)) { RUN(20, st_post_fast(p)); RUN(22, st_gdn_g1_mfma(p, (char*)lds_raw)); } SEAM(2);
    if (IN(3)) { RUN(30, st_gdn_naive(p, BATCH)); __syncthreads(); st_mixers(p, (char*)lds_raw, misc, QW_P3, 0, tp_a); if (DUP_PHASE == 3) { __syncthreads(); st_mixers(p, (char*)lds_raw, misc, QW_P3 + 64); }
                 if (DUP_PHASE == 301) { __syncthreads(); st_mixers(p, (char*)lds_raw, misc, QW_P3 + 64, 1); }
                 if (DUP_PHASE == 303) { __syncthreads(); st_mixers(p, (char*)lds_raw, misc, QW_P3 + 64, 3); }
                 if (DUP_PHASE == 304) { __syncthreads(); st_mixers(p, (char*)lds_raw, misc, QW_P3 + 64, 4); }
                 if (DUP_PHASE == 302) { __syncthreads(); st_mixers(p, (char*)lds_raw, misc, QW_P3 + 64, 2); } } SEAM(3);
    if (IN(4)) { RUN(4, st_merge_fast(p)); } SEAM(4);
#define RXE(set) rx::RowEx{p.RXS() + (size_t)(set) * 64 * 64 * 256, p.ctl() + rx::RX_CNT0 + (set) * 64 * 64, p.ctl() + XB_TMO}
#ifndef FUSED_NORMS
#define FUSED_NORMS 0
#endif
    if (IN(5)) { RUN(5,
                 if (FUSED_NORMS) { run_gemm(lds, p.MIX(), p.Wt_o(), MPR, D, D, EpiWoNorm{p.x_prompt, p.X1(), p.H2(), p.g_post1, p.g_pre2, RXE(0), RXE(1)}); __syncthreads();
                                    small32_norm<D, 0>(p, (char*)lds_raw, p.MIX() + (size_t)MPR * D, p.Wt_o(), RXE(0), RXE(1)); st_h2_pad(p); }
                 else { run_gemm(lds, p.MIX(), p.Wt_o(), MPR, D, D, pg8::EpiBf16<0>{p.T1b(), D, nullptr, 0, 0}); __syncthreads();
                        gemm_small32<D, D>((char*)lds_raw, p.MIX() + (size_t)MPR * D, p.Wt_o(), EpiSBf16{p.T1b() + (size_t)MPR * D, D}); }); } SEAM(5);
    if (IN(6) && !FUSED_NORMS) { RUN(6, st_norm1_fast(p)); } SEAM(6);
    if (IN(7)) { RUN(7, run_gemm(lds, p.H2(), p.Wt_ffi(), MPAD, 2 * FFN, D, EpiSwiGLU{p.ACT(), FFN}));
                 { constexpr int NU7 = (MPAD / 256) * (2 * FFN / 256); const int G = (int)gridDim.x, full = NU7 % G;
                   const int c = (int)blockIdx.x, nfree = full ? G - full : G, c2 = full ? c - full : c;
                   if (c2 >= 0) { __syncthreads();
                       pg8::Gemm g{p.Pbf(), p.Wt_ple(), MPR, D, PLE}; pg8::StaticOrder S; S.init(MPR, D, nfree, c2);
                       pg8::gemm_phase<pg8::EpiBf16<0>, pg8::StaticOrder, false>(lds, g, S, pg8::EpiBf16<0>{p.PLb(), D, nullptr, 0, 0}, nullptr); __syncthreads();
                       for (int unit = c2; unit < D / 32; unit += nfree) gemm_small32_unit<D, PLE>((char*)lds_raw, p.Pbf() + (size_t)MPR * PLE, p.Wt_ple(), EpiSBf16{p.PLb() + (size_t)MPR * D, D}, unit); } } } SEAM(7);
    if (IN(9)) { RUN(9, if (FUSED_NORMS) { run_gemm(lds, p.ACT(), p.Wt_ffo(), MPR, D, FFN, EpiFfoNorm{p.X1(), p.X2(), p.X2b(), p.g_post2, RXE(2)}); __syncthreads();
                                           small32_norm<FFN, 1>(p, (char*)lds_raw, p.ACT() + (size_t)MPR * FFN, p.Wt_ffo(), RXE(2), RXE(2)); }
                 else { run_gemm(lds, p.ACT(), p.Wt_ffo(), MPR, D, FFN, pg8::EpiBf16<0>{p.T2b(), D, nullptr, 0, 0}); __syncthreads();
                        gemm_small32<D, FFN>((char*)lds_raw, p.ACT() + (size_t)MPR * FFN, p.Wt_ffo(), EpiSBf16{p.T2b() + (size_t)MPR * D, D}); }); } SEAM(9);
    if (IN(10) && !FUSED_NORMS) { RUN(10, st_norm2_fast(p)); } SEAM(10);
    if (IN(11)) { RUN(11, run_gemm(lds, p.X2b(), p.Wt_pg(), MPR, D, D, EpiFinal{p.X2b(), p.PLb(), p.out}); __syncthreads();
                  gemm_small32<D, D>((char*)lds_raw, p.X2b() + (size_t)MPR * D, p.Wt_pg(), EpiSFinal{p.X2b() + (size_t)MPR * D, p.PLb() + (size_t)MPR * D, p.out + O_YS})); }
    if (TIME_PHASE >= 0) { if (TIME_PHASE % 100 == 11) tp_b = wall_clock64();
                           if (blockIdx.x == 0) { const unsigned long long t_end = wall_clock64(), dt = 4ull * (tp_b - tp_a); while (wall_clock64() - t_end < dt) __builtin_amdgcn_s_sleep(8); } }
#undef RUN
#undef IN
#undef SEAM
}

extern "C" void kernel_launch(void* const* d_in, const int* in_sizes, int n_in, void* d_out, int out_size, void* d_ws, size_t ws_size, hipStream_t stream) {
    static int grid = 0;
    Params p; memset(&p, 0, sizeof(p));
    const size_t need = WSL.end; p.ws = (unsigned char*)d_ws;
    if (grid == 0) {
        if (n_in != 25 || (long)out_size != O_END || ws_size < need) { fprintf(stderr, "kernel_launch: shape mismatch (n_in %d out %d ws %zu need %zu)\n", n_in, out_size, ws_size, need); grid = -1; return; }
        int dev = 0, cus = 0, per_cu = 0;
        if (hipGetDevice(&dev) != hipSuccess || hipDeviceGetAttribute(&cus, hipDeviceAttributeMultiprocessorCount, dev) != hipSuccess) { grid = -1; return; }
        if (hipFuncSetAttribute((const void*)fwd, hipFuncAttributeMaxDynamicSharedMemorySize, LDS_BYTES) != hipSuccess) { fprintf(stderr, "kernel_launch: hipFuncSetAttribute failed\n"); grid = -1; return; }
        if (hipOccupancyMaxActiveBlocksPerMultiprocessor(&per_cu, (const void*)fwd, 512, LDS_BYTES) != hipSuccess || per_cu < 1) fprintf(stderr, "kernel_launch: occupancy query says %d\n", per_cu);
        (void)hipGetLastError();
        grid = cus;
    }
    if (grid < 0) return;
    fill_inputs(p, d_in, d_out);
    (void)hipMemsetAsync(p.ctl(), 0, CTL_BYTES, stream);
#if MK_N_LAUNCHES == 1
    p.ph_lo = 0; p.ph_hi = N_PHASES;
    hipLaunchKernelGGL(fwd, dim3(grid), dim3(512), LDS_BYTES, stream, p);
#else
    for (int k = 0; k < N_PHASES; ++k) { p.ph_lo = k; p.ph_hi = k + 1; hipLaunchKernelGGL(fwd, dim3(grid), dim3(512), LDS_BYTES, stream, p); }
#endif
    const hipError_t le = hipPeekAtLastError();
    if (le != hipSuccess) fprintf(stderr, "kernel_launch: launch failed: %s\n", hipGetErrorName(le));
}
#else
#include <omp.h>
static void cpu_gemm(const act_t* A, int lda, const float* W, int K, int N, float* C, int ldc, int rows) {
#pragma omp parallel for schedule(dynamic, 4)
    for (int m = 0; m < rows; ++m) { float* c = C + (size_t)m * ldc; for (int n = 0; n < N; ++n) c[n] = 0.f;
        for (int k = 0; k < K; ++k) { const float a = A[(size_t)m * lda + k]; const float* w = W + (size_t)k * N; for (int n = 0; n < N; ++n) c[n] += a * w[n]; } }
}
template <class F> static void par(F f) {
#pragma omp parallel
    { g_bid = omp_get_thread_num(); g_nblk = omp_get_num_threads(); static thread_local float smbuf[65536]; f(smbuf); }
}
static void run_all_cpu(Params& p) {
    par([&](float* sm) { st_prep(p, sm); });
    cpu_gemm(p.H1(), D, p.w_in, D, PROJ, p.Z(), NPROJ, M);
    par([&](float* sm) { st_post_inproj(p); st_gdn_g1(p, sm); });
    par([&](float* sm) { st_gdn_naive(p, BATCH); st_gdn_g2(p, sm); st_nsa_naive(p, sm, 0); });
    par([&](float*) { st_merge(p); });
    cpu_gemm(p.MIX(), D, p.w_o, D, D, p.T1(), D, M); cpu_gemm(p.Pbf(), PLE, p.w_ple, PLE, D, p.PL(), D, M);
    par([&](float* sm) { st_norm1(p, sm); });
    cpu_gemm(p.H2(), D, p.w_ffn_in, D, 2 * FFN, p.FF(), 2 * FFN, M);
    par([&](float*) { st_act(p); });
    cpu_gemm(p.ACT(), FFN, p.w_ffn_out, FFN, D, p.T2(), D, M);
    par([&](float* sm) { st_norm2(p, sm); });
    cpu_gemm(p.X2b(), D, p.w_ple_gate, D, D, p.G(), D, M);
    par([&](float*) { st_final(p); });
}
#endif
```
